# Optimizing an MI355X kernel written in HIP

```python
import jax, jax.numpy as jnp
from jax import lax
import numpy as np

D_MODEL = 1024
BATCH = 16
SEQ = 2048
DEPTH = 2

GRID_W = 64
CTX_LEN = 256
N_MIXERS = 2
POOL_WINDOWS = (2, 4, 8, 16)
N_POOL_GROUPS = 4
POOL_GC = D_MODEL // N_POOL_GROUPS
D_RNN = (4 * D_MODEL // 3) // 128 * 128
LRU_BLOCK = 128
LRU_HEADS = D_RNN // LRU_BLOCK
CONV_W = 4
LRU_C = 8.0
D_FF = (8 * D_MODEL // 3 + 255) // 256 * 256
N_EXPERTS = 8
TOP_K = 2
D_EXPERT = 7 * D_MODEL // 2
MOE_BLOCK = 256
EPS = 1e-6

kernel_name = "hybrid_pool_rglru_moe_dit_trunk"


def rmsnorm(x, g):
    xf = x.astype(jnp.float32)
    y = xf * lax.rsqrt(jnp.mean(xf * xf, axis=-1, keepdims=True) + EPS)
    return (y * g.astype(jnp.float32)).astype(x.dtype)


def modulate(h, shift, scale):
    return h * (1 + scale) + shift


def centred_window_mean(u, win, axis):
    n = u.shape[axis]
    cs = jnp.cumsum(u.astype(jnp.float32), axis=axis)
    pad = [(0, 0)] * u.ndim
    pad[axis] = (1, 0)
    cs = jnp.pad(cs, pad)
    t = np.arange(n)
    lo = np.clip(t - win // 2, 0, n)
    hi = np.clip(t - win // 2 + win, 0, n)
    shape = [1] * u.ndim
    shape[axis] = n
    count = jnp.asarray((hi - lo).astype(np.float32)).reshape(shape)
    s = jnp.take(cs, jnp.asarray(hi), axis=axis) - jnp.take(cs, jnp.asarray(lo), axis=axis)
    return (s / count).astype(u.dtype)


def pool_mixer(h, axis, w, scale):
    groups = jnp.split(h, N_POOL_GROUPS, axis=-1)
    pooled = jnp.stack([centred_window_mean(g, win, axis) - g
                        for g, win in zip(groups, POOL_WINDOWS)], axis=-2)
    y = jnp.einsum('...gc,gcd->...gd', pooled, w)
    return y.reshape(h.shape) * scale


def centred_depthwise_conv(u, w, b):
    L = u.shape[1]
    left = CONV_W // 2
    right = CONV_W - 1 - left
    up = jnp.pad(u, ((0, 0), (left, right), (0, 0)))
    return sum(up[:, k:k + L] * w[k] for k in range(CONV_W)) + b


def lru_inputs(h, w_in, conv_w, conv_b):
    gate, u = jnp.split(h @ w_in, 2, axis=-1)
    return gate, centred_depthwise_conv(u, conv_w, conv_b)


def _scan_combine(left, right):
    a_l, b_l = left
    a_r, b_r = right
    return a_l * a_r, a_r * b_l + b_r


def rglru_scan(u, w_r, b_r, w_i, b_i, lam, h0, reverse):
    bsz, L, _ = u.shape
    ub = u.reshape(bsz, L, LRU_HEADS, LRU_BLOCK)
    r = jax.nn.sigmoid(jnp.einsum('blhc,hcd->blhd', ub, w_r).reshape(bsz, L, D_RNN) + b_r)
    i = jax.nn.sigmoid(jnp.einsum('blhc,hcd->blhd', ub, w_i).reshape(bsz, L, D_RNN) + b_i)
    log_a = -LRU_C * r.astype(jnp.float32) * jax.nn.softplus(-lam.astype(jnp.float32))
    a = jnp.exp(log_a)
    b = jnp.sqrt(-jnp.expm1(2.0 * log_a)) * (i * u).astype(jnp.float32)
    if reverse:
        a, b = jnp.flip(a, 1), jnp.flip(b, 1)
    a_cum, h = lax.associative_scan(_scan_combine, (a, b), axis=1)
    h = h + a_cum * h0[:, None, :]
    if reverse:
        h = jnp.flip(h, 1)
    return h


def rglru_mixer(hx, hz, w_in, conv_w, conv_b, w_r, b_r, w_i, b_i, lam, w_out, need_ctx_out):
    gx, ux = lru_inputs(hx, w_in, conv_w, conv_b)
    gz, uz = lru_inputs(hz, w_in, conv_w, conv_b)
    h0 = jnp.zeros((uz.shape[0], D_RNN), jnp.float32)
    sum_x = 0.0
    sum_z = 0.0
    for d, reverse in enumerate((False, True)):
        hz_d = rglru_scan(uz, w_r[d], b_r[d], w_i[d], b_i[d], lam[d], h0, reverse)
        state = hz_d[:, 0] if reverse else hz_d[:, -1]
        hx_d = rglru_scan(ux, w_r[d], b_r[d], w_i[d], b_i[d], lam[d], state, reverse)
        sum_x = sum_x + hx_d
        sum_z = sum_z + hz_d
    yx = (sum_x.astype(hx.dtype) * jax.nn.gelu(gx)) @ w_out
    yz = (sum_z.astype(hz.dtype) * jax.nn.gelu(gz)) @ w_out if need_ctx_out else None
    return yx, yz


def swiglu(h, w_gu, w_down):
    g, u = jnp.split(h @ w_gu, 2, axis=-1)
    return (jax.nn.silu(g) * u) @ w_down


def moe_swiglu(h, w_router, w_gu, w_down):
    shp = h.shape
    t = h.reshape(-1, shp[-1])
    n = t.shape[0]
    logits = t.astype(jnp.float32) @ w_router.astype(jnp.float32)
    probs = jax.nn.softmax(logits, axis=-1)
    top_p, top_e = lax.top_k(probs, TOP_K)
    top_w = (top_p / jnp.sum(top_p, axis=-1, keepdims=True)).astype(h.dtype)
    flat_e = top_e.reshape(-1)
    flat_w = top_w.reshape(-1)
    flat_tok = jnp.repeat(jnp.arange(n, dtype=jnp.int32), TOP_K)
    order = jnp.argsort(flat_e)
    se = flat_e[order]
    counts = jnp.bincount(flat_e, length=N_EXPERTS)
    padded = (counts + MOE_BLOCK - 1) // MOE_BLOCK * MOE_BLOCK
    starts = jnp.cumsum(counts) - counts
    pends = jnp.cumsum(padded)
    pstarts = pends - padded
    rank = jnp.arange(n * TOP_K, dtype=jnp.int32) - starts[se]
    dest = pstarts[se] + rank
    n_slots = (-(-(n * TOP_K) // MOE_BLOCK) + N_EXPERTS) * MOE_BLOCK
    n_blocks = n_slots // MOE_BLOCK
    slot_tok = jnp.full((n_slots,), n, jnp.int32).at[dest].set(flat_tok[order])
    slot_w = jnp.zeros((n_slots,), h.dtype).at[dest].set(flat_w[order])
    block_e = jnp.minimum(jnp.searchsorted(pends, jnp.arange(n_blocks, dtype=jnp.int32) * MOE_BLOCK,
                                           side='right'), N_EXPERTS - 1)
    t_pad = jnp.concatenate([t, jnp.zeros((1, t.shape[1]), t.dtype)], axis=0)

    def expert_block(args):
        tok, e = args
        return swiglu(t_pad[tok], w_gu[e], w_down[e])

    yb = lax.map(expert_block, (slot_tok.reshape(n_blocks, MOE_BLOCK), block_e))
    y = jax.ops.segment_sum(yb.reshape(n_slots, -1) * slot_w[:, None], slot_tok, num_segments=n + 1)[:n]
    return y.reshape(shp)


def setup_inputs(seed: int = 0) -> dict:
    key = jax.random.key(seed)
    ks = iter(jax.random.split(key, 40))
    n_even = (DEPTH + 1) // 2
    n_odd = DEPTH // 2
    D = D_MODEL

    def nrm(shape, scale):
        return jax.random.normal(next(ks), shape, jnp.float32) * scale

    x = nrm((BATCH, SEQ, D), 1.0)
    c = nrm((BATCH, D), 1.0)
    ctx = nrm((BATCH, CTX_LEN, D), 1.0)
    c_ctx = nrm((D,), 1.0)
    ada_w = nrm((DEPTH, D, 6 * D), 0.5 * D ** -0.5)
    ada_b = nrm((DEPTH, 6 * D), 0.02)
    norm1_g = 1.0 + nrm((DEPTH, D), 0.05)
    norm2_g = 1.0 + nrm((DEPTH, D), 0.05)
    pool_w = nrm((n_even, N_POOL_GROUPS, POOL_GC, POOL_GC), POOL_GC ** -0.5)
    pool_scale = 1.0 + nrm((n_even, D), 0.05)
    ffn_w_gu = nrm((n_even, D, 2 * D_FF), D ** -0.5)
    ffn_w_down = nrm((n_even, D_FF, D), D_FF ** -0.5)
    lru_w_in = nrm((n_odd, D, 2 * D_RNN), D ** -0.5)
    lru_conv_w = nrm((n_odd, CONV_W, D_RNN), CONV_W ** -0.5)
    lru_conv_b = nrm((n_odd, D_RNN), 0.02)
    lru_w_r = nrm((n_odd, 2, LRU_HEADS, LRU_BLOCK, LRU_BLOCK), LRU_BLOCK ** -0.5)
    lru_b_r = nrm((n_odd, 2, D_RNN), 0.02)
    lru_w_i = nrm((n_odd, 2, LRU_HEADS, LRU_BLOCK, LRU_BLOCK), LRU_BLOCK ** -0.5)
    lru_b_i = nrm((n_odd, 2, D_RNN), 0.02)
    a8 = jax.random.uniform(next(ks), (n_odd, 2, D_RNN), jnp.float32, minval=0.9, maxval=0.999)
    a_base = a8 ** (1.0 / LRU_C)
    lru_lambda = jnp.log(a_base) - jnp.log1p(-a_base)
    lru_w_out = nrm((n_odd, D_RNN, D), D_RNN ** -0.5)
    moe_w_router = nrm((n_odd, D, N_EXPERTS), D ** -0.5)
    moe_w_gu = nrm((n_odd, N_EXPERTS, D, 2 * D_EXPERT), D ** -0.5)
    moe_w_down = nrm((n_odd, N_EXPERTS, D_EXPERT, D), D_EXPERT ** -0.5)
    final_g = 1.0 + nrm((D,), 0.05)
    return {"x": x, "c": c, "ctx": ctx, "c_ctx": c_ctx,
            "ada_w": ada_w, "ada_b": ada_b, "norm1_g": norm1_g, "norm2_g": norm2_g,
            "pool_w": pool_w, "pool_scale": pool_scale,
            "ffn_w_gu": ffn_w_gu, "ffn_w_down": ffn_w_down,
            "lru_w_in": lru_w_in, "lru_conv_w": lru_conv_w, "lru_conv_b": lru_conv_b,
            "lru_w_r": lru_w_r, "lru_b_r": lru_b_r, "lru_w_i": lru_w_i, "lru_b_i": lru_b_i,
            "lru_lambda": lru_lambda, "lru_w_out": lru_w_out,
            "moe_w_router": moe_w_router, "moe_w_gu": moe_w_gu, "moe_w_down": moe_w_down,
            "final_g": final_g}


def reference(x, c, ctx, c_ctx, ada_w, ada_b, norm1_g, norm2_g, pool_w, pool_scale,
              ffn_w_gu, ffn_w_down, lru_w_in, lru_conv_w, lru_conv_b, lru_w_r, lru_b_r,
              lru_w_i, lru_b_i, lru_lambda, lru_w_out, moe_w_router, moe_w_gu, moe_w_down,
              final_g):
    bsz, seq_len, d = x.shape
    rows = seq_len // GRID_W
    z = ctx
    for i in range(DEPTH):
        is_last = i == DEPTH - 1
        j = i // N_MIXERS
        mx = (jax.nn.silu(c) @ ada_w[i] + ada_b[i])[:, None, :]
        mz = jax.nn.silu(c_ctx) @ ada_w[i] + ada_b[i]
        sh1x, sc1x, g1x, sh2x, sc2x, g2x = jnp.split(mx, 6, axis=-1)
        sh1z, sc1z, g1z, sh2z, sc2z, g2z = jnp.split(mz, 6, axis=-1)
        hx = modulate(rmsnorm(x, norm1_g[i]), sh1x, sc1x)
        if i % N_MIXERS == 0:
            yx = pool_mixer(hx.reshape(bsz, rows, GRID_W, d), 2, pool_w[j], pool_scale[j])
            x = x + g1x * yx.reshape(bsz, seq_len, d)
            if not is_last:
                hz = modulate(rmsnorm(z, norm1_g[i]), sh1z, sc1z)
                z = z + g1z * pool_mixer(hz, 1, pool_w[j], pool_scale[j])
            x = x + g2x * swiglu(modulate(rmsnorm(x, norm2_g[i]), sh2x, sc2x), ffn_w_gu[j], ffn_w_down[j])
            if not is_last:
                z = z + g2z * swiglu(modulate(rmsnorm(z, norm2_g[i]), sh2z, sc2z), ffn_w_gu[j], ffn_w_down[j])
        else:
            hz = modulate(rmsnorm(z, norm1_g[i]), sh1z, sc1z)
            yx, yz = rglru_mixer(hx, hz, lru_w_in[j], lru_conv_w[j], lru_conv_b[j], lru_w_r[j], lru_b_r[j],
                                 lru_w_i[j], lru_b_i[j], lru_lambda[j], lru_w_out[j], not is_last)
            x = x + g1x * yx
            if not is_last:
                z = z + g1z * yz
            x = x + g2x * moe_swiglu(modulate(rmsnorm(x, norm2_g[i]), sh2x, sc2x),
                                     moe_w_router[j], moe_w_gu[j], moe_w_down[j])
            if not is_last:
                z = z + g2z * moe_swiglu(modulate(rmsnorm(z, norm2_g[i]), sh2z, sc2z),
                                         moe_w_router[j], moe_w_gu[j], moe_w_down[j])
    return rmsnorm(x, final_g)
```

```cpp
#include <hip/hip_runtime.h>
#include <hip/hip_cooperative_groups.h>
#include <cstdio>
#include <cstdint>
namespace cg = cooperative_groups;

#define LAS __attribute__((address_space(3)))
typedef unsigned short bf16_t;
typedef short bf16x8 __attribute__((ext_vector_type(8)));
typedef float f32x4 __attribute__((ext_vector_type(4)));
typedef float f32x2 __attribute__((ext_vector_type(2)));
typedef unsigned u32x4 __attribute__((ext_vector_type(4)));
typedef unsigned u32x2 __attribute__((ext_vector_type(2)));

#ifndef MK_SINGLE
#define MK_SINGLE 0
#endif

constexpr int D = 1024, NB = 16, SEQ = 2048, CL = 256, NX = NB * SEQ, NZ = NB * CL, NT = NX + NZ;
constexpr int DFF = 2816, DR = 1280, DE = 3584, NE = 8;
constexpr int NSLOT = (NX * 2 / 256 + NE) * 256;
constexpr int NWAVES = 8, NTHREADS = 512;
constexpr float EPS = 1e-6f;
constexpr int NPHASES = 17;

constexpr size_t MiB = 1024 * 1024;
constexpr size_t WS_CTL = 0;
constexpr size_t CTL_BYTES = 4096;
constexpr size_t WS_TILEE = 4096;
constexpr size_t WS_MOD = 64 * 1024;
constexpr size_t WS_ROUTE = 1 * MiB;
constexpr size_t WS_CHUNK = 2 * MiB;
constexpr size_t WS_ZRES = 5 * MiB;
constexpr size_t WS_W = 21 * MiB;
constexpr size_t W_POOLT = WS_W;
constexpr size_t W_GUT = W_POOLT + (size_t)1024 * 256 * 2;
constexpr size_t W_DT = W_GUT + (size_t)5632 * 1024 * 2;
constexpr size_t W_INT = W_DT + (size_t)1024 * 2816 * 2;
constexpr size_t W_GT = W_INT + (size_t)2560 * 1024 * 2;
constexpr size_t W_OUTT = W_GT + (size_t)5120 * 256 * 2;
constexpr size_t W_MGUT = W_OUTT + (size_t)1024 * 1280 * 2;
constexpr size_t W_MDT = W_MGUT + (size_t)8 * 7168 * 1024 * 2;
constexpr size_t W_END = W_MDT + (size_t)8 * 1024 * 3584 * 2;
constexpr size_t WS_R = 217 * MiB;
static_assert(W_END <= WS_R, "weights overflow");
constexpr size_t R_HB = WS_R;
constexpr size_t R_HID = WS_R + 72 * MiB;
constexpr size_t R_GU2 = WS_R;
constexpr size_t R_UC = WS_R + 180 * MiB;
constexpr size_t R_LAF = WS_R + 270 * MiB;
constexpr size_t R_BF = R_LAF + 90 * MiB, R_LAR = R_LAF + 180 * MiB, R_BR = R_LAF + 270 * MiB;
constexpr size_t R_H3 = R_LAF;
constexpr size_t R_HP = WS_R;
constexpr size_t R_MH = WS_R + 132 * MiB;
constexpr size_t R_H4 = WS_R + 200 * MiB;
constexpr size_t WS_NEED = WS_R + 630 * MiB;
static_assert(R_MH + (size_t)NSLOT * DE * 2 <= WS_NEED, "MH overflow");
static_assert(WS_NEED <= (size_t)896 * MiB, "workspace");

__device__ __forceinline__ unsigned cvt_pk_bf16(float lo, float hi) { unsigned r; asm volatile("v_cvt_pk_bf16_f32 %0, %1, %2" : "=v"(r) : "v"(lo), "v"(hi)); return r; }
__device__ __forceinline__ float bf_lo(unsigned u) { return __uint_as_float(u << 16); }
__device__ __forceinline__ float bf_hi(unsigned u) { return __uint_as_float(u & 0xffff0000u); }
__device__ __forceinline__ float wave_sum(float v) {
#pragma unroll
    for (int o = 1; o < 64; o <<= 1) v += __shfl_xor(v, o);
    return v;
}
__device__ __forceinline__ float fast_exp(float x) { return __builtin_amdgcn_exp2f(x * 1.44269504089f); }
__device__ __forceinline__ float sigmoidf_(float x) { return __builtin_amdgcn_rcpf(1.0f + fast_exp(-x)); }
__device__ __forceinline__ float siluf_(float x) { return x * sigmoidf_(x); }
__device__ __forceinline__ float gelu_tanh(float x) {
    const float u = 0.7978845608f * (x + 0.044715f * x * x * x);
    const float t = 1.0f - 2.0f * __builtin_amdgcn_rcpf(fast_exp(2.0f * u) + 1.0f);
    return 0.5f * x * (1.0f + t);
}

namespace pg8 {
constexpr int BM = 256, BK = 64, HALF = 128, HTB = HALF * BK * 2, STAGE_BYTES = 8 * HTB, NXCD = 8, WGM = 8;
__device__ __forceinline__ int lds_byte(int r, int c) { const int st = (r >> 4) * 2 + (c >> 5), rr = r & 15, cc = c & 31, ob = rr * 64 + cc * 2; return st * 1024 + (ob ^ (((ob >> 9) & 1) << 5)); }
__device__ __forceinline__ void stage_rc(int b, int& R, int& C) { const int st = b / 1024, sb = b % 1024, swz = sb ^ (((sb >> 9) & 1) << 5); R = (st >> 1) * 16 + swz / 64; C = (st & 1) * 32 + (swz % 64) / 2; }
__device__ __forceinline__ int perm32(int rho) { const int n = rho >> 4, i = rho & 15; return 8 * (i >> 2) + 4 * n + (i & 3); }

struct Unit { int pm, pn; const char* A; const char* B; };

struct Prob {
    const bf16_t* A; const bf16_t* Bt; int nM, nN, K, lda, ldb;
    int grp, kshr;
    const int* tile_e; size_t estride;
    int G, c;
    __device__ __forceinline__ bool next(int i, Unit& u) const {
        const int nwg = nM * nN; const long L = (long)i * G + c; if (L >= nwg) return false;
        int wgid = (int)L; { const int q = nwg / NXCD, r = nwg % NXCD, xcd = wgid % NXCD, off = wgid / NXCD; wgid = (xcd < r ? xcd * (q + 1) : r * (q + 1) + (xcd - r) * q) + off; }
        const int nig = WGM * nN, gid = wgid / nig, fm = gid * WGM, gsz = (nM - fm) < WGM ? (nM - fm) : WGM;
        u.pm = fm + ((wgid % nig) % gsz); u.pn = (wgid % nig) / gsz;
        u.A = (const char*)(A + (size_t)u.pm * BM * lda + (grp ? (size_t)((u.pn >> kshr) * 256) : (size_t)0));
        const bf16_t* b = Bt + (size_t)u.pn * BM * ldb;
        if (tile_e) b += (size_t)tile_e[u.pm] * estride;
        u.B = (const char*)b;
        return true;
    }
};

struct EpiBf16 {
    static constexpr bool PERM = true;
    bf16_t* O; int ldc;
    __device__ __forceinline__ void operator()(const f32x4 (&acc)[2][2][4][2], const Unit& u, int wr, int wc, int fr, int fq) const {
        const int row0 = u.pm * BM + wr * 64 + fr, col0 = u.pn * BM + wc * 32 + 8 * fq;
#pragma unroll
        for (int ai = 0; ai < 2; ++ai)
#pragma unroll
            for (int m = 0; m < 4; ++m) { bf16_t* rowp = O + (size_t)(row0 + ai * HALF + m * 16) * ldc + col0;
#pragma unroll
                for (int bj = 0; bj < 2; ++bj) { const f32x4 v0 = acc[ai][bj][m][0], v1 = acc[ai][bj][m][1];
                    u32x4 w; w.x = cvt_pk_bf16(v0[0], v0[1]); w.y = cvt_pk_bf16(v0[2], v0[3]); w.z = cvt_pk_bf16(v1[0], v1[1]); w.w = cvt_pk_bf16(v1[2], v1[3]);
                    *(u32x4*)(rowp + bj * HALF) = w; } }
    }
};
struct EpiSwiGLU {
    static constexpr bool PERM = true;
    bf16_t* O; int ldc;
    __device__ __forceinline__ void operator()(const f32x4 (&acc)[2][2][4][2], const Unit& u, int wr, int wc, int fr, int fq) const {
        const int row0 = u.pm * BM + wr * 64 + fr, col0 = u.pn * HALF + wc * 32 + 8 * fq;
#pragma unroll
        for (int ai = 0; ai < 2; ++ai)
#pragma unroll
            for (int m = 0; m < 4; ++m) { bf16_t* rowp = O + (size_t)(row0 + ai * HALF + m * 16) * ldc + col0;
                float v[8];
#pragma unroll
                for (int n = 0; n < 2; ++n)
#pragma unroll
                    for (int j = 0; j < 4; ++j) v[n * 4 + j] = siluf_(acc[ai][0][m][n][j]) * acc[ai][1][m][n][j];
                u32x4 w; w.x = cvt_pk_bf16(v[0], v[1]); w.y = cvt_pk_bf16(v[2], v[3]); w.z = cvt_pk_bf16(v[4], v[5]); w.w = cvt_pk_bf16(v[6], v[7]);
                *(u32x4*)rowp = w; }
    }
};
struct EpiResid {
    static constexpr bool PERM = false;
    const float* xb; float* xo; const float* zb; float* zo; const float* gate  ; const float* colscale;
    __device__ __forceinline__ void operator()(const f32x4 (&acc)[2][2][4][2], const Unit& u, int wr, int wc, int fr, int fq) const {
        const bool isx = u.pm < NX / BM; const int b = isx ? (u.pm >> 3) : NB;
        const float* base = isx ? xb + (size_t)u.pm * BM * D : zb + (size_t)(u.pm - NX / BM) * BM * D;
        float* out = isx ? xo + (size_t)u.pm * BM * D : zo + (size_t)(u.pm - NX / BM) * BM * D;
        const int col0 = u.pn * BM + wc * 32 + 4 * fq;
        f32x4 gv[2][2];
#pragma unroll
        for (int bj = 0; bj < 2; ++bj)
#pragma unroll
            for (int n = 0; n < 2; ++n) { const int col = col0 + bj * HALF + n * 16; gv[bj][n] = *(const f32x4*)(gate + (size_t)b * 6144 + col); if (colscale) gv[bj][n] = gv[bj][n] * *(const f32x4*)(colscale + col); }
#pragma unroll
        for (int ai = 0; ai < 2; ++ai)
#pragma unroll
            for (int m = 0; m < 4; ++m) { const size_t off = (size_t)(ai * HALF + wr * 64 + m * 16 + fr) * D + col0;
#pragma unroll
                for (int bj = 0; bj < 2; ++bj)
#pragma unroll
                    for (int n = 0; n < 2; ++n) { const f32x4 bs = *(const f32x4*)(base + off + bj * HALF + n * 16);
                        *(f32x4*)(out + off + bj * HALF + n * 16) = bs + gv[bj][n] * acc[ai][bj][m][n]; } }
    }
};
struct EpiGate {
    static constexpr bool PERM = true;
    const bf16_t* UC; bf16_t* LA0; bf16_t* B0; size_t dstride  ; const float* b_r; const float* b_i; const float* lam;
    __device__ __forceinline__ void operator()(const f32x4 (&acc)[2][2][4][2], const Unit& u, int wr, int wc, int fr, int fq) const {
        const int head = u.pn >> 1, dir = u.pn & 1;
        const int row0 = u.pm * BM + wr * 64 + fr, ch0 = head * 128 + wc * 32 + 8 * fq;
        float br[8], bi[8], sp[8];
#pragma unroll
        for (int j = 0; j < 8; ++j) { br[j] = b_r[dir * DR + ch0 + j]; bi[j] = b_i[dir * DR + ch0 + j]; const float l = lam[dir * DR + ch0 + j]; sp[j] = -8.0f * log1pf(__expf(-l)); }
        bf16_t* LA = LA0 + (size_t)dir * dstride; bf16_t* BB = B0 + (size_t)dir * dstride;
#pragma unroll
        for (int ai = 0; ai < 2; ++ai)
#pragma unroll
            for (int m = 0; m < 4; ++m) { const size_t off = (size_t)(row0 + ai * HALF + m * 16) * DR + ch0;
                const u32x4 uw = *(const u32x4*)(UC + off);
                float uv[8] = {bf_lo(uw.x), bf_hi(uw.x), bf_lo(uw.y), bf_hi(uw.y), bf_lo(uw.z), bf_hi(uw.z), bf_lo(uw.w), bf_hi(uw.w)};
                float la[8], bb[8];
#pragma unroll
                for (int n = 0; n < 2; ++n)
#pragma unroll
                    for (int j = 0; j < 4; ++j) { const int q = n * 4 + j;
                        const float r = sigmoidf_(acc[ai][0][m][n][j] + br[q]), ig = sigmoidf_(acc[ai][1][m][n][j] + bi[q]);
                        const float l = r * sp[q]; la[q] = l;
                        const float y = 2.0f * l;
                        const float em = (y > -0.3f) ? -y * (1.0f + y * 0.5f * (1.0f + y * (1.0f / 3.0f) * (1.0f + y * 0.25f * (1.0f + y * 0.2f)))) : 1.0f - fast_exp(y);
                        bb[q] = sqrtf(em) * ig * uv[q]; }
                u32x4 w; w.x = cvt_pk_bf16(la[0], la[1]); w.y = cvt_pk_bf16(la[2], la[3]); w.z = cvt_pk_bf16(la[4], la[5]); w.w = cvt_pk_bf16(la[6], la[7]);
                *(u32x4*)(LA + off) = w;
                w.x = cvt_pk_bf16(bb[0], bb[1]); w.y = cvt_pk_bf16(bb[2], bb[3]); w.z = cvt_pk_bf16(bb[4], bb[5]); w.w = cvt_pk_bf16(bb[6], bb[7]);
                *(u32x4*)(BB + off) = w; }
    }
};

template <class Epi>
__device__ __forceinline__ void gemm_phase(LAS unsigned char* lds, const Prob& S, const Epi& E) {
    const int tid = threadIdx.x, wid = __builtin_amdgcn_readfirstlane(tid >> 6), lane = tid & 63, wr = wid >> 2, wc = wid & 3, fr = lane & 15, fq = lane >> 4;
    const int K = S.K, nt = K / BK;
    unsigned voffA[2], voffB[2];
#pragma unroll
    for (int i = 0; i < 2; ++i) { int R, C; stage_rc(tid * 16 + i * 8192, R, C); const int Rb = Epi::PERM ? ((R & ~31) + perm32(R & 31)) : R;
        voffA[i] = (unsigned)(R * S.lda + C) * 2u; voffB[i] = (unsigned)(Rb * S.ldb + C) * 2u; }
    const size_t kstep = (size_t)(BK * 2);
    const size_t hstepA = (size_t)HALF * S.lda * 2, hstepB = (size_t)HALF * S.ldb * 2;
    const unsigned ldsw = (unsigned)wid * 1024u;
    const int aoff = lds_byte(wr * 64 + fr, fq * 8), boff = lds_byte(wc * 32 + fr, fq * 8);
#define PG8_SA(b, h) (((b) * 2 + (h)) * HTB)
#define PG8_SB(b, h) ((4 + (b) * 2 + (h)) * HTB)
#define PG8_STAGE(bufoff, gbase, voff) do { _Pragma("unroll") for (int _i = 0; _i < 2; ++_i) \
        __builtin_amdgcn_global_load_lds((const unsigned*)((const char*)(gbase) + (voff)[_i]), (LAS unsigned*)(lds + (bufoff) + ldsw + _i * 8192), 16, 0, 0); } while (0)
#define PG8_LDA(dst, b, h) do { _Pragma("unroll") for (int m = 0; m < 4; ++m) _Pragma("unroll") for (int k = 0; k < 2; ++k) dst[m][k] = *(const LAS bf16x8*)(lds + PG8_SA(b, h) + aoff + m * 2048 + k * 1024); } while (0)
#define PG8_LDB(dst, b, h) do { _Pragma("unroll") for (int n = 0; n < 2; ++n) _Pragma("unroll") for (int k = 0; k < 2; ++k) dst[n][k] = *(const LAS bf16x8*)(lds + PG8_SB(b, h) + boff + n * 2048 + k * 1024); } while (0)
#define PG8_MMA(ai, bj, At, Bt) do { __builtin_amdgcn_s_setprio(1); _Pragma("unroll") for (int m = 0; m < 4; ++m) _Pragma("unroll") for (int n = 0; n < 2; ++n) _Pragma("unroll") for (int k = 0; k < 2; ++k) \
        acc[ai][bj][m][n] = __builtin_amdgcn_mfma_f32_16x16x32_bf16(Bt[n][k], At[m][k], acc[ai][bj][m][n], 0, 0, 0); __builtin_amdgcn_s_setprio(0); } while (0)
#define PG8_WAIT_V(n) asm volatile("s_waitcnt vmcnt(" #n ")" ::: "memory")
#define PG8_WAIT_L(n) asm volatile("s_waitcnt lgkmcnt(" #n ")" ::: "memory")
#define PG8_BAR __builtin_amdgcn_s_barrier()
#define PG8_SCHED __builtin_amdgcn_sched_barrier(0)
    Unit cur, nxt; int ui = 0;
    if (!S.next(0, cur)) return;
    f32x4 acc[2][2][4][2];
#pragma unroll
    for (int a = 0; a < 2; ++a)
#pragma unroll
        for (int b = 0; b < 2; ++b)
#pragma unroll
            for (int m = 0; m < 4; ++m)
#pragma unroll
                for (int n = 0; n < 2; ++n) acc[a][b][m][n] = (f32x4){0.f, 0.f, 0.f, 0.f};
    bf16x8 At[4][2], B0[2][2], B1[2][2];
    const char* cA = cur.A; const char* cB = cur.B;
    PG8_STAGE(PG8_SB(0, 0), cB, voffB); PG8_STAGE(PG8_SB(0, 1), cB + hstepB, voffB); PG8_STAGE(PG8_SA(0, 0), cA, voffA); PG8_STAGE(PG8_SA(0, 1), cA + hstepA, voffA);
    if (wr == 1) PG8_BAR;
    PG8_WAIT_V(2); PG8_BAR;
    PG8_STAGE(PG8_SB(1, 0), cB + kstep, voffB); PG8_STAGE(PG8_SA(1, 0), cA + kstep, voffA); PG8_STAGE(PG8_SB(1, 1), cB + hstepB + kstep, voffB);
    PG8_WAIT_V(6); PG8_BAR;
    for (;;) {
        const bool has_next = S.next(ui + 1, nxt);
        const char* nA = has_next ? nxt.A : cA; const char* nB = has_next ? nxt.B : cB;
        for (int t = 0; t < nt; t += 2) {
            const bool last = (t == nt - 2);
            const char* a1 = cA + (size_t)(t + 1) * kstep;
            const char* a2 = last ? nA : cA + (size_t)(t + 2) * kstep; const char* b2 = last ? nB : cB + (size_t)(t + 2) * kstep;
            const char* a3 = a2 + kstep; const char* b3 = b2 + kstep;
            PG8_LDB(B0, 0, 0); PG8_LDB(B1, 0, 1); PG8_SCHED; PG8_LDA(At, 0, 0); PG8_STAGE(PG8_SA(1, 1), a1 + hstepA, voffA);
            PG8_WAIT_V(8); PG8_WAIT_L(0); PG8_BAR; PG8_MMA(0, 0, At, B0); PG8_MMA(0, 1, At, B1); PG8_BAR; PG8_SCHED;
            PG8_LDA(At, 0, 1); PG8_STAGE(PG8_SB(0, 0), b2, voffB); PG8_STAGE(PG8_SB(0, 1), b2 + hstepB, voffB); PG8_STAGE(PG8_SA(0, 0), a2, voffA);
            PG8_WAIT_V(8); PG8_WAIT_L(0); PG8_BAR; PG8_MMA(1, 0, At, B0); PG8_MMA(1, 1, At, B1); PG8_BAR; PG8_SCHED;
            PG8_LDB(B0, 1, 0); PG8_LDB(B1, 1, 1); PG8_SCHED; PG8_LDA(At, 1, 0); PG8_STAGE(PG8_SA(0, 1), a2 + hstepA, voffA);
            PG8_WAIT_V(8); PG8_WAIT_L(0); PG8_BAR; PG8_MMA(0, 0, At, B0); PG8_MMA(0, 1, At, B1); PG8_BAR; PG8_SCHED;
            PG8_LDA(At, 1, 1); PG8_STAGE(PG8_SB(1, 0), b3, voffB); PG8_STAGE(PG8_SB(1, 1), b3 + hstepB, voffB); PG8_STAGE(PG8_SA(1, 0), a3, voffA);
            PG8_WAIT_V(8); PG8_WAIT_L(0); PG8_BAR; PG8_MMA(1, 0, At, B0); PG8_MMA(1, 1, At, B1); PG8_BAR; PG8_SCHED;
        }
        if (wr == 0) PG8_BAR;
        E(acc, cur, wr, wc, fr, fq);
        if (!has_next) break;
#pragma unroll
        for (int a = 0; a < 2; ++a)
#pragma unroll
            for (int b = 0; b < 2; ++b)
#pragma unroll
                for (int m = 0; m < 4; ++m)
#pragma unroll
                    for (int n = 0; n < 2; ++n) acc[a][b][m][n] = (f32x4){0.f, 0.f, 0.f, 0.f};
        cur = nxt; cA = nA; cB = nB; ++ui;
        if (wr == 1) PG8_BAR;
    }
    PG8_WAIT_V(0);
    PG8_BAR;
#undef PG8_SA
#undef PG8_SB
#undef PG8_STAGE
#undef PG8_LDA
#undef PG8_LDB
#undef PG8_MMA
#undef PG8_WAIT_V
#undef PG8_WAIT_L
#undef PG8_BAR
#undef PG8_SCHED
}
}

struct Args {
    const float* in[25]; float* out; unsigned char* ws; int ph_lo, ph_hi;
};

struct Ctx { LAS unsigned char* lds; int tid, lane, wave, gw, NGW, G; };

__device__ __forceinline__ void tr_item(const float* W, int ldw, int scol0, int k0, bf16_t* WT, int ldt, int drow0, int dk0, LAS float* scr, int lane) {
#pragma unroll 8
    for (int i = 0; i < 32; ++i) { const int kk = 2 * i + (lane >> 5); scr[kk * 33 + (lane & 31)] = W[(size_t)(k0 + kk) * ldw + scol0 + (lane & 31)]; }
    asm volatile("s_waitcnt lgkmcnt(0)" ::: "memory");
    const int c = lane & 7;
#pragma unroll
    for (int j = 0; j < 4; ++j) { const int n = (lane >> 3) + 8 * j; const LAS float* s = scr + (8 * c) * 33 + n;
        u32x4 o; o.x = cvt_pk_bf16(s[0 * 33], s[1 * 33]); o.y = cvt_pk_bf16(s[2 * 33], s[3 * 33]); o.z = cvt_pk_bf16(s[4 * 33], s[5 * 33]); o.w = cvt_pk_bf16(s[6 * 33], s[7 * 33]);
        *(u32x4*)(WT + (size_t)(drow0 + n) * ldt + dk0 + k0 + 8 * c) = o; }
    asm volatile("s_waitcnt lgkmcnt(0)" ::: "memory");
}
__device__ __forceinline__ int gu_src_col(int nrow, int H) { return ((nrow & 255) >> 7) * H + (nrow >> 8) * 128 + (nrow & 127); }

__device__ __forceinline__ void p0_convert(const Args& a, const Ctx& c) {
    unsigned char* ws = a.ws;
    LAS float* scr = (LAS float*)(c.lds + c.wave * 16384);
    constexpr int I_POOL = 4 * (256 / 64) * (256 / 32);
    constexpr int I_GU = (D / 64) * (2 * DFF / 32);
    constexpr int I_DN = (DFF / 64) * (D / 32);
    constexpr int I_IN = (D / 64) * (2 * DR / 32);
    constexpr int I_GT = 40 * 2 * 4;
    constexpr int I_OUT = (DR / 64) * (D / 32);
    constexpr int I_MGU1 = (D / 64) * (2 * DE / 32);
    constexpr int I_MDN1 = (DE / 64) * (D / 32);
    constexpr int NITEMS = I_POOL + I_GU + I_DN + I_IN + I_GT + I_OUT + NE * I_MGU1 + NE * I_MDN1;
    for (int it = c.gw; it < NITEMS; it += c.NGW) {
        int r = it;
        if (r < I_POOL) { const int g = r / 32, q = r % 32, kb = q / 8, nb = q % 8;
            tr_item(a.in[8] + (size_t)g * 65536, 256, 32 * nb, 64 * kb, (bf16_t*)(ws + W_POOLT), 256, g * 256 + 32 * nb, 0, scr, c.lane); continue; } r -= I_POOL;
        if (r < I_GU) { const int nblk = 2 * DFF / 32, kb = r / nblk, nb = r % nblk;
            tr_item(a.in[10], 2 * DFF, gu_src_col(32 * nb, DFF), 64 * kb, (bf16_t*)(ws + W_GUT), D, 32 * nb, 0, scr, c.lane); continue; } r -= I_GU;
        if (r < I_DN) { const int nblk = D / 32, kb = r / nblk, nb = r % nblk;
            tr_item(a.in[11], D, 32 * nb, 64 * kb, (bf16_t*)(ws + W_DT), DFF, 32 * nb, 0, scr, c.lane); continue; } r -= I_DN;
        if (r < I_IN) { const int nblk = 2 * DR / 32, kb = r / nblk, nb = r % nblk;
            tr_item(a.in[12], 2 * DR, 32 * nb, 64 * kb, (bf16_t*)(ws + W_INT), D, 32 * nb, 0, scr, c.lane); continue; } r -= I_IN;
        if (r < I_GT) { const int mat = r / 8, q = r % 8, kb = q / 4, nb = q % 4; const int which = mat / 20, dh = mat % 20, dir = dh / 10, head = dh % 10;
            const float* W = (which ? a.in[17] : a.in[15]) + (size_t)(dir * 10 + head) * 16384;
            tr_item(W, 128, 32 * nb, 64 * kb, (bf16_t*)(ws + W_GT), 256, (head * 2 + dir) * 256 + which * 128 + 32 * nb, (head & 1) * 128, scr, c.lane); continue; } r -= I_GT;
        if (r < I_OUT) { const int nblk = D / 32, kb = r / nblk, nb = r % nblk;
            tr_item(a.in[20], D, 32 * nb, 64 * kb, (bf16_t*)(ws + W_OUTT), DR, 32 * nb, 0, scr, c.lane); continue; } r -= I_OUT;
        if (r < NE * I_MGU1) { const int e = r / I_MGU1, q = r % I_MGU1, nblk = 2 * DE / 32, kb = q / nblk, nb = q % nblk;
            tr_item(a.in[22] + (size_t)e * D * 2 * DE, 2 * DE, gu_src_col(32 * nb, DE), 64 * kb, (bf16_t*)(ws + W_MGUT) + (size_t)e * 2 * DE * D, D, 32 * nb, 0, scr, c.lane); continue; } r -= NE * I_MGU1;
        { const int e = r / I_MDN1, q = r % I_MDN1, nblk = D / 32, kb = q / nblk, nb = q % nblk;
            tr_item(a.in[23] + (size_t)e * DE * D, D, 32 * nb, 64 * kb, (bf16_t*)(ws + W_MDT) + (size_t)e * D * DE, DE, 32 * nb, 0, scr, c.lane); }
    }
    { bf16_t* GT = (bf16_t*)(ws + W_GT);
      for (int i = c.gw * 64 + c.lane; i < 5120 * 16; i += c.NGW * 64) { const int R = i >> 4, q = i & 15, head = R >> 9;
          *(u32x4*)(GT + (size_t)R * 256 + (1 - (head & 1)) * 128 + q * 8) = (u32x4){0u, 0u, 0u, 0u}; } }
}

__device__ __forceinline__ void p0_adaln(const Args& a, const Ctx& c) {
    if ((int)blockIdx.x >= 192) return;
    const int layer = blockIdx.x / 96, col0 = (blockIdx.x % 96) * 64;
    LAS float* s = (LAS float*)c.lds;
    LAS float* red = (LAS float*)(c.lds + 17 * 1024 * 4);
    for (int i = c.tid; i < 17 * 1024; i += NTHREADS) { const int b = i >> 10, k = i & 1023; const float v = b < NB ? a.in[1][b * D + k] : a.in[3][k]; s[i] = v / (1.0f + __expf(-v)); }
    __syncthreads();
    const float* W = a.in[4] + (size_t)layer * D * 6 * D + col0 + c.lane;
    float acc[17];
#pragma unroll
    for (int b = 0; b < 17; ++b) acc[b] = 0.f;
    const int k0 = c.wave * 128;
#pragma unroll 4
    for (int k = 0; k < 128; ++k) { const float w = W[(size_t)(k0 + k) * 6 * D];
#pragma unroll
        for (int b = 0; b < 17; ++b) acc[b] += s[b * 1024 + k0 + k] * w; }
#pragma unroll
    for (int b = 0; b < 17; ++b) red[(c.wave * 17 + b) * 64 + c.lane] = acc[b];
    __syncthreads();
    float* mod = (float*)(a.ws + WS_MOD) + (size_t)layer * 17 * 6144;
    for (int i = c.tid; i < 17 * 64; i += NTHREADS) { const int b = i >> 6, l = i & 63; float v = a.in[5][layer * 6 * D + col0 + l];
#pragma unroll
        for (int w = 0; w < 8; ++w) v += red[(w * 17 + b) * 64 + l];
        mod[b * 6144 + col0 + l] = v; }
    __syncthreads();
}

template <int W>
__device__ __forceinline__ void pool_cols(const float* src  , LAS const float* rs, int t0, int L, float g0, float g1, float b0, float b1, bf16_t* dst  ) {
    float r0[16], r1[16]; float S0 = 0.f, S1 = 0.f;
#pragma unroll
    for (int s = 8 - W / 2; s < 72 + W / 2 - 1; ++s) {
        const int t = t0 - 8 + s; float v0 = 0.f, v1 = 0.f;
        if (t >= 0 && t < L) { const f32x2 xv = *(const f32x2*)(src + (size_t)s * D); const float r = rs[s]; v0 = xv.x * r * g0 + b0; v1 = xv.y * r * g1 + b1; }
        r0[s & 15] = v0; r1[s & 15] = v1; S0 += v0; S1 += v1;
        const int p = s - W / 2 + 1;
        if (p >= 8 && p < 72) { const int tp = t0 - 8 + p; const int lo = max(tp - W / 2, 0), hi = min(tp - W / 2 + W, L); const float inv = 1.0f / (float)(hi - lo);
            *(unsigned*)(dst + (size_t)(p - 8) * D) = cvt_pk_bf16(S0 * inv - r0[p & 15], S1 * inv - r1[p & 15]); }
        if (s - W + 1 >= 8 - W / 2) { S0 -= r0[(s - W + 1) & 15]; S1 -= r1[(s - W + 1) & 15]; }
    }
}
__device__ __forceinline__ void p1_pool_prep(const Args& a, const Ctx& c) {
    LAS float* rs = (LAS float*)c.lds;
    const float* g1 = a.in[6];
    const float* mod0 = (const float*)(a.ws + WS_MOD);
    bf16_t* AP = (bf16_t*)(a.ws + R_HB);
    for (int tile = blockIdx.x; tile < 576; tile += c.G) {
        const bool isx = tile < 512; const int L = isx ? 64 : 256;
        const int t0 = isx ? 0 : ((tile - 512) & 3) * 64;
        const float* seq = isx ? a.in[0] + (size_t)tile * 64 * D : a.in[2] + (size_t)((tile - 512) >> 2) * CL * D;
        const int b = isx ? (tile >> 5) : NB;
        const size_t orow0 = isx ? (size_t)tile * 64 : (size_t)NX + (size_t)((tile - 512) >> 2) * CL + t0;
        __syncthreads();
        for (int s = c.wave; s < 80; s += NWAVES) { const int t = t0 - 8 + s;
            if (t >= 0 && t < L) { const f32x4* xr = (const f32x4*)(seq + (size_t)t * D) + c.lane; float ss = 0.f;
#pragma unroll
                for (int j = 0; j < 4; ++j) { const f32x4 v = xr[64 * j]; ss += (v.x * v.x + v.y * v.y) + (v.z * v.z + v.w * v.w); }
                ss = wave_sum(ss); if (c.lane == 0) rs[s] = rsqrtf(ss * (1.0f / D) + EPS); } }
        __syncthreads();
        const int col = 2 * c.tid;
        const f32x2 gg = *(const f32x2*)(g1 + col), sc = *(const f32x2*)(mod0 + (size_t)b * 6144 + 1024 + col), sh = *(const f32x2*)(mod0 + (size_t)b * 6144 + col);
        const float ga = gg.x * (1.0f + sc.x), gb = gg.y * (1.0f + sc.y);
        const float* src = seq + (ptrdiff_t)(t0 - 8) * D + col; bf16_t* dst = AP + (orow0) * D + col;
        const int grp = __builtin_amdgcn_readfirstlane(col >> 8);
        if (grp == 0) pool_cols<2>(src, rs, t0, L, ga, gb, sh.x, sh.y, dst);
        else if (grp == 1) pool_cols<4>(src, rs, t0, L, ga, gb, sh.x, sh.y, dst);
        else if (grp == 2) pool_cols<8>(src, rs, t0, L, ga, gb, sh.x, sh.y, dst);
        else pool_cols<16>(src, rs, t0, L, ga, gb, sh.x, sh.y, dst);
    }
}

__device__ __forceinline__ void norm_mod_rows(const float* X, const float* Z, int nrows, const float* gvec, const float* modl, int sh_off, int sc_off, bf16_t* out, const Ctx& c) {
    for (int row = c.gw; row < nrows; row += c.NGW) {
        const float* src = row < NX ? X + (size_t)row * D : Z + (size_t)(row - NX) * D; const int b = row < NX ? row / SEQ : NB;
        const f32x4* xr = (const f32x4*)src + c.lane; f32x4 v[4]; float ss = 0.f;
#pragma unroll
        for (int j = 0; j < 4; ++j) { v[j] = xr[64 * j]; ss += (v[j].x * v[j].x + v[j].y * v[j].y) + (v[j].z * v[j].z + v[j].w * v[j].w); }
        const float rstd = rsqrtf(wave_sum(ss) * (1.0f / D) + EPS);
        const float* mb = modl + (size_t)b * 6144;
#pragma unroll
        for (int j = 0; j < 4; ++j) { const int col = 4 * (c.lane + 64 * j);
            const f32x4 g = *(const f32x4*)(gvec + col), sc = *(const f32x4*)(mb + sc_off + col), sh = *(const f32x4*)(mb + sh_off + col);
            const f32x4 h = v[j] * rstd * g * (sc + 1.0f) + sh;
            u32x2 w; w.x = cvt_pk_bf16(h.x, h.y); w.y = cvt_pk_bf16(h.z, h.w);
            *(u32x2*)(out + (size_t)row * D + col) = w; }
    }
}

__device__ __forceinline__ void p8_conv(const Args& a, const Ctx& c) {
    const bf16_t* GU2 = (const bf16_t*)(a.ws + R_GU2); bf16_t* UC = (bf16_t*)(a.ws + R_UC);
    const float* cw = a.in[13]; const float* cb = a.in[14];
    const int total = NT * 160;
    for (int idx = blockIdx.x * NTHREADS + c.tid; idx < total; idx += c.G * NTHREADS) {
        const int row = idx / 160, ch = (idx % 160) * 8;
        int t, L; if (row < NX) { t = row % SEQ; L = SEQ; } else { t = (row - NX) % CL; L = CL; }
        float acc[8];
#pragma unroll
        for (int j = 0; j < 8; ++j) acc[j] = cb[ch + j];
#pragma unroll
        for (int k = 0; k < 4; ++k) { const int tt = t + k - 2;
            if (tt >= 0 && tt < L) { const u32x4 uw = *(const u32x4*)(GU2 + (size_t)(row + k - 2) * (2 * DR) + DR + ch);
                const f32x4 w0 = *(const f32x4*)(cw + k * DR + ch), w1 = *(const f32x4*)(cw + k * DR + ch + 4);
                acc[0] += w0.x * bf_lo(uw.x); acc[1] += w0.y * bf_hi(uw.x); acc[2] += w0.z * bf_lo(uw.y); acc[3] += w0.w * bf_hi(uw.y);
                acc[4] += w1.x * bf_lo(uw.z); acc[5] += w1.y * bf_hi(uw.z); acc[6] += w1.z * bf_lo(uw.w); acc[7] += w1.w * bf_hi(uw.w); } }
        u32x4 w; w.x = cvt_pk_bf16(acc[0], acc[1]); w.y = cvt_pk_bf16(acc[2], acc[3]); w.z = cvt_pk_bf16(acc[4], acc[5]); w.w = cvt_pk_bf16(acc[6], acc[7]);
        *(u32x4*)(UC + (size_t)row * DR + ch) = w;
    }
}

__device__ __forceinline__ void p10a_chunk_sums(const Args& a, const Ctx& c) {
    float* CA = (float*)(a.ws + WS_CHUNK); float* CB = CA + 2 * 144 * DR;
    for (int wi = c.gw; wi < 144 * 2 * 10; wi += c.NGW) {
        const int chunk = wi / 20, dir = (wi % 20) / 10, cp = (wi % 10) * 64 + c.lane;
        const size_t row0 = chunk < 128 ? (size_t)chunk * 256 : (size_t)NX + (size_t)(chunk - 128) * 256;
        const unsigned* LA = (const unsigned*)(a.ws + (dir ? R_LAR : R_LAF)) + row0 * (DR / 2) + cp;
        const unsigned* BB = (const unsigned*)(a.ws + (dir ? R_BR : R_BF)) + row0 * (DR / 2) + cp;
        float s0 = 0.f, s1 = 0.f, h0 = 0.f, h1 = 0.f;
#pragma unroll 8
        for (int i = 0; i < 256; ++i) { const int t = dir ? 255 - i : i;
            const unsigned la = LA[(size_t)t * (DR / 2)], bb = BB[(size_t)t * (DR / 2)];
            const float l0 = bf_lo(la), l1 = bf_hi(la); s0 += l0; s1 += l1;
            h0 = fast_exp(l0) * h0 + bf_lo(bb); h1 = fast_exp(l1) * h1 + bf_hi(bb); }
        const size_t o = ((size_t)dir * 144 + chunk) * DR + 2 * cp;
        *(f32x2*)(CA + o) = (f32x2){fast_exp(s0), fast_exp(s1)}; *(f32x2*)(CB + o) = (f32x2){h0, h1};
    }
}
__device__ __forceinline__ void p10c_scan(const Args& a, const Ctx& c) {
    const float* CA = (const float*)(a.ws + WS_CHUNK); const float* CB = CA + 2 * 144 * DR;
    for (int wi = c.gw; wi < 128 * 10; wi += c.NGW) {
        const int chunk = wi / 10, cp = (wi % 10) * 64 + c.lane, b = chunk >> 3, cj = chunk & 7;
        f32x2 hf = *(const f32x2*)(CB + ((size_t)0 * 144 + 128 + b) * DR + 2 * cp);
        for (int j = 0; j < cj; ++j) { const size_t o = ((size_t)0 * 144 + b * 8 + j) * DR + 2 * cp; hf = *(const f32x2*)(CA + o) * hf + *(const f32x2*)(CB + o); }
        f32x2 hr = *(const f32x2*)(CB + ((size_t)1 * 144 + 128 + b) * DR + 2 * cp);
        for (int j = 7; j > cj; --j) { const size_t o = ((size_t)1 * 144 + b * 8 + j) * DR + 2 * cp; hr = *(const f32x2*)(CA + o) * hr + *(const f32x2*)(CB + o); }
        const size_t row0 = (size_t)chunk * 256;
        const unsigned* LAF = (const unsigned*)(a.ws + R_LAF) + row0 * (DR / 2) + cp; unsigned* BF = (unsigned*)(a.ws + R_BF) + row0 * (DR / 2) + cp;
        const unsigned* LAR = (const unsigned*)(a.ws + R_LAR) + row0 * (DR / 2) + cp; unsigned* BR = (unsigned*)(a.ws + R_BR) + row0 * (DR / 2) + cp;
        const unsigned* GT = (const unsigned*)(a.ws + R_GU2) + row0 * DR + cp;
        float h0 = hf.x, h1 = hf.y;
#pragma unroll 8
        for (int t = 0; t < 256; ++t) { const unsigned la = LAF[(size_t)t * (DR / 2)], bb = BF[(size_t)t * (DR / 2)];
            h0 = fast_exp(bf_lo(la)) * h0 + bf_lo(bb); h1 = fast_exp(bf_hi(la)) * h1 + bf_hi(bb);
            BF[(size_t)t * (DR / 2)] = cvt_pk_bf16(h0, h1); }
        h0 = hr.x; h1 = hr.y;
#pragma unroll 8
        for (int i = 0; i < 256; ++i) { const int t = 255 - i; const unsigned la = LAR[(size_t)t * (DR / 2)], bb = BR[(size_t)t * (DR / 2)], fw = BF[(size_t)t * (DR / 2)], gt = GT[(size_t)t * DR];
            h0 = fast_exp(bf_lo(la)) * h0 + bf_lo(bb); h1 = fast_exp(bf_hi(la)) * h1 + bf_hi(bb);
            BR[(size_t)t * (DR / 2)] = cvt_pk_bf16((h0 + bf_lo(fw)) * gelu_tanh(bf_lo(gt)), (h1 + bf_hi(fw)) * gelu_tanh(bf_hi(gt))); }
    }
}

__device__ __forceinline__ void p12_route(const Args& a, const Ctx& c) {
    LAS unsigned* lcnt = (LAS unsigned*)c.lds;
    if (c.tid < NE) lcnt[c.tid] = 0u;
    __syncthreads();
    const float* X = a.out; const float* gvec = a.in[7] + D; const float* modl = (const float*)(a.ws + WS_MOD) + (size_t)17 * 6144; const float* WR = a.in[21];
    bf16_t* H4 = (bf16_t*)(a.ws + R_H4);
    int* tok_e = (int*)(a.ws + WS_ROUTE); float* tok_w = (float*)(a.ws + WS_ROUTE + (size_t)NX * 8);
    for (int row = c.gw; row < NX; row += c.NGW) {
        const int b = row / SEQ; const f32x4* xr = (const f32x4*)(X + (size_t)row * D) + c.lane; f32x4 v[4]; float ss = 0.f;
#pragma unroll
        for (int j = 0; j < 4; ++j) { v[j] = xr[64 * j]; ss += (v[j].x * v[j].x + v[j].y * v[j].y) + (v[j].z * v[j].z + v[j].w * v[j].w); }
        const float rstd = rsqrtf(wave_sum(ss) * (1.0f / D) + EPS);
        const float* mb = modl + (size_t)b * 6144;
        float lg[8];
#pragma unroll
        for (int e = 0; e < 8; ++e) lg[e] = 0.f;
#pragma unroll
        for (int j = 0; j < 4; ++j) { const int col = 4 * (c.lane + 64 * j);
            const f32x4 g = *(const f32x4*)(gvec + col), sc = *(const f32x4*)(mb + 4096 + col), sh = *(const f32x4*)(mb + 3072 + col);
            const f32x4 h = v[j] * rstd * g * (sc + 1.0f) + sh;
            u32x2 w; w.x = cvt_pk_bf16(h.x, h.y); w.y = cvt_pk_bf16(h.z, h.w);
            *(u32x2*)(H4 + (size_t)row * D + col) = w;
#pragma unroll
            for (int q = 0; q < 4; ++q) { const f32x4 w0 = *(const f32x4*)(WR + (size_t)(col + q) * 8), w1 = *(const f32x4*)(WR + (size_t)(col + q) * 8 + 4); const float hv = h[q];
                lg[0] += hv * w0.x; lg[1] += hv * w0.y; lg[2] += hv * w0.z; lg[3] += hv * w0.w; lg[4] += hv * w1.x; lg[5] += hv * w1.y; lg[6] += hv * w1.z; lg[7] += hv * w1.w; } }
#pragma unroll
        for (int e = 0; e < 8; ++e) lg[e] = wave_sum(lg[e]);
        int e0 = 0; float l0 = lg[0];
#pragma unroll
        for (int e = 1; e < 8; ++e) if (lg[e] > l0) { l0 = lg[e]; e0 = e; }
        int e1 = -1; float l1 = -3.0e38f;
#pragma unroll
        for (int e = 0; e < 8; ++e) if (e != e0 && lg[e] > l1) { l1 = lg[e]; e1 = e; }
        if (c.lane == 0) { const float w0 = 1.0f / (1.0f + __expf(l1 - l0));
            tok_e[row * 2] = e0; tok_e[row * 2 + 1] = e1; tok_w[row * 2] = w0; tok_w[row * 2 + 1] = 1.0f - w0;
            atomicAdd((unsigned*)&lcnt[e0], 1u); atomicAdd((unsigned*)&lcnt[e1], 1u); }
    }
    __syncthreads();
    if (c.tid < NE) atomicAdd((unsigned*)(a.ws + WS_CTL) + c.tid, lcnt[c.tid]);
}

__device__ __forceinline__ void p13_assign(const Args& a, const Ctx& c) {
    unsigned* ctl = (unsigned*)(a.ws + WS_CTL);
    unsigned cnt[8], pst[8]; unsigned run = 0;
#pragma unroll
    for (int e = 0; e < 8; ++e) { cnt[e] = __hip_atomic_load(ctl + e, __ATOMIC_RELAXED, __HIP_MEMORY_SCOPE_AGENT); pst[e] = run; run += (cnt[e] + 255u) & ~255u; }
    if (blockIdx.x == 0 && c.tid == 0) { int* tile_e = (int*)(a.ws + WS_TILEE);
        for (int e = 0; e < 8; ++e) { const unsigned nt_ = ((cnt[e] + 255u) >> 8); for (unsigned j = 0; j < nt_; ++j) tile_e[(pst[e] >> 8) + j] = e; }
        ctl[16] = run >> 8; }
    const int* tok_e = (const int*)(a.ws + WS_ROUTE); int* tok_slot = (int*)(a.ws + WS_ROUTE + (size_t)NX * 16);
    const bf16_t* H4 = (const bf16_t*)(a.ws + R_H4); bf16_t* HP = (bf16_t*)(a.ws + R_HP);
    for (int ch = c.gw; ch < NX * 2 / 64; ch += c.NGW) {
        const int p = ch * 64 + c.lane; const int e = tok_e[p]; unsigned slot = 0;
#pragma unroll
        for (int q = 0; q < 8; ++q) { const unsigned long long m = __ballot(e == q);
            if (m) { unsigned base = 0; const int leader = __ffsll((long long)m) - 1;
                if (c.lane == leader) base = atomicAdd(ctl + 8 + q, (unsigned)__popcll(m));
                base = __shfl(base, leader);
                if (e == q) slot = pst[q] + base + (unsigned)__popcll(m & ((1ull << c.lane) - 1ull)); } }
        tok_slot[p] = (int)slot;
        for (int i = 0; i < 64; ++i) { const unsigned sl = __shfl(slot, i); const int tok = (ch * 64 + i) >> 1;
            const u32x4* s = (const u32x4*)(H4 + (size_t)tok * D); u32x4* d = (u32x4*)(HP + (size_t)sl * D);
            const u32x4 v0 = s[c.lane], v1 = s[64 + c.lane]; d[c.lane] = v0; d[64 + c.lane] = v1; }
    }
    for (int e = 0; e < 8; ++e) { const unsigned r0 = pst[e] + cnt[e], r1 = pst[e] + ((cnt[e] + 255u) & ~255u);
        for (unsigned r = r0 + c.gw; r < r1; r += c.NGW) { u32x4* d = (u32x4*)(HP + (size_t)r * D); d[c.lane] = (u32x4){0u, 0u, 0u, 0u}; d[64 + c.lane] = (u32x4){0u, 0u, 0u, 0u}; } }
}

__device__ __forceinline__ void p16_final(const Args& a, const Ctx& c) {
    const float* modl = (const float*)(a.ws + WS_MOD) + (size_t)17 * 6144; const float* fg = a.in[24];
    const float* tok_w = (const float*)(a.ws + WS_ROUTE + (size_t)NX * 8); const int* tok_slot = (const int*)(a.ws + WS_ROUTE + (size_t)NX * 16);
    const bf16_t* YS = (const bf16_t*)(a.ws + R_HP);
    for (int row = c.gw; row < NX; row += c.NGW) {
        const int b = row / SEQ; f32x4* xr = (f32x4*)(a.out + (size_t)row * D) + c.lane;
        const float w0 = tok_w[row * 2], w1 = tok_w[row * 2 + 1]; const int s0 = tok_slot[row * 2], s1 = tok_slot[row * 2 + 1];
        const u32x2* y0 = (const u32x2*)(YS + (size_t)s0 * D) + c.lane; const u32x2* y1 = (const u32x2*)(YS + (size_t)s1 * D) + c.lane;
        f32x4 v[4]; float ss = 0.f;
#pragma unroll
        for (int j = 0; j < 4; ++j) { const int col = 4 * (c.lane + 64 * j); const f32x4 g2 = *(const f32x4*)(modl + (size_t)b * 6144 + 5120 + col);
            const u32x2 a0 = y0[64 * j], a1 = y1[64 * j];
            const f32x4 ya = (f32x4){bf_lo(a0.x), bf_hi(a0.x), bf_lo(a0.y), bf_hi(a0.y)}, yb = (f32x4){bf_lo(a1.x), bf_hi(a1.x), bf_lo(a1.y), bf_hi(a1.y)};
            v[j] = xr[64 * j] + g2 * (ya * w0 + yb * w1);
            ss += (v[j].x * v[j].x + v[j].y * v[j].y) + (v[j].z * v[j].z + v[j].w * v[j].w); }
        const float rstd = rsqrtf(wave_sum(ss) * (1.0f / D) + EPS);
#pragma unroll
        for (int j = 0; j < 4; ++j) { const int col = 4 * (c.lane + 64 * j); xr[64 * j] = v[j] * rstd * *(const f32x4*)(fg + col); }
    }
}

__global__ void __launch_bounds__(NTHREADS, 2) trunk_fwd(Args a) {
    extern __shared__ __attribute__((aligned(16))) unsigned char lds_raw[];
    Ctx c; c.lds = (LAS unsigned char*)lds_raw; c.tid = threadIdx.x; c.lane = c.tid & 63; c.wave = __builtin_amdgcn_readfirstlane(c.tid >> 6);
    c.G = gridDim.x; c.gw = blockIdx.x * NWAVES + c.wave; c.NGW = c.G * NWAVES;
    unsigned char* ws = a.ws;
    const float* mod0 = (const float*)(ws + WS_MOD); const float* mod1 = mod0 + (size_t)17 * 6144;
    float* ZR = (float*)(ws + WS_ZRES);
    const int lo = a.ph_lo, hi = a.ph_hi;
#define IN(k) (lo <= (k) && (k) < hi)
#define SEAM(k) do { if (IN(k) && IN((k) + 1)) { cg::this_grid().sync(); } } while (0)

    if (IN(0)) { p0_adaln(a, c); p0_convert(a, c); } SEAM(0);
    if (IN(1)) { p1_pool_prep(a, c); } SEAM(1);
    if (IN(2)) {
        pg8::Prob P{(const bf16_t*)(ws + R_HB), (const bf16_t*)(ws + W_POOLT), NT / 256, 4, 256, D, 256, 1, 0, nullptr, 0, c.G, (int)blockIdx.x};
        pg8::EpiResid E{a.in[0], a.out, a.in[2], ZR, mod0 + 2048, a.in[9]};
        pg8::gemm_phase(c.lds, P, E);
    } SEAM(2);
    if (IN(3)) { norm_mod_rows(a.out, ZR, NT, a.in[7], mod0, 3072, 4096, (bf16_t*)(ws + R_HB), c); } SEAM(3);
    if (IN(4)) {
        pg8::Prob P{(const bf16_t*)(ws + R_HB), (const bf16_t*)(ws + W_GUT), NT / 256, 2 * DFF / 256, D, D, D, 0, 0, nullptr, 0, c.G, (int)blockIdx.x};
        pg8::EpiSwiGLU E{(bf16_t*)(ws + R_HID), DFF};
        pg8::gemm_phase(c.lds, P, E);
    } SEAM(4);
    if (IN(5)) {
        pg8::Prob P{(const bf16_t*)(ws + R_HID), (const bf16_t*)(ws + W_DT), NT / 256, D / 256, DFF, DFF, DFF, 0, 0, nullptr, 0, c.G, (int)blockIdx.x};
        pg8::EpiResid E{a.out, a.out, ZR, ZR, mod0 + 5120, nullptr};
        pg8::gemm_phase(c.lds, P, E);
    } SEAM(5);
    if (IN(6)) { norm_mod_rows(a.out, ZR, NT, a.in[6] + D, mod1, 0, 1024, (bf16_t*)(ws + R_H3), c); } SEAM(6);
    if (IN(7)) {
        pg8::Prob P{(const bf16_t*)(ws + R_H3), (const bf16_t*)(ws + W_INT), NT / 256, 2 * DR / 256, D, D, D, 0, 0, nullptr, 0, c.G, (int)blockIdx.x};
        pg8::EpiBf16 E{(bf16_t*)(ws + R_GU2), 2 * DR};
        pg8::gemm_phase(c.lds, P, E);
    } SEAM(7);
    if (IN(8)) { p8_conv(a, c); } SEAM(8);
    if (IN(9)) {
        pg8::Prob P{(const bf16_t*)(ws + R_UC), (const bf16_t*)(ws + W_GT), NT / 256, 20, 256, DR, 256, 1, 2, nullptr, 0, c.G, (int)blockIdx.x};
        pg8::EpiGate E{(const bf16_t*)(ws + R_UC), (bf16_t*)(ws + R_LAF), (bf16_t*)(ws + R_BF), (size_t)(R_LAR - R_LAF) / 2, a.in[16], a.in[18], a.in[19]};
        pg8::gemm_phase(c.lds, P, E);
    } SEAM(9);
    if (IN(10)) { p10a_chunk_sums(a, c); } SEAM(10);
    if (IN(11)) { p10c_scan(a, c); } SEAM(11);
    if (IN(12)) {
        pg8::Prob P{(const bf16_t*)(ws + R_BR), (const bf16_t*)(ws + W_OUTT), NX / 256, D / 256, DR, DR, DR, 0, 0, nullptr, 0, c.G, (int)blockIdx.x};
        pg8::EpiResid E{a.out, a.out, ZR, ZR, mod1 + 2048, nullptr};
        pg8::gemm_phase(c.lds, P, E);
    } SEAM(12);
    if (IN(13)) { p12_route(a, c); } SEAM(13);
    if (IN(14)) { p13_assign(a, c); } SEAM(14);
    if (IN(15)) {
        const int mt = (int)__hip_atomic_load((unsigned*)(ws + WS_CTL) + 16, __ATOMIC_RELAXED, __HIP_MEMORY_SCOPE_AGENT);
        pg8::Prob P{(const bf16_t*)(ws + R_HP), (const bf16_t*)(ws + W_MGUT), mt, 2 * DE / 256, D, D, D, 0, 0, (const int*)(ws + WS_TILEE), (size_t)2 * DE * D, c.G, (int)blockIdx.x};
        pg8::EpiSwiGLU E{(bf16_t*)(ws + R_MH), DE};
        pg8::gemm_phase(c.lds, P, E);
    } SEAM(15);
    if (IN(16)) {
        const int mt = (int)__hip_atomic_load((unsigned*)(ws + WS_CTL) + 16, __ATOMIC_RELAXED, __HIP_MEMORY_SCOPE_AGENT);
        pg8::Prob P{(const bf16_t*)(ws + R_MH), (const bf16_t*)(ws + W_MDT), mt, D / 256, DE, DE, DE, 0, 0, (const int*)(ws + WS_TILEE), (size_t)D * DE, c.G, (int)blockIdx.x};
        pg8::EpiBf16 E{(bf16_t*)(ws + R_HP), D};
        pg8::gemm_phase(c.lds, P, E);
    } SEAM(16);
    if (IN(17)) { p16_final(a, c); }
#undef IN
#undef SEAM
}

constexpr int LDS_BYTES = 147456;
extern "C" void kernel_launch(void* const* d_in, const int* in_sizes, int n_in, void* d_out, int out_size, void* d_ws, size_t ws_size, hipStream_t stream) {
    static int grid = 0;
    if (grid == 0) {
        if (n_in != 25 || out_size != NX * D || ws_size < WS_NEED) { fprintf(stderr, "kernel_launch: unexpected shapes (n_in %d out %d ws %zu, need %zu)\n", n_in, out_size, ws_size, (size_t)WS_NEED); grid = -1; return; }
        int dev = 0, cus = 0, per_cu = 0;
        hipGetDevice(&dev); hipDeviceGetAttribute(&cus, hipDeviceAttributeMultiprocessorCount, dev);
        if (hipFuncSetAttribute((const void*)trunk_fwd, hipFuncAttributeMaxDynamicSharedMemorySize, LDS_BYTES) != hipSuccess) { fprintf(stderr, "kernel_launch: hipFuncSetAttribute failed\n"); grid = -1; return; }
        if (hipOccupancyMaxActiveBlocksPerMultiprocessor(&per_cu, (const void*)trunk_fwd, NTHREADS, LDS_BYTES) != hipSuccess || per_cu < 1) { fprintf(stderr, "kernel_launch: occupancy query says %d\n", per_cu); per_cu = 1; }
        (void)hipGetLastError();
        grid = cus;
    }
    if (grid < 0) return;
    hipMemsetAsync((char*)d_ws + WS_CTL, 0, CTL_BYTES, stream);
    Args a{};
    for (int i = 0; i < 25; ++i) a.in[i] = (const float*)d_in[i];
    a.out = (float*)d_out; a.ws = (unsigned char*)d_ws;
#if MK_SINGLE
    a.ph_lo = 0; a.ph_hi = NPHASES + 1;
    void* args[] = {&a};
    hipError_t e = hipLaunchCooperativeKernel((const void*)trunk_fwd, dim3(grid), dim3(NTHREADS), args, LDS_BYTES, stream);
    if (e != hipSuccess) fprintf(stderr, "cooperative launch failed: %s (grid %d)\n", hipGetErrorString(e), grid);
#else
    for (int ph = 0; ph <= NPHASES; ++ph) { a.ph_lo = ph; a.ph_hi = ph + 1;
        hipLaunchKernelGGL(trunk_fwd, dim3(grid), dim3(NTHREADS), LDS_BYTES, stream, a); }
#endif
}
```

```cpp
#include <hip/hip_runtime.h>
#include <hip/hip_cooperative_groups.h>
#include <cstdio>
#include <cstdint>
namespace cg = cooperative_groups;

#define LAS __attribute__((address_space(3)))
typedef unsigned short bf16_t;
typedef short bf16x8 __attribute__((ext_vector_type(8)));
typedef float f32x4 __attribute__((ext_vector_type(4)));
typedef float f32x2 __attribute__((ext_vector_type(2)));
typedef unsigned u32x4 __attribute__((ext_vector_type(4)));
typedef unsigned u32x2 __attribute__((ext_vector_type(2)));

#ifndef MK_SINGLE
#define MK_SINGLE 1
#endif

constexpr int D = 1024, NB = 16, SEQ = 2048, CL = 256, NX = NB * SEQ, NZ = NB * CL, NT = NX + NZ;
constexpr int DFF = 2816, DR = 1280, DE = 3584, NE = 8;
constexpr int NSLOT = (NX * 2 / 256 + NE) * 256;
constexpr int NWAVES = 8, NTHREADS = 512;
constexpr float EPS = 1e-6f;
constexpr int NPHASES = 17;

constexpr size_t MiB = 1024 * 1024;
constexpr size_t WS_CTL = 0;
constexpr size_t CTL_BYTES = 4096;
constexpr size_t WS_TILEE = 4096;
constexpr size_t WS_MOD = 64 * 1024;
constexpr size_t WS_ROUTE = 1 * MiB;
constexpr size_t WS_CHUNK = 2 * MiB;
constexpr size_t WS_ZRES = 5 * MiB;
constexpr size_t WS_W = 21 * MiB;
constexpr size_t W_POOLT = WS_W;
constexpr size_t W_GUT = W_POOLT + (size_t)1024 * 256 * 2;
constexpr size_t W_DT = W_GUT + (size_t)5632 * 1024 * 2;
constexpr size_t W_INT = W_DT + (size_t)1024 * 2816 * 2;
constexpr size_t W_GT = W_INT + (size_t)2560 * 1024 * 2;
constexpr size_t W_OUTT = W_GT + (size_t)5120 * 256 * 2;
constexpr size_t W_MGUT = W_OUTT + (size_t)1024 * 1280 * 2;
constexpr size_t W_MDT = W_MGUT + (size_t)8 * 7168 * 1024 * 2;
constexpr size_t W_END = W_MDT + (size_t)8 * 1024 * 3584 * 2;
constexpr size_t WS_R = 217 * MiB;
static_assert(W_END <= WS_R, "weights overflow");
constexpr size_t R_HB = WS_R;
constexpr size_t R_HID = WS_R + 72 * MiB;
constexpr size_t R_GU2 = WS_R;
constexpr size_t R_UC = WS_R + 180 * MiB;
constexpr size_t R_LAF = WS_R + 270 * MiB;
constexpr size_t R_BF = R_LAF + 90 * MiB, R_LAR = R_LAF + 180 * MiB, R_BR = R_LAF + 270 * MiB;
constexpr size_t R_H3 = R_LAF;
constexpr size_t R_HP = WS_R;
constexpr size_t R_MH = WS_R + 132 * MiB;
constexpr size_t R_H4 = WS_R + 200 * MiB;
constexpr size_t WS_NEED = WS_R + 630 * MiB;
static_assert(R_MH + (size_t)NSLOT * DE * 2 <= WS_NEED, "MH overflow");
static_assert(WS_NEED <= (size_t)896 * MiB, "workspace");

__device__ __forceinline__ unsigned cvt_pk_bf16(float lo, float hi) { unsigned r; asm volatile("v_cvt_pk_bf16_f32 %0, %1, %2" : "=v"(r) : "v"(lo), "v"(hi)); return r; }
__device__ __forceinline__ float bf_lo(unsigned u) { return __uint_as_float(u << 16); }
__device__ __forceinline__ float bf_hi(unsigned u) { return __uint_as_float(u & 0xffff0000u); }
__device__ __forceinline__ float wave_sum(float v) {
#pragma unroll
    for (int o = 1; o < 64; o <<= 1) v += __shfl_xor(v, o);
    return v;
}
__device__ __forceinline__ float fast_exp(float x) { return __builtin_amdgcn_exp2f(x * 1.44269504089f); }
__device__ __forceinline__ float sigmoidf_(float x) { return __builtin_amdgcn_rcpf(1.0f + fast_exp(-x)); }
__device__ __forceinline__ float siluf_(float x) { return x * sigmoidf_(x); }
__device__ __forceinline__ float gelu_tanh(float x) {
    const float u = 0.7978845608f * (x + 0.044715f * x * x * x);
    const float t = 1.0f - 2.0f * __builtin_amdgcn_rcpf(fast_exp(2.0f * u) + 1.0f);
    return 0.5f * x * (1.0f + t);
}

namespace pg8 {
constexpr int BM = 256, BK = 64, HALF = 128, HTB = HALF * BK * 2, STAGE_BYTES = 8 * HTB, NXCD = 8, WGM = 8;
__device__ __forceinline__ int lds_byte(int r, int c) { const int st = (r >> 4) * 2 + (c >> 5), rr = r & 15, cc = c & 31, ob = rr * 64 + cc * 2; return st * 1024 + (ob ^ (((ob >> 9) & 1) << 5)); }
__device__ __forceinline__ void stage_rc(int b, int& R, int& C) { const int st = b / 1024, sb = b % 1024, swz = sb ^ (((sb >> 9) & 1) << 5); R = (st >> 1) * 16 + swz / 64; C = (st & 1) * 32 + (swz % 64) / 2; }
__device__ __forceinline__ int perm32(int rho) { const int n = rho >> 4, i = rho & 15; return 8 * (i >> 2) + 4 * n + (i & 3); }

struct Unit { int pm, pn; const char* A; const char* B; };

struct Prob {
    const bf16_t* A; const bf16_t* Bt; int nM, nN, K, lda, ldb;
    int grp, kshr;
    const int* tile_e; size_t estride;
    int G, c;
    __device__ __forceinline__ bool next(int i, Unit& u) const {
        const int nwg = nM * nN; const long L = (long)i * G + c; if (L >= nwg) return false;
        int wgid = (int)L; { const int q = nwg / NXCD, r = nwg % NXCD, xcd = wgid % NXCD, off = wgid / NXCD; wgid = (xcd < r ? xcd * (q + 1) : r * (q + 1) + (xcd - r) * q) + off; }
        const int nig = WGM * nN, gid = wgid / nig, fm = gid * WGM, gsz = (nM - fm) < WGM ? (nM - fm) : WGM;
        u.pm = fm + ((wgid % nig) % gsz); u.pn = (wgid % nig) / gsz;
        u.A = (const char*)(A + (size_t)u.pm * BM * lda + (grp ? (size_t)((u.pn >> kshr) * 256) : (size_t)0));
        const bf16_t* b = Bt + (size_t)u.pn * BM * ldb;
        if (tile_e) b += (size_t)tile_e[u.pm] * estride;
        u.B = (const char*)b;
        return true;
    }
};

struct EpiBf16 {
    static constexpr bool PERM = true;
    bf16_t* O; int ldc;
    __device__ __forceinline__ void operator()(const f32x4 (&acc)[2][2][4][2], const Unit& u, int wr, int wc, int fr, int fq) const {
        const int row0 = u.pm * BM + wr * 64 + fr, col0 = u.pn * BM + wc * 32 + 8 * fq;
#pragma unroll
        for (int ai = 0; ai < 2; ++ai)
#pragma unroll
            for (int m = 0; m < 4; ++m) { bf16_t* rowp = O + (size_t)(row0 + ai * HALF + m * 16) * ldc + col0;
#pragma unroll
                for (int bj = 0; bj < 2; ++bj) { const f32x4 v0 = acc[ai][bj][m][0], v1 = acc[ai][bj][m][1];
                    u32x4 w; w.x = cvt_pk_bf16(v0[0], v0[1]); w.y = cvt_pk_bf16(v0[2], v0[3]); w.z = cvt_pk_bf16(v1[0], v1[1]); w.w = cvt_pk_bf16(v1[2], v1[3]);
                    *(u32x4*)(rowp + bj * HALF) = w; } }
    }
};
struct EpiSwiGLU {
    static constexpr bool PERM = true;
    bf16_t* O; int ldc;
    __device__ __forceinline__ void operator()(const f32x4 (&acc)[2][2][4][2], const Unit& u, int wr, int wc, int fr, int fq) const {
        const int row0 = u.pm * BM + wr * 64 + fr, col0 = u.pn * HALF + wc * 32 + 8 * fq;
#pragma unroll
        for (int ai = 0; ai < 2; ++ai)
#pragma unroll
            for (int m = 0; m < 4; ++m) { bf16_t* rowp = O + (size_t)(row0 + ai * HALF + m * 16) * ldc + col0;
                float v[8];
#pragma unroll
                for (int n = 0; n < 2; ++n)
#pragma unroll
                    for (int j = 0; j < 4; ++j) v[n * 4 + j] = siluf_(acc[ai][0][m][n][j]) * acc[ai][1][m][n][j];
                u32x4 w; w.x = cvt_pk_bf16(v[0], v[1]); w.y = cvt_pk_bf16(v[2], v[3]); w.z = cvt_pk_bf16(v[4], v[5]); w.w = cvt_pk_bf16(v[6], v[7]);
                *(u32x4*)rowp = w; }
    }
};
struct EpiResid {
    static constexpr bool PERM = false;
    const float* xb; float* xo; const float* zb; float* zo; const float* gate  ; const float* colscale;
    __device__ __forceinline__ void operator()(const f32x4 (&acc)[2][2][4][2], const Unit& u, int wr, int wc, int fr, int fq) const {
        const bool isx = u.pm < NX / BM; const int b = isx ? (u.pm >> 3) : NB;
        const float* base = isx ? xb + (size_t)u.pm * BM * D : zb + (size_t)(u.pm - NX / BM) * BM * D;
        float* out = isx ? xo + (size_t)u.pm * BM * D : zo + (size_t)(u.pm - NX / BM) * BM * D;
        const int col0 = u.pn * BM + wc * 32 + 4 * fq;
        f32x4 gv[2][2];
#pragma unroll
        for (int bj = 0; bj < 2; ++bj)
#pragma unroll
            for (int n = 0; n < 2; ++n) { const int col = col0 + bj * HALF + n * 16; gv[bj][n] = *(const f32x4*)(gate + (size_t)b * 6144 + col); if (colscale) gv[bj][n] = gv[bj][n] * *(const f32x4*)(colscale + col); }
#pragma unroll
        for (int ai = 0; ai < 2; ++ai)
#pragma unroll
            for (int m = 0; m < 4; ++m) { const size_t off = (size_t)(ai * HALF + wr * 64 + m * 16 + fr) * D + col0;
#pragma unroll
                for (int bj = 0; bj < 2; ++bj)
#pragma unroll
                    for (int n = 0; n < 2; ++n) { const f32x4 bs = *(const f32x4*)(base + off + bj * HALF + n * 16);
                        *(f32x4*)(out + off + bj * HALF + n * 16) = bs + gv[bj][n] * acc[ai][bj][m][n]; } }
    }
};
struct EpiGate {
    static constexpr bool PERM = true;
    const bf16_t* UC; bf16_t* LA0; bf16_t* B0; size_t dstride  ; const float* b_r; const float* b_i; const float* lam;
    __device__ __forceinline__ void operator()(const f32x4 (&acc)[2][2][4][2], const Unit& u, int wr, int wc, int fr, int fq) const {
        const int head = u.pn >> 1, dir = u.pn & 1;
        const int row0 = u.pm * BM + wr * 64 + fr, ch0 = head * 128 + wc * 32 + 8 * fq;
        float br[8], bi[8], sp[8];
#pragma unroll
        for (int j = 0; j < 8; ++j) { br[j] = b_r[dir * DR + ch0 + j]; bi[j] = b_i[dir * DR + ch0 + j]; const float l = lam[dir * DR + ch0 + j]; sp[j] = -8.0f * log1pf(__expf(-l)); }
        bf16_t* LA = LA0 + (size_t)dir * dstride; bf16_t* BB = B0 + (size_t)dir * dstride;
#pragma unroll
        for (int ai = 0; ai < 2; ++ai)
#pragma unroll
            for (int m = 0; m < 4; ++m) { const size_t off = (size_t)(row0 + ai * HALF + m * 16) * DR + ch0;
                const u32x4 uw = *(const u32x4*)(UC + off);
                float uv[8] = {bf_lo(uw.x), bf_hi(uw.x), bf_lo(uw.y), bf_hi(uw.y), bf_lo(uw.z), bf_hi(uw.z), bf_lo(uw.w), bf_hi(uw.w)};
                float la[8], bb[8];
#pragma unroll
                for (int n = 0; n < 2; ++n)
#pragma unroll
                    for (int j = 0; j < 4; ++j) { const int q = n * 4 + j;
                        const float r = sigmoidf_(acc[ai][0][m][n][j] + br[q]), ig = sigmoidf_(acc[ai][1][m][n][j] + bi[q]);
                        const float l = r * sp[q]; la[q] = l;
                        const float y = 2.0f * l;
                        const float em = (y > -0.3f) ? -y * (1.0f + y * 0.5f * (1.0f + y * (1.0f / 3.0f) * (1.0f + y * 0.25f * (1.0f + y * 0.2f)))) : 1.0f - fast_exp(y);
                        bb[q] = sqrtf(em) * ig * uv[q]; }
                u32x4 w; w.x = cvt_pk_bf16(la[0], la[1]); w.y = cvt_pk_bf16(la[2], la[3]); w.z = cvt_pk_bf16(la[4], la[5]); w.w = cvt_pk_bf16(la[6], la[7]);
                *(u32x4*)(LA + off) = w;
                w.x = cvt_pk_bf16(bb[0], bb[1]); w.y = cvt_pk_bf16(bb[2], bb[3]); w.z = cvt_pk_bf16(bb[4], bb[5]); w.w = cvt_pk_bf16(bb[6], bb[7]);
                *(u32x4*)(BB + off) = w; }
    }
};

template <class Epi>
__device__ __forceinline__ void gemm_phase(LAS unsigned char* lds, const Prob& S, const Epi& E) {
    const int tid = threadIdx.x, wid = __builtin_amdgcn_readfirstlane(tid >> 6), lane = tid & 63, wr = wid >> 2, wc = wid & 3, fr = lane & 15, fq = lane >> 4;
    const int K = S.K, nt = K / BK;
    unsigned voffA[2], voffB[2];
#pragma unroll
    for (int i = 0; i < 2; ++i) { int R, C; stage_rc(tid * 16 + i * 8192, R, C); const int Rb = Epi::PERM ? ((R & ~31) + perm32(R & 31)) : R;
        voffA[i] = (unsigned)(R * S.lda + C) * 2u; voffB[i] = (unsigned)(Rb * S.ldb + C) * 2u; }
    const size_t kstep = (size_t)(BK * 2);
    const size_t hstepA = (size_t)HALF * S.lda * 2, hstepB = (size_t)HALF * S.ldb * 2;
    const unsigned ldsw = (unsigned)wid * 1024u;
    const int aoff = lds_byte(wr * 64 + fr, fq * 8), boff = lds_byte(wc * 32 + fr, fq * 8);
#define PG8_SA(b, h) (((b) * 2 + (h)) * HTB)
#define PG8_SB(b, h) ((4 + (b) * 2 + (h)) * HTB)
#define PG8_STAGE(bufoff, gbase, voff) do { _Pragma("unroll") for (int _i = 0; _i < 2; ++_i) \
        __builtin_amdgcn_global_load_lds((const unsigned*)((const char*)(gbase) + (voff)[_i]), (LAS unsigned*)(lds + (bufoff) + ldsw + _i * 8192), 16, 0, 0); } while (0)
#define PG8_LDA(dst, b, h) do { _Pragma("unroll") for (int m = 0; m < 4; ++m) _Pragma("unroll") for (int k = 0; k < 2; ++k) dst[m][k] = *(const LAS bf16x8*)(lds + PG8_SA(b, h) + aoff + m * 2048 + k * 1024); } while (0)
#define PG8_LDB(dst, b, h) do { _Pragma("unroll") for (int n = 0; n < 2; ++n) _Pragma("unroll") for (int k = 0; k < 2; ++k) dst[n][k] = *(const LAS bf16x8*)(lds + PG8_SB(b, h) + boff + n * 2048 + k * 1024); } while (0)
#define PG8_MMA(ai, bj, At, Bt) do { __builtin_amdgcn_s_setprio(1); _Pragma("unroll") for (int m = 0; m < 4; ++m) _Pragma("unroll") for (int n = 0; n < 2; ++n) _Pragma("unroll") for (int k = 0; k < 2; ++k) \
        acc[ai][bj][m][n] = __builtin_amdgcn_mfma_f32_16x16x32_bf16(Bt[n][k], At[m][k], acc[ai][bj][m][n], 0, 0, 0); __builtin_amdgcn_s_setprio(0); } while (0)
#define PG8_WAIT_V(n) asm volatile("s_waitcnt vmcnt(" #n ")" ::: "memory")
#define PG8_WAIT_L(n) asm volatile("s_waitcnt lgkmcnt(" #n ")" ::: "memory")
#define PG8_BAR __builtin_amdgcn_s_barrier()
#define PG8_SCHED __builtin_amdgcn_sched_barrier(0)
    Unit cur, nxt; int ui = 0;
    if (!S.next(0, cur)) return;
    f32x4 acc[2][2][4][2];
#pragma unroll
    for (int a = 0; a < 2; ++a)
#pragma unroll
        for (int b = 0; b < 2; ++b)
#pragma unroll
            for (int m = 0; m < 4; ++m)
#pragma unroll
                for (int n = 0; n < 2; ++n) acc[a][b][m][n] = (f32x4){0.f, 0.f, 0.f, 0.f};
    bf16x8 At[4][2], B0[2][2], B1[2][2];
    const char* cA = cur.A; const char* cB = cur.B;
    PG8_STAGE(PG8_SB(0, 0), cB, voffB); PG8_STAGE(PG8_SB(0, 1), cB + hstepB, voffB); PG8_STAGE(PG8_SA(0, 0), cA, voffA); PG8_STAGE(PG8_SA(0, 1), cA + hstepA, voffA);
    if (wr == 1) PG8_BAR;
    PG8_WAIT_V(2); PG8_BAR;
    PG8_STAGE(PG8_SB(1, 0), cB + kstep, voffB); PG8_STAGE(PG8_SA(1, 0), cA + kstep, voffA); PG8_STAGE(PG8_SB(1, 1), cB + hstepB + kstep, voffB);
    PG8_WAIT_V(6); PG8_BAR;
    for (;;) {
        const bool has_next = S.next(ui + 1, nxt);
        const char* nA = has_next ? nxt.A : cA; const char* nB = has_next ? nxt.B : cB;
        for (int t = 0; t < nt; t += 2) {
            const bool last = (t == nt - 2);
            const char* a1 = cA + (size_t)(t + 1) * kstep;
            const char* a2 = last ? nA : cA + (size_t)(t + 2) * kstep; const char* b2 = last ? nB : cB + (size_t)(t + 2) * kstep;
            const char* a3 = a2 + kstep; const char* b3 = b2 + kstep;
            PG8_LDB(B0, 0, 0); PG8_LDB(B1, 0, 1); PG8_SCHED; PG8_LDA(At, 0, 0); PG8_STAGE(PG8_SA(1, 1), a1 + hstepA, voffA);
            PG8_WAIT_V(8); PG8_WAIT_L(0); PG8_BAR; PG8_MMA(0, 0, At, B0); PG8_MMA(0, 1, At, B1); PG8_BAR; PG8_SCHED;
            PG8_LDA(At, 0, 1); PG8_STAGE(PG8_SB(0, 0), b2, voffB); PG8_STAGE(PG8_SB(0, 1), b2 + hstepB, voffB); PG8_STAGE(PG8_SA(0, 0), a2, voffA);
            PG8_WAIT_V(8); PG8_WAIT_L(0); PG8_BAR; PG8_MMA(1, 0, At, B0); PG8_MMA(1, 1, At, B1); PG8_BAR; PG8_SCHED;
            PG8_LDB(B0, 1, 0); PG8_LDB(B1, 1, 1); PG8_SCHED; PG8_LDA(At, 1, 0); PG8_STAGE(PG8_SA(0, 1), a2 + hstepA, voffA);
            PG8_WAIT_V(8); PG8_WAIT_L(0); PG8_BAR; PG8_MMA(0, 0, At, B0); PG8_MMA(0, 1, At, B1); PG8_BAR; PG8_SCHED;
            PG8_LDA(At, 1, 1); PG8_STAGE(PG8_SB(1, 0), b3, voffB); PG8_STAGE(PG8_SB(1, 1), b3 + hstepB, voffB); PG8_STAGE(PG8_SA(1, 0), a3, voffA);
            PG8_WAIT_V(8); PG8_WAIT_L(0); PG8_BAR; PG8_MMA(1, 0, At, B0); PG8_MMA(1, 1, At, B1); PG8_BAR; PG8_SCHED;
        }
        if (wr == 0) PG8_BAR;
        E(acc, cur, wr, wc, fr, fq);
        if (!has_next) break;
#pragma unroll
        for (int a = 0; a < 2; ++a)
#pragma unroll
            for (int b = 0; b < 2; ++b)
#pragma unroll
                for (int m = 0; m < 4; ++m)
#pragma unroll
                    for (int n = 0; n < 2; ++n) acc[a][b][m][n] = (f32x4){0.f, 0.f, 0.f, 0.f};
        cur = nxt; cA = nA; cB = nB; ++ui;
        if (wr == 1) PG8_BAR;
    }
    PG8_WAIT_V(0);
    PG8_BAR;
#undef PG8_SA
#undef PG8_SB
#undef PG8_STAGE
#undef PG8_LDA
#undef PG8_LDB
#undef PG8_MMA
#undef PG8_WAIT_V
#undef PG8_WAIT_L
#undef PG8_BAR
#undef PG8_SCHED
}
}

struct Args {
    const float* in[25]; float* out; unsigned char* ws; int ph_lo, ph_hi;
};

struct Ctx { LAS unsigned char* lds; int tid, lane, wave, gw, NGW, G; };

__device__ __forceinline__ void tr_item(const float* W, int ldw, int scol0, int k0, bf16_t* WT, int ldt, int drow0, int dk0, LAS float* scr, int lane) {
#pragma unroll 8
    for (int i = 0; i < 32; ++i) { const int kk = 2 * i + (lane >> 5); scr[kk * 33 + (lane & 31)] = W[(size_t)(k0 + kk) * ldw + scol0 + (lane & 31)]; }
    asm volatile("s_waitcnt lgkmcnt(0)" ::: "memory");
    const int c = lane & 7;
#pragma unroll
    for (int j = 0; j < 4; ++j) { const int n = (lane >> 3) + 8 * j; const LAS float* s = scr + (8 * c) * 33 + n;
        u32x4 o; o.x = cvt_pk_bf16(s[0 * 33], s[1 * 33]); o.y = cvt_pk_bf16(s[2 * 33], s[3 * 33]); o.z = cvt_pk_bf16(s[4 * 33], s[5 * 33]); o.w = cvt_pk_bf16(s[6 * 33], s[7 * 33]);
        *(u32x4*)(WT + (size_t)(drow0 + n) * ldt + dk0 + k0 + 8 * c) = o; }
    asm volatile("s_waitcnt lgkmcnt(0)" ::: "memory");
}
__device__ __forceinline__ int gu_src_col(int nrow, int H) { return ((nrow & 255) >> 7) * H + (nrow >> 8) * 128 + (nrow & 127); }

__device__ __forceinline__ void p0_convert(const Args& a, const Ctx& c) {
    unsigned char* ws = a.ws;
    LAS float* scr = (LAS float*)(c.lds + c.wave * 16384);
    constexpr int I_POOL = 4 * (256 / 64) * (256 / 32);
    constexpr int I_GU = (D / 64) * (2 * DFF / 32);
    constexpr int I_DN = (DFF / 64) * (D / 32);
    constexpr int I_IN = (D / 64) * (2 * DR / 32);
    constexpr int I_GT = 40 * 2 * 4;
    constexpr int I_OUT = (DR / 64) * (D / 32);
    constexpr int I_MGU1 = (D / 64) * (2 * DE / 32);
    constexpr int I_MDN1 = (DE / 64) * (D / 32);
    constexpr int NITEMS = I_POOL + I_GU + I_DN + I_IN + I_GT + I_OUT + NE * I_MGU1 + NE * I_MDN1;
    for (int it = c.gw; it < NITEMS; it += c.NGW) {
        int r = it;
        if (r < I_POOL) { const int g = r / 32, q = r % 32, kb = q / 8, nb = q % 8;
            tr_item(a.in[8] + (size_t)g * 65536, 256, 32 * nb, 64 * kb, (bf16_t*)(ws + W_POOLT), 256, g * 256 + 32 * nb, 0, scr, c.lane); continue; } r -= I_POOL;
        if (r < I_GU) { const int nblk = 2 * DFF / 32, kb = r / nblk, nb = r % nblk;
            tr_item(a.in[10], 2 * DFF, gu_src_col(32 * nb, DFF), 64 * kb, (bf16_t*)(ws + W_GUT), D, 32 * nb, 0, scr, c.lane); continue; } r -= I_GU;
        if (r < I_DN) { const int nblk = D / 32, kb = r / nblk, nb = r % nblk;
            tr_item(a.in[11], D, 32 * nb, 64 * kb, (bf16_t*)(ws + W_DT), DFF, 32 * nb, 0, scr, c.lane); continue; } r -= I_DN;
        if (r < I_IN) { const int nblk = 2 * DR / 32, kb = r / nblk, nb = r % nblk;
            tr_item(a.in[12], 2 * DR, 32 * nb, 64 * kb, (bf16_t*)(ws + W_INT), D, 32 * nb, 0, scr, c.lane); continue; } r -= I_IN;
        if (r < I_GT) { const int mat = r / 8, q = r % 8, kb = q / 4, nb = q % 4; const int which = mat / 20, dh = mat % 20, dir = dh / 10, head = dh % 10;
            const float* W = (which ? a.in[17] : a.in[15]) + (size_t)(dir * 10 + head) * 16384;
            tr_item(W, 128, 32 * nb, 64 * kb, (bf16_t*)(ws + W_GT), 256, (head * 2 + dir) * 256 + which * 128 + 32 * nb, (head & 1) * 128, scr, c.lane); continue; } r -= I_GT;
        if (r < I_OUT) { const int nblk = D / 32, kb = r / nblk, nb = r % nblk;
            tr_item(a.in[20], D, 32 * nb, 64 * kb, (bf16_t*)(ws + W_OUTT), DR, 32 * nb, 0, scr, c.lane); continue; } r -= I_OUT;
        if (r < NE * I_MGU1) { const int e = r / I_MGU1, q = r % I_MGU1, nblk = 2 * DE / 32, kb = q / nblk, nb = q % nblk;
            tr_item(a.in[22] + (size_t)e * D * 2 * DE, 2 * DE, gu_src_col(32 * nb, DE), 64 * kb, (bf16_t*)(ws + W_MGUT) + (size_t)e * 2 * DE * D, D, 32 * nb, 0, scr, c.lane); continue; } r -= NE * I_MGU1;
        { const int e = r / I_MDN1, q = r % I_MDN1, nblk = D / 32, kb = q / nblk, nb = q % nblk;
            tr_item(a.in[23] + (size_t)e * DE * D, D, 32 * nb, 64 * kb, (bf16_t*)(ws + W_MDT) + (size_t)e * D * DE, DE, 32 * nb, 0, scr, c.lane); }
    }
    { bf16_t* GT = (bf16_t*)(ws + W_GT);
      for (int i = c.gw * 64 + c.lane; i < 5120 * 16; i += c.NGW * 64) { const int R = i >> 4, q = i & 15, head = R >> 9;
          *(u32x4*)(GT + (size_t)R * 256 + (1 - (head & 1)) * 128 + q * 8) = (u32x4){0u, 0u, 0u, 0u}; } }
}

__device__ __forceinline__ void p0_adaln(const Args& a, const Ctx& c) {
    if ((int)blockIdx.x >= 192) return;
    const int layer = blockIdx.x / 96, col0 = (blockIdx.x % 96) * 64;
    LAS float* s = (LAS float*)c.lds;
    LAS float* red = (LAS float*)(c.lds + 17 * 1024 * 4);
    for (int i = c.tid; i < 17 * 1024; i += NTHREADS) { const int b = i >> 10, k = i & 1023; const float v = b < NB ? a.in[1][b * D + k] : a.in[3][k]; s[i] = v / (1.0f + __expf(-v)); }
    __syncthreads();
    const float* W = a.in[4] + (size_t)layer * D * 6 * D + col0 + c.lane;
    float acc[17];
#pragma unroll
    for (int b = 0; b < 17; ++b) acc[b] = 0.f;
    const int k0 = c.wave * 128;
#pragma unroll 4
    for (int k = 0; k < 128; ++k) { const float w = W[(size_t)(k0 + k) * 6 * D];
#pragma unroll
        for (int b = 0; b < 17; ++b) acc[b] += s[b * 1024 + k0 + k] * w; }
#pragma unroll
    for (int b = 0; b < 17; ++b) red[(c.wave * 17 + b) * 64 + c.lane] = acc[b];
    __syncthreads();
    float* mod = (float*)(a.ws + WS_MOD) + (size_t)layer * 17 * 6144;
    for (int i = c.tid; i < 17 * 64; i += NTHREADS) { const int b = i >> 6, l = i & 63; float v = a.in[5][layer * 6 * D + col0 + l];
#pragma unroll
        for (int w = 0; w < 8; ++w) v += red[(w * 17 + b) * 64 + l];
        mod[b * 6144 + col0 + l] = v; }
    __syncthreads();
}

template <int W>
__device__ __forceinline__ void pool_cols(const float* src  , LAS const float* rs, int t0, int L, float g0, float g1, float b0, float b1, bf16_t* dst  ) {
    float r0[16], r1[16]; float S0 = 0.f, S1 = 0.f;
#pragma unroll
    for (int s = 8 - W / 2; s < 72 + W / 2 - 1; ++s) {
        const int t = t0 - 8 + s; float v0 = 0.f, v1 = 0.f;
        if (t >= 0 && t < L) { const f32x2 xv = *(const f32x2*)(src + (size_t)s * D); const float r = rs[s]; v0 = xv.x * r * g0 + b0; v1 = xv.y * r * g1 + b1; }
        r0[s & 15] = v0; r1[s & 15] = v1; S0 += v0; S1 += v1;
        const int p = s - W / 2 + 1;
        if (p >= 8 && p < 72) { const int tp = t0 - 8 + p; const int lo = max(tp - W / 2, 0), hi = min(tp - W / 2 + W, L); const float inv = 1.0f / (float)(hi - lo);
            *(unsigned*)(dst + (size_t)(p - 8) * D) = cvt_pk_bf16(S0 * inv - r0[p & 15], S1 * inv - r1[p & 15]); }
        if (s - W + 1 >= 8 - W / 2) { S0 -= r0[(s - W + 1) & 15]; S1 -= r1[(s - W + 1) & 15]; }
    }
}
__device__ __forceinline__ void p1_pool_prep(const Args& a, const Ctx& c) {
    LAS float* rs = (LAS float*)c.lds;
    const float* g1 = a.in[6];
    const float* mod0 = (const float*)(a.ws + WS_MOD);
    bf16_t* AP = (bf16_t*)(a.ws + R_HB);
    for (int tile = blockIdx.x; tile < 576; tile += c.G) {
        const bool isx = tile < 512; const int L = isx ? 64 : 256;
        const int t0 = isx ? 0 : ((tile - 512) & 3) * 64;
        const float* seq = isx ? a.in[0] + (size_t)tile * 64 * D : a.in[2] + (size_t)((tile - 512) >> 2) * CL * D;
        const int b = isx ? (tile >> 5) : NB;
        const size_t orow0 = isx ? (size_t)tile * 64 : (size_t)NX + (size_t)((tile - 512) >> 2) * CL + t0;
        __syncthreads();
        for (int s = c.wave; s < 80; s += NWAVES) { const int t = t0 - 8 + s;
            if (t >= 0 && t < L) { const f32x4* xr = (const f32x4*)(seq + (size_t)t * D) + c.lane; float ss = 0.f;
#pragma unroll
                for (int j = 0; j < 4; ++j) { const f32x4 v = xr[64 * j]; ss += (v.x * v.x + v.y * v.y) + (v.z * v.z + v.w * v.w); }
                ss = wave_sum(ss); if (c.lane == 0) rs[s] = rsqrtf(ss * (1.0f / D) + EPS); } }
        __syncthreads();
        const int col = 2 * c.tid;
        const f32x2 gg = *(const f32x2*)(g1 + col), sc = *(const f32x2*)(mod0 + (size_t)b * 6144 + 1024 + col), sh = *(const f32x2*)(mod0 + (size_t)b * 6144 + col);
        const float ga = gg.x * (1.0f + sc.x), gb = gg.y * (1.0f + sc.y);
        const float* src = seq + (ptrdiff_t)(t0 - 8) * D + col; bf16_t* dst = AP + (orow0) * D + col;
        const int grp = __builtin_amdgcn_readfirstlane(col >> 8);
        if (grp == 0) pool_cols<2>(src, rs, t0, L, ga, gb, sh.x, sh.y, dst);
        else if (grp == 1) pool_cols<4>(src, rs, t0, L, ga, gb, sh.x, sh.y, dst);
        else if (grp == 2) pool_cols<8>(src, rs, t0, L, ga, gb, sh.x, sh.y, dst);
        else pool_cols<16>(src, rs, t0, L, ga, gb, sh.x, sh.y, dst);
    }
}

__device__ __forceinline__ void norm_mod_rows(const float* X, const float* Z, int nrows, const float* gvec, const float* modl, int sh_off, int sc_off, bf16_t* out, const Ctx& c) {
    for (int row = c.gw; row < nrows; row += c.NGW) {
        const float* src = row < NX ? X + (size_t)row * D : Z + (size_t)(row - NX) * D; const int b = row < NX ? row / SEQ : NB;
        const f32x4* xr = (const f32x4*)src + c.lane; f32x4 v[4]; float ss = 0.f;
#pragma unroll
        for (int j = 0; j < 4; ++j) { v[j] = xr[64 * j]; ss += (v[j].x * v[j].x + v[j].y * v[j].y) + (v[j].z * v[j].z + v[j].w * v[j].w); }
        const float rstd = rsqrtf(wave_sum(ss) * (1.0f / D) + EPS);
        const float* mb = modl + (size_t)b * 6144;
#pragma unroll
        for (int j = 0; j < 4; ++j) { const int col = 4 * (c.lane + 64 * j);
            const f32x4 g = *(const f32x4*)(gvec + col), sc = *(const f32x4*)(mb + sc_off + col), sh = *(const f32x4*)(mb + sh_off + col);
            const f32x4 h = v[j] * rstd * g * (sc + 1.0f) + sh;
            u32x2 w; w.x = cvt_pk_bf16(h.x, h.y); w.y = cvt_pk_bf16(h.z, h.w);
            *(u32x2*)(out + (size_t)row * D + col) = w; }
    }
}

__device__ __forceinline__ void p8_conv(const Args& a, const Ctx& c) {
    const bf16_t* GU2 = (const bf16_t*)(a.ws + R_GU2); bf16_t* UC = (bf16_t*)(a.ws + R_UC);
    const float* cw = a.in[13]; const float* cb = a.in[14];
    const int total = NT * 160;
    for (int idx = blockIdx.x * NTHREADS + c.tid; idx < total; idx += c.G * NTHREADS) {
        const int row = idx / 160, ch = (idx % 160) * 8;
        int t, L; if (row < NX) { t = row % SEQ; L = SEQ; } else { t = (row - NX) % CL; L = CL; }
        float acc[8];
#pragma unroll
        for (int j = 0; j < 8; ++j) acc[j] = cb[ch + j];
#pragma unroll
        for (int k = 0; k < 4; ++k) { const int tt = t + k - 2;
            if (tt >= 0 && tt < L) { const u32x4 uw = *(const u32x4*)(GU2 + (size_t)(row + k - 2) * (2 * DR) + DR + ch);
                const f32x4 w0 = *(const f32x4*)(cw + k * DR + ch), w1 = *(const f32x4*)(cw + k * DR + ch + 4);
                acc[0] += w0.x * bf_lo(uw.x); acc[1] += w0.y * bf_hi(uw.x); acc[2] += w0.z * bf_lo(uw.y); acc[3] += w0.w * bf_hi(uw.y);
                acc[4] += w1.x * bf_lo(uw.z); acc[5] += w1.y * bf_hi(uw.z); acc[6] += w1.z * bf_lo(uw.w); acc[7] += w1.w * bf_hi(uw.w); } }
        u32x4 w; w.x = cvt_pk_bf16(acc[0], acc[1]); w.y = cvt_pk_bf16(acc[2], acc[3]); w.z = cvt_pk_bf16(acc[4], acc[5]); w.w = cvt_pk_bf16(acc[6], acc[7]);
        *(u32x4*)(UC + (size_t)row * DR + ch) = w;
    }
}

__device__ __forceinline__ void p10a_chunk_sums(const Args& a, const Ctx& c) {
    float* CA = (float*)(a.ws + WS_CHUNK); float* CB = CA + 2 * 144 * DR;
    for (int wi = c.gw; wi < 144 * 2 * 10; wi += c.NGW) {
        const int chunk = wi / 20, dir = (wi % 20) / 10, cp = (wi % 10) * 64 + c.lane;
        const size_t row0 = chunk < 128 ? (size_t)chunk * 256 : (size_t)NX + (size_t)(chunk - 128) * 256;
        const unsigned* LA = (const unsigned*)(a.ws + (dir ? R_LAR : R_LAF)) + row0 * (DR / 2) + cp;
        const unsigned* BB = (const unsigned*)(a.ws + (dir ? R_BR : R_BF)) + row0 * (DR / 2) + cp;
        float s0 = 0.f, s1 = 0.f, h0 = 0.f, h1 = 0.f;
#pragma unroll 8
        for (int i = 0; i < 256; ++i) { const int t = dir ? 255 - i : i;
            const unsigned la = LA[(size_t)t * (DR / 2)], bb = BB[(size_t)t * (DR / 2)];
            const float l0 = bf_lo(la), l1 = bf_hi(la); s0 += l0; s1 += l1;
            h0 = fast_exp(l0) * h0 + bf_lo(bb); h1 = fast_exp(l1) * h1 + bf_hi(bb); }
        const size_t o = ((size_t)dir * 144 + chunk) * DR + 2 * cp;
        *(f32x2*)(CA + o) = (f32x2){fast_exp(s0), fast_exp(s1)}; *(f32x2*)(CB + o) = (f32x2){h0, h1};
    }
}
__device__ __forceinline__ void p10c_scan(const Args& a, const Ctx& c) {
    const float* CA = (const float*)(a.ws + WS_CHUNK); const float* CB = CA + 2 * 144 * DR;
    for (int wi = c.gw; wi < 128 * 10; wi += c.NGW) {
        const int chunk = wi / 10, cp = (wi % 10) * 64 + c.lane, b = chunk >> 3, cj = chunk & 7;
        f32x2 hf = *(const f32x2*)(CB + ((size_t)0 * 144 + 128 + b) * DR + 2 * cp);
        for (int j = 0; j < cj; ++j) { const size_t o = ((size_t)0 * 144 + b * 8 + j) * DR + 2 * cp; hf = *(const f32x2*)(CA + o) * hf + *(const f32x2*)(CB + o); }
        f32x2 hr = *(const f32x2*)(CB + ((size_t)1 * 144 + 128 + b) * DR + 2 * cp);
        for (int j = 7; j > cj; --j) { const size_t o = ((size_t)1 * 144 + b * 8 + j) * DR + 2 * cp; hr = *(const f32x2*)(CA + o) * hr + *(const f32x2*)(CB + o); }
        const size_t row0 = (size_t)chunk * 256;
        const unsigned* LAF = (const unsigned*)(a.ws + R_LAF) + row0 * (DR / 2) + cp; unsigned* BF = (unsigned*)(a.ws + R_BF) + row0 * (DR / 2) + cp;
        const unsigned* LAR = (const unsigned*)(a.ws + R_LAR) + row0 * (DR / 2) + cp; unsigned* BR = (unsigned*)(a.ws + R_BR) + row0 * (DR / 2) + cp;
        const unsigned* GT = (const unsigned*)(a.ws + R_GU2) + row0 * DR + cp;
        float h0 = hf.x, h1 = hf.y;
#pragma unroll 8
        for (int t = 0; t < 256; ++t) { const unsigned la = LAF[(size_t)t * (DR / 2)], bb = BF[(size_t)t * (DR / 2)];
            h0 = fast_exp(bf_lo(la)) * h0 + bf_lo(bb); h1 = fast_exp(bf_hi(la)) * h1 + bf_hi(bb);
            BF[(size_t)t * (DR / 2)] = cvt_pk_bf16(h0, h1); }
        h0 = hr.x; h1 = hr.y;
#pragma unroll 8
        for (int i = 0; i < 256; ++i) { const int t = 255 - i; const unsigned la = LAR[(size_t)t * (DR / 2)], bb = BR[(size_t)t * (DR / 2)], fw = BF[(size_t)t * (DR / 2)], gt = GT[(size_t)t * DR];
            h0 = fast_exp(bf_lo(la)) * h0 + bf_lo(bb); h1 = fast_exp(bf_hi(la)) * h1 + bf_hi(bb);
            BR[(size_t)t * (DR / 2)] = cvt_pk_bf16((h0 + bf_lo(fw)) * gelu_tanh(bf_lo(gt)), (h1 + bf_hi(fw)) * gelu_tanh(bf_hi(gt))); }
    }
}

__device__ __forceinline__ void p12_route(const Args& a, const Ctx& c) {
    LAS unsigned* lcnt = (LAS unsigned*)c.lds;
    if (c.tid < NE) lcnt[c.tid] = 0u;
    __syncthreads();
    const float* X = a.out; const float* gvec = a.in[7] + D; const float* modl = (const float*)(a.ws + WS_MOD) + (size_t)17 * 6144; const float* WR = a.in[21];
    bf16_t* H4 = (bf16_t*)(a.ws + R_H4);
    int* tok_e = (int*)(a.ws + WS_ROUTE); float* tok_w = (float*)(a.ws + WS_ROUTE + (size_t)NX * 8);
    for (int row = c.gw; row < NX; row += c.NGW) {
        const int b = row / SEQ; const f32x4* xr = (const f32x4*)(X + (size_t)row * D) + c.lane; f32x4 v[4]; float ss = 0.f;
#pragma unroll
        for (int j = 0; j < 4; ++j) { v[j] = xr[64 * j]; ss += (v[j].x * v[j].x + v[j].y * v[j].y) + (v[j].z * v[j].z + v[j].w * v[j].w); }
        const float rstd = rsqrtf(wave_sum(ss) * (1.0f / D) + EPS);
        const float* mb = modl + (size_t)b * 6144;
        float lg[8];
#pragma unroll
        for (int e = 0; e < 8; ++e) lg[e] = 0.f;
#pragma unroll
        for (int j = 0; j < 4; ++j) { const int col = 4 * (c.lane + 64 * j);
            const f32x4 g = *(const f32x4*)(gvec + col), sc = *(const f32x4*)(mb + 4096 + col), sh = *(const f32x4*)(mb + 3072 + col);
            const f32x4 h = v[j] * rstd * g * (sc + 1.0f) + sh;
            u32x2 w; w.x = cvt_pk_bf16(h.x, h.y); w.y = cvt_pk_bf16(h.z, h.w);
            *(u32x2*)(H4 + (size_t)row * D + col) = w;
#pragma unroll
            for (int q = 0; q < 4; ++q) { const f32x4 w0 = *(const f32x4*)(WR + (size_t)(col + q) * 8), w1 = *(const f32x4*)(WR + (size_t)(col + q) * 8 + 4); const float hv = h[q];
                lg[0] += hv * w0.x; lg[1] += hv * w0.y; lg[2] += hv * w0.z; lg[3] += hv * w0.w; lg[4] += hv * w1.x; lg[5] += hv * w1.y; lg[6] += hv * w1.z; lg[7] += hv * w1.w; } }
#pragma unroll
        for (int e = 0; e < 8; ++e) lg[e] = wave_sum(lg[e]);
        int e0 = 0; float l0 = lg[0];
#pragma unroll
        for (int e = 1; e < 8; ++e) if (lg[e] > l0) { l0 = lg[e]; e0 = e; }
        int e1 = -1; float l1 = -3.0e38f;
#pragma unroll
        for (int e = 0; e < 8; ++e) if (e != e0 && lg[e] > l1) { l1 = lg[e]; e1 = e; }
        if (c.lane == 0) { const float w0 = 1.0f / (1.0f + __expf(l1 - l0));
            tok_e[row * 2] = e0; tok_e[row * 2 + 1] = e1; tok_w[row * 2] = w0; tok_w[row * 2 + 1] = 1.0f - w0;
            atomicAdd((unsigned*)&lcnt[e0], 1u); atomicAdd((unsigned*)&lcnt[e1], 1u); }
    }
    __syncthreads();
    if (c.tid < NE) atomicAdd((unsigned*)(a.ws + WS_CTL) + c.tid, lcnt[c.tid]);
}

__device__ __forceinline__ void p13_assign(const Args& a, const Ctx& c) {
    unsigned* ctl = (unsigned*)(a.ws + WS_CTL);
    unsigned cnt[8], pst[8]; unsigned run = 0;
#pragma unroll
    for (int e = 0; e < 8; ++e) { cnt[e] = __hip_atomic_load(ctl + e, __ATOMIC_RELAXED, __HIP_MEMORY_SCOPE_AGENT); pst[e] = run; run += (cnt[e] + 255u) & ~255u; }
    if (blockIdx.x == 0 && c.tid == 0) { int* tile_e = (int*)(a.ws + WS_TILEE);
        for (int e = 0; e < 8; ++e) { const unsigned nt_ = ((cnt[e] + 255u) >> 8); for (unsigned j = 0; j < nt_; ++j) tile_e[(pst[e] >> 8) + j] = e; }
        ctl[16] = run >> 8; }
    const int* tok_e = (const int*)(a.ws + WS_ROUTE); int* tok_slot = (int*)(a.ws + WS_ROUTE + (size_t)NX * 16);
    const bf16_t* H4 = (const bf16_t*)(a.ws + R_H4); bf16_t* HP = (bf16_t*)(a.ws + R_HP);
    for (int ch = c.gw; ch < NX * 2 / 64; ch += c.NGW) {
        const int p = ch * 64 + c.lane; const int e = tok_e[p]; unsigned slot = 0;
#pragma unroll
        for (int q = 0; q < 8; ++q) { const unsigned long long m = __ballot(e == q);
            if (m) { unsigned base = 0; const int leader = __ffsll((long long)m) - 1;
                if (c.lane == leader) base = atomicAdd(ctl + 8 + q, (unsigned)__popcll(m));
                base = __shfl(base, leader);
                if (e == q) slot = pst[q] + base + (unsigned)__popcll(m & ((1ull << c.lane) - 1ull)); } }
        tok_slot[p] = (int)slot;
        for (int i = 0; i < 64; ++i) { const unsigned sl = __shfl(slot, i); const int tok = (ch * 64 + i) >> 1;
            const u32x4* s = (const u32x4*)(H4 + (size_t)tok * D); u32x4* d = (u32x4*)(HP + (size_t)sl * D);
            const u32x4 v0 = s[c.lane], v1 = s[64 + c.lane]; d[c.lane] = v0; d[64 + c.lane] = v1; }
    }
    for (int e = 0; e < 8; ++e) { const unsigned r0 = pst[e] + cnt[e], r1 = pst[e] + ((cnt[e] + 255u) & ~255u);
        for (unsigned r = r0 + c.gw; r < r1; r += c.NGW) { u32x4* d = (u32x4*)(HP + (size_t)r * D); d[c.lane] = (u32x4){0u, 0u, 0u, 0u}; d[64 + c.lane] = (u32x4){0u, 0u, 0u, 0u}; } }
}

__device__ __forceinline__ void p16_final(const Args& a, const Ctx& c) {
    const float* modl = (const float*)(a.ws + WS_MOD) + (size_t)17 * 6144; const float* fg = a.in[24];
    const float* tok_w = (const float*)(a.ws + WS_ROUTE + (size_t)NX * 8); const int* tok_slot = (const int*)(a.ws + WS_ROUTE + (size_t)NX * 16);
    const bf16_t* YS = (const bf16_t*)(a.ws + R_HP);
    for (int row = c.gw; row < NX; row += c.NGW) {
        const int b = row / SEQ; f32x4* xr = (f32x4*)(a.out + (size_t)row * D) + c.lane;
        const float w0 = tok_w[row * 2], w1 = tok_w[row * 2 + 1]; const int s0 = tok_slot[row * 2], s1 = tok_slot[row * 2 + 1];
        const u32x2* y0 = (const u32x2*)(YS + (size_t)s0 * D) + c.lane; const u32x2* y1 = (const u32x2*)(YS + (size_t)s1 * D) + c.lane;
        f32x4 v[4]; float ss = 0.f;
#pragma unroll
        for (int j = 0; j < 4; ++j) { const int col = 4 * (c.lane + 64 * j); const f32x4 g2 = *(const f32x4*)(modl + (size_t)b * 6144 + 5120 + col);
            const u32x2 a0 = y0[64 * j], a1 = y1[64 * j];
            const f32x4 ya = (f32x4){bf_lo(a0.x), bf_hi(a0.x), bf_lo(a0.y), bf_hi(a0.y)}, yb = (f32x4){bf_lo(a1.x), bf_hi(a1.x), bf_lo(a1.y), bf_hi(a1.y)};
            v[j] = xr[64 * j] + g2 * (ya * w0 + yb * w1);
            ss += (v[j].x * v[j].x + v[j].y * v[j].y) + (v[j].z * v[j].z + v[j].w * v[j].w); }
        const float rstd = rsqrtf(wave_sum(ss) * (1.0f / D) + EPS);
#pragma unroll
        for (int j = 0; j < 4; ++j) { const int col = 4 * (c.lane + 64 * j); xr[64 * j] = v[j] * rstd * *(const f32x4*)(fg + col); }
    }
}

__global__ void __launch_bounds__(NTHREADS, 2) trunk_fwd(Args a) {
    extern __shared__ __attribute__((aligned(16))) unsigned char lds_raw[];
    Ctx c; c.lds = (LAS unsigned char*)lds_raw; c.tid = threadIdx.x; c.lane = c.tid & 63; c.wave = __builtin_amdgcn_readfirstlane(c.tid >> 6);
    c.G = gridDim.x; c.gw = blockIdx.x * NWAVES + c.wave; c.NGW = c.G * NWAVES;
    unsigned char* ws = a.ws;
    const float* mod0 = (const float*)(ws + WS_MOD); const float* mod1 = mod0 + (size_t)17 * 6144;
    float* ZR = (float*)(ws + WS_ZRES);
    const int lo = a.ph_lo, hi = a.ph_hi;
#define IN(k) (lo <= (k) && (k) < hi)
#define SEAM(k) do { if (IN(k) && IN((k) + 1)) { cg::this_grid().sync(); } } while (0)

    if (IN(0)) { p0_adaln(a, c); p0_convert(a, c); } SEAM(0);
    if (IN(1)) { p1_pool_prep(a, c); } SEAM(1);
    if (IN(2)) {
        pg8::Prob P{(const bf16_t*)(ws + R_HB), (const bf16_t*)(ws + W_POOLT), NT / 256, 4, 256, D, 256, 1, 0, nullptr, 0, c.G, (int)blockIdx.x};
        pg8::EpiResid E{a.in[0], a.out, a.in[2], ZR, mod0 + 2048, a.in[9]};
        pg8::gemm_phase(c.lds, P, E);
    } SEAM(2);
    if (IN(3)) { norm_mod_rows(a.out, ZR, NT, a.in[7], mod0, 3072, 4096, (bf16_t*)(ws + R_HB), c); } SEAM(3);
    if (IN(4)) {
        pg8::Prob P{(const bf16_t*)(ws + R_HB), (const bf16_t*)(ws + W_GUT), NT / 256, 2 * DFF / 256, D, D, D, 0, 0, nullptr, 0, c.G, (int)blockIdx.x};
        pg8::EpiSwiGLU E{(bf16_t*)(ws + R_HID), DFF};
        pg8::gemm_phase(c.lds, P, E);
    } SEAM(4);
    if (IN(5)) {
        pg8::Prob P{(const bf16_t*)(ws + R_HID), (const bf16_t*)(ws + W_DT), NT / 256, D / 256, DFF, DFF, DFF, 0, 0, nullptr, 0, c.G, (int)blockIdx.x};
        pg8::EpiResid E{a.out, a.out, ZR, ZR, mod0 + 5120, nullptr};
        pg8::gemm_phase(c.lds, P, E);
    } SEAM(5);
    if (IN(6)) { norm_mod_rows(a.out, ZR, NT, a.in[6] + D, mod1, 0, 1024, (bf16_t*)(ws + R_H3), c); } SEAM(6);
    if (IN(7)) {
        pg8::Prob P{(const bf16_t*)(ws + R_H3), (const bf16_t*)(ws + W_INT), NT / 256, 2 * DR / 256, D, D, D, 0, 0, nullptr, 0, c.G, (int)blockIdx.x};
        pg8::EpiBf16 E{(bf16_t*)(ws + R_GU2), 2 * DR};
        pg8::gemm_phase(c.lds, P, E);
    } SEAM(7);
    if (IN(8)) { p8_conv(a, c); } SEAM(8);
    if (IN(9)) {
        pg8::Prob P{(const bf16_t*)(ws + R_UC), (const bf16_t*)(ws + W_GT), NT / 256, 20, 256, DR, 256, 1, 2, nullptr, 0, c.G, (int)blockIdx.x};
        pg8::EpiGate E{(const bf16_t*)(ws + R_UC), (bf16_t*)(ws + R_LAF), (bf16_t*)(ws + R_BF), (size_t)(R_LAR - R_LAF) / 2, a.in[16], a.in[18], a.in[19]};
        pg8::gemm_phase(c.lds, P, E);
    } SEAM(9);
    if (IN(10)) { p10a_chunk_sums(a, c); } SEAM(10);
    if (IN(11)) { p10c_scan(a, c); } SEAM(11);
    if (IN(12)) {
        pg8::Prob P{(const bf16_t*)(ws + R_BR), (const bf16_t*)(ws + W_OUTT), NX / 256, D / 256, DR, DR, DR, 0, 0, nullptr, 0, c.G, (int)blockIdx.x};
        pg8::EpiResid E{a.out, a.out, ZR, ZR, mod1 + 2048, nullptr};
        pg8::gemm_phase(c.lds, P, E);
    } SEAM(12);
    if (IN(13)) { p12_route(a, c); } SEAM(13);
    if (IN(14)) { p13_assign(a, c); } SEAM(14);
    if (IN(15)) {
        const int mt = (int)__hip_atomic_load((unsigned*)(ws + WS_CTL) + 16, __ATOMIC_RELAXED, __HIP_MEMORY_SCOPE_AGENT);
        pg8::Prob P{(const bf16_t*)(ws + R_HP), (const bf16_t*)(ws + W_MGUT), mt, 2 * DE / 256, D, D, D, 0, 0, (const int*)(ws + WS_TILEE), (size_t)2 * DE * D, c.G, (int)blockIdx.x};
        pg8::EpiSwiGLU E{(bf16_t*)(ws + R_MH), DE};
        pg8::gemm_phase(c.lds, P, E);
    } SEAM(15);
    if (IN(16)) {
        const int mt = (int)__hip_atomic_load((unsigned*)(ws + WS_CTL) + 16, __ATOMIC_RELAXED, __HIP_MEMORY_SCOPE_AGENT);
        pg8::Prob P{(const bf16_t*)(ws + R_MH), (const bf16_t*)(ws + W_MDT), mt, D / 256, DE, DE, DE, 0, 0, (const int*)(ws + WS_TILEE), (size_t)D * DE, c.G, (int)blockIdx.x};
        pg8::EpiBf16 E{(bf16_t*)(ws + R_HP), D};
        pg8::gemm_phase(c.lds, P, E);
    } SEAM(16);
    if (IN(17)) { p16_final(a, c); }
#undef IN
#undef SEAM
}

constexpr int LDS_BYTES = 147456;
extern "C" void kernel_launch(void* const* d_in, const int* in_sizes, int n_in, void* d_out, int out_size, void* d_ws, size_t ws_size, hipStream_t stream) {
    static int grid = 0;
    if (grid == 0) {
        if (n_in != 25 || out_size != NX * D || ws_size < WS_NEED) { fprintf(stderr, "kernel_launch: unexpected shapes (n_in %d out %d ws %zu, need %zu)\n", n_in, out_size, ws_size, (size_t)WS_NEED); grid = -1; return; }
        int dev = 0, cus = 0, per_cu = 0;
        hipGetDevice(&dev); hipDeviceGetAttribute(&cus, hipDeviceAttributeMultiprocessorCount, dev);
        if (hipFuncSetAttribute((const void*)trunk_fwd, hipFuncAttributeMaxDynamicSharedMemorySize, LDS_BYTES) != hipSuccess) { fprintf(stderr, "kernel_launch: hipFuncSetAttribute failed\n"); grid = -1; return; }
        if (hipOccupancyMaxActiveBlocksPerMultiprocessor(&per_cu, (const void*)trunk_fwd, NTHREADS, LDS_BYTES) != hipSuccess || per_cu < 1) { fprintf(stderr, "kernel_launch: occupancy query says %d\n", per_cu); per_cu = 1; }
        (void)hipGetLastError();
        grid = cus;
    }
    if (grid < 0) return;
    hipMemsetAsync((char*)d_ws + WS_CTL, 0, CTL_BYTES, stream);
    Args a{};
    for (int i = 0; i < 25; ++i) a.in[i] = (const float*)d_in[i];
    a.out = (float*)d_out; a.ws = (unsigned char*)d_ws;
#if MK_SINGLE
    a.ph_lo = 0; a.ph_hi = NPHASES + 1;
    void* args[] = {&a};
    hipError_t e = hipLaunchCooperativeKernel((const void*)trunk_fwd, dim3(grid), dim3(NTHREADS), args, LDS_BYTES, stream);
    if (e != hipSuccess) fprintf(stderr, "cooperative launch failed: %s (grid %d)\n", hipGetErrorString(e), grid);
#else
    for (int ph = 0; ph <= NPHASES; ++ph) { a.ph_lo = ph; a.ph_hi = ph + 1;
        hipLaunchKernelGGL(trunk_fwd, dim3(grid), dim3(NTHREADS), LDS_BYTES, stream, a); }
#endif
}
```

```cpp
#include <hip/hip_runtime.h>
#include <cstdio>
#include <cstdint>

#define LAS __attribute__((address_space(3)))
typedef unsigned short bf16_t;
typedef short bf16x8 __attribute__((ext_vector_type(8)));
typedef float f32x4 __attribute__((ext_vector_type(4)));
typedef float f32x2 __attribute__((ext_vector_type(2)));
typedef unsigned u32x4 __attribute__((ext_vector_type(4)));
typedef unsigned u32x2 __attribute__((ext_vector_type(2)));
typedef int i32x4 __attribute__((ext_vector_type(4)));
typedef int i32x8 __attribute__((ext_vector_type(8)));

#ifndef MK_SINGLE
#define MK_SINGLE 1
#endif

constexpr int D = 1024, NB = 16, SEQ = 2048, CL = 256, NX = NB * SEQ, NZ = NB * CL, NT = NX + NZ;
constexpr int DFF = 2816, DR = 1280, DE = 3584, NE = 8;
constexpr int NSLOT = (NX * 2 / 256 + NE) * 256;
constexpr int NWAVES = 8, NTHREADS = 512;
constexpr float EPS = 1e-6f;
constexpr int NPHASES = 18;
constexpr int LDS_BYTES = 147456;

constexpr size_t MiB = 1024 * 1024;
constexpr size_t WS_CTL = 0;
constexpr size_t CTL_BYTES = 32768;
constexpr size_t WS_BAR = 16384;
constexpr size_t WS_TILEE = 8192;
constexpr size_t WS_MOD = 64 * 1024;
constexpr size_t WS_SP = 900 * 1024;
constexpr size_t WS_ROUTE = 1 * MiB;
constexpr size_t WS_SLOTTOK = 2 * MiB;
constexpr size_t WS_CHUNK = 3 * MiB;
constexpr size_t WS_ZRES = 9 * MiB;
constexpr size_t WS_W = 25 * MiB;
constexpr size_t W_POOLT = WS_W;
constexpr size_t W_GUT = W_POOLT + (size_t)1024 * 256 * 2;
constexpr size_t W_DT = W_GUT + (size_t)5632 * 1024 * 2;
constexpr size_t W_INT = W_DT + (size_t)1024 * 2816 * 2;
constexpr size_t W_GT = W_INT + (size_t)2560 * 1024 * 2;
constexpr size_t W_OUTT = W_GT + (size_t)5120 * 256 * 2;
constexpr size_t W_MGUT = W_OUTT + (size_t)1024 * 1280 * 2;
constexpr size_t W_MDT = W_MGUT + (size_t)8 * 7168 * 1024 * 2;
constexpr size_t W_END = W_MDT + (size_t)8 * 1024 * 3584 * 2;
constexpr size_t WS_R = 221 * MiB;
static_assert(W_END <= WS_R, "weights overflow");
constexpr size_t R_HB = WS_R;
constexpr size_t R_HID = WS_R + 72 * MiB;
constexpr size_t R_GU2 = WS_R;
constexpr size_t R_Y = WS_R + 180 * MiB;
constexpr size_t R_H3 = WS_R + 270 * MiB;
constexpr size_t R_LABG = WS_R + 270 * MiB;
constexpr size_t R_HP = WS_R;
constexpr size_t R_MH = WS_R + 132 * MiB;
constexpr size_t R_H4 = WS_R;
constexpr size_t WS_NEED = WS_R + 630 * MiB;
static_assert(R_MH + (size_t)NSLOT * DE * 2 <= WS_NEED, "MH overflow");
static_assert(WS_NEED <= (size_t)896 * MiB, "workspace");

__device__ __forceinline__ unsigned cvt_pk_bf16(float lo, float hi) { unsigned r; asm volatile("v_cvt_pk_bf16_f32 %0, %1, %2" : "=v"(r) : "v"(lo), "v"(hi)); return r; }
__device__ __forceinline__ unsigned pk4_fp8(float a, float b, float c, float d) { int w = 0; w = __builtin_amdgcn_cvt_pk_fp8_f32(a, b, w, false); w = __builtin_amdgcn_cvt_pk_fp8_f32(c, d, w, true); return (unsigned)w; }
constexpr float W8_SCALE = 64.0f;
__device__ __forceinline__ float bf_lo(unsigned u) { return __uint_as_float(u << 16); }
__device__ __forceinline__ float bf_hi(unsigned u) { return __uint_as_float(u & 0xffff0000u); }
__device__ __forceinline__ float wave_sum(float v) {
#pragma unroll
    for (int o = 1; o < 64; o <<= 1) v += __shfl_xor(v, o);
    return v;
}
__device__ __forceinline__ float fast_exp(float x) { return __builtin_amdgcn_exp2f(x * 1.44269504089f); }
__device__ __forceinline__ float sigmoidf_(float x) { return __builtin_amdgcn_rcpf(1.0f + fast_exp(-x)); }
__device__ __forceinline__ float siluf_(float x) { return x * sigmoidf_(x); }
__device__ __forceinline__ float gelu_tanh(float x) {
    const float u = 0.7978845608f * (x + 0.044715f * x * x * x);
    const float t = 1.0f - 2.0f * __builtin_amdgcn_rcpf(fast_exp(2.0f * u) + 1.0f);
    return 0.5f * x * (1.0f + t);
}

#ifdef PROBE_SUB
#define SUBT0(id) do { if ((id) == PROBE_SUB) psub_t0 = __builtin_amdgcn_s_memrealtime(); } while (0)
#define SUBT1(id) do { if ((id) == PROBE_SUB) psub_acc += __builtin_amdgcn_s_memrealtime() - psub_t0; } while (0)
#define SUBDECL unsigned long long psub_t0 = 0, psub_acc = 0
#define SUBSPIN do { const unsigned long long te_ = __builtin_amdgcn_s_memrealtime(); while (__builtin_amdgcn_s_memrealtime() - te_ < psub_acc) __builtin_amdgcn_s_sleep(8); } while (0)
#else
#define SUBT0(id) do { } while (0)
#define SUBT1(id) do { } while (0)
#define SUBDECL do { } while (0)
#define SUBSPIN do { } while (0)
#endif
namespace pg8 {
constexpr int BM = 256, BK = 64, HALF = 128, HTB = HALF * BK * 2, STAGE_BYTES = 8 * HTB, NXCD = 8, WGM = 8;
__device__ __forceinline__ int lds_byte(int r, int c) { const int st = (r >> 4) * 2 + (c >> 5), rr = r & 15, cc = c & 31, ob = rr * 64 + cc * 2; return st * 1024 + (ob ^ (((ob >> 9) & 1) << 5)); }
__device__ __forceinline__ void stage_rc(int b, int& R, int& C) { const int st = b / 1024, sb = b % 1024, swz = sb ^ (((sb >> 9) & 1) << 5); R = (st >> 1) * 16 + swz / 64; C = (st & 1) * 32 + (swz % 64) / 2; }
__device__ __forceinline__ int perm32(int rho) { const int n = rho >> 4, i = rho & 15; return 8 * (i >> 2) + 4 * n + (i & 3); }

struct Unit { int pm, pn; const char* A; const char* B; };

struct Prob {
    const bf16_t* A; const bf16_t* Bt; int nM, nN, K, lda, ldb;
    int grp, kshr;
    const int* tile_e; size_t estride;
    const int* rowidx;
    int G, c;
    int pm_off = 0;
    int esz = 2;
    __device__ __forceinline__ bool next(int i, Unit& u) const {
        const int nwg = nM * nN; const long L = (long)i * G + c; if (L >= nwg) return false;
        int wgid = (int)L; { const int q = nwg / NXCD, r = nwg % NXCD, xcd = wgid % NXCD, off = wgid / NXCD; wgid = (xcd < r ? xcd * (q + 1) : r * (q + 1) + (xcd - r) * q) + off; }
        const int nig = WGM * nN, gid = wgid / nig, fm = gid * WGM, gsz = (nM - fm) < WGM ? (nM - fm) : WGM;
        u.pm = fm + ((wgid % nig) % gsz) + pm_off; u.pn = (wgid % nig) / gsz;
        u.A = rowidx ? (const char*)A : (const char*)A + ((size_t)u.pm * BM * lda + (grp ? (size_t)((u.pn >> kshr) * 256) : (size_t)0)) * esz;
        size_t bo = (size_t)u.pn * BM * ldb;
        if (tile_e) bo += (size_t)tile_e[u.pm] * estride;
        u.B = (const char*)Bt + bo * esz;
        return true;
    }
};

struct EpiBf16 {
    static constexpr bool PERM = true;
    bf16_t* O; int ldc; float sc = 1.0f;
    __device__ __forceinline__ void operator()(const f32x4 (&acc)[2][2][4][2], const Unit& u, int wr, int wc, int fr, int fq) const {
        const int row0 = u.pm * BM + wr * 64 + fr, col0 = u.pn * BM + wc * 32 + 8 * fq;
#pragma unroll
        for (int ai = 0; ai < 2; ++ai)
#pragma unroll
            for (int m = 0; m < 4; ++m) { bf16_t* rowp = O + (size_t)(row0 + ai * HALF + m * 16) * ldc + col0;
#pragma unroll
                for (int bj = 0; bj < 2; ++bj) { const f32x4 v0 = acc[ai][bj][m][0] * sc, v1 = acc[ai][bj][m][1] * sc;
                    u32x4 w; w.x = cvt_pk_bf16(v0[0], v0[1]); w.y = cvt_pk_bf16(v0[2], v0[3]); w.z = cvt_pk_bf16(v1[0], v1[1]); w.w = cvt_pk_bf16(v1[2], v1[3]);
                    __builtin_nontemporal_store(w, (u32x4*)(rowp + bj * HALF)); } }
    }
};
struct EpiSwiGLU {
    static constexpr bool PERM = true;
    bf16_t* O; int ldc;
    __device__ __forceinline__ void operator()(const f32x4 (&acc)[2][2][4][2], const Unit& u, int wr, int wc, int fr, int fq) const {
        const int row0 = u.pm * BM + wr * 64 + fr, col0 = u.pn * HALF + wc * 32 + 8 * fq;
#pragma unroll
        for (int ai = 0; ai < 2; ++ai)
#pragma unroll
            for (int m = 0; m < 4; ++m) { bf16_t* rowp = O + (size_t)(row0 + ai * HALF + m * 16) * ldc + col0;
                float v[8];
#pragma unroll
                for (int n = 0; n < 2; ++n)
#pragma unroll
                    for (int j = 0; j < 4; ++j) v[n * 4 + j] = siluf_(acc[ai][0][m][n][j]) * acc[ai][1][m][n][j];
                u32x4 w; w.x = cvt_pk_bf16(v[0], v[1]); w.y = cvt_pk_bf16(v[2], v[3]); w.z = cvt_pk_bf16(v[4], v[5]); w.w = cvt_pk_bf16(v[6], v[7]);
                *(u32x4*)rowp = w; }
    }
};
struct EpiSwiGLU8 {
    static constexpr bool PERM = true;
    unsigned char* O; int ldc;
    __device__ __forceinline__ void operator()(const f32x4 (&acc)[2][2][4][2], const Unit& u, int wr, int wc, int fr, int fq) const {
        const int row0 = u.pm * BM + wr * 64 + fr, col0 = u.pn * HALF + wc * 32 + 8 * (fq & ~1); const bool odd = fq & 1;
#pragma unroll
        for (int ai = 0; ai < 2; ++ai)
#pragma unroll
            for (int mp = 0; mp < 2; ++mp) { u32x2 w[2];
#pragma unroll
                for (int q = 0; q < 2; ++q) { const int m = 2 * mp + q; float v[8];
#pragma unroll
                    for (int n = 0; n < 2; ++n)
#pragma unroll
                        for (int j = 0; j < 4; ++j) v[n * 4 + j] = siluf_(acc[ai][0][m][n][j]) * acc[ai][1][m][n][j];
                    w[q].x = pk4_fp8(v[0], v[1], v[2], v[3]); w[q].y = pk4_fp8(v[4], v[5], v[6], v[7]); }
                const u32x2 send = odd ? w[0] : w[1];
                u32x2 recv; recv.x = (unsigned)__shfl_xor((int)send.x, 16); recv.y = (unsigned)__shfl_xor((int)send.y, 16);
                const int m = 2 * mp + (odd ? 1 : 0);
                u32x4 o; if (odd) { o.x = recv.x; o.y = recv.y; o.z = w[1].x; o.w = w[1].y; } else { o.x = w[0].x; o.y = w[0].y; o.z = recv.x; o.w = recv.y; }
                __builtin_nontemporal_store(o, (u32x4*)(O + (size_t)(row0 + ai * HALF + m * 16) * ldc + col0)); }
    }
};
struct EpiResid {
    static constexpr bool PERM = false;
    const float* xb; float* xo; const float* zb; float* zo; const float* gate  ; const float* colscale; float sc = 1.0f;
    __device__ __forceinline__ void operator()(const f32x4 (&acc)[2][2][4][2], const Unit& u, int wr, int wc, int fr, int fq) const {
        const bool isx = u.pm < NX / BM; const int b = isx ? (u.pm >> 3) : NB;
        const float* base = isx ? xb + (size_t)u.pm * BM * D : zb + (size_t)(u.pm - NX / BM) * BM * D;
        float* out = isx ? xo + (size_t)u.pm * BM * D : zo + (size_t)(u.pm - NX / BM) * BM * D;
        const int col0 = u.pn * BM + wc * 32 + 4 * fq;
        f32x4 gv[2][2];
#pragma unroll
        for (int bj = 0; bj < 2; ++bj)
#pragma unroll
            for (int n = 0; n < 2; ++n) { const int col = col0 + bj * HALF + n * 16; gv[bj][n] = *(const f32x4*)(gate + (size_t)b * 6144 + col) * sc; if (colscale) gv[bj][n] = gv[bj][n] * *(const f32x4*)(colscale + col); }
#pragma unroll
        for (int ai = 0; ai < 2; ++ai)
#pragma unroll
            for (int m = 0; m < 4; ++m) { const size_t off = (size_t)(ai * HALF + wr * 64 + m * 16 + fr) * D + col0;
#pragma unroll
                for (int bj = 0; bj < 2; ++bj)
#pragma unroll
                    for (int n = 0; n < 2; ++n) { const f32x4 bs = *(const f32x4*)(base + off + bj * HALF + n * 16);
                        *(f32x4*)(out + off + bj * HALF + n * 16) = bs + gv[bj][n] * acc[ai][bj][m][n]; } }
    }
};
template <class Epi, bool GATHER = false, bool FP8 = false>
__device__ __forceinline__ void gemm_phase(LAS unsigned char* lds, const Prob& S, const Epi& E) {
    const int tid = threadIdx.x, wid = __builtin_amdgcn_readfirstlane(tid >> 6), lane = tid & 63, wr = wid >> 2, wc = wid & 3, fr = lane & 15, fq = lane >> 4;
    const int ESZ = FP8 ? 1 : 2;
    const int K = S.K, nt = K * ESZ / (BK * 2);
    unsigned voffA[2], voffB[2];
#pragma unroll
    for (int i = 0; i < 2; ++i) { int R, C; stage_rc(tid * 16 + i * 8192, R, C); const int Rb = Epi::PERM ? ((R & ~31) + perm32(R & 31)) : R;
        voffA[i] = (unsigned)(R * S.lda * ESZ + C * 2); voffB[i] = (unsigned)(Rb * S.ldb * ESZ + C * 2); }
    const size_t kstep = (size_t)(BK * 2);
    const size_t hstepA = GATHER ? (size_t)0 : (size_t)HALF * S.lda * ESZ, hstepB = (size_t)HALF * S.ldb * ESZ;
    unsigned gc[2][2], gn[2][2];
#define PG8_GLOAD(dst, pm_) do { _Pragma("unroll") for (int _i = 0; _i < 2; ++_i) { int R_, C_; stage_rc(tid * 16 + _i * 8192, R_, C_); _Pragma("unroll") for (int _h = 0; _h < 2; ++_h) \
        dst[_h][_i] = (unsigned)S.rowidx[(pm_) * BM + _h * HALF + R_] * (unsigned)(S.lda * ESZ) + (unsigned)(C_ * 2); } } while (0)
    const unsigned ldsw = (unsigned)wid * 1024u;
    const int aoff = lds_byte(wr * 64 + fr, fq * 8), boff = lds_byte(wc * 32 + fr, fq * 8);
#define PG8_SA(b, h) (((b) * 2 + (h)) * HTB)
#define PG8_SB(b, h) ((4 + (b) * 2 + (h)) * HTB)
#define PG8_STAGE(bufoff, gbase, voff) do { _Pragma("unroll") for (int _i = 0; _i < 2; ++_i) \
        __builtin_amdgcn_global_load_lds((const unsigned*)((const char*)(gbase) + (voff)[_i]), (LAS unsigned*)(lds + (bufoff) + ldsw + _i * 8192), 16, 0, 0); } while (0)
#define PG8_STAGEA(bufoff, gbase, h, offs) do { if constexpr (GATHER) { PG8_STAGE(bufoff, gbase, offs[h]); } else { PG8_STAGE(bufoff, (gbase) + (h) * hstepA, voffA); } } while (0)
#define PG8_STAGEA2(bufoff, gbase, h) do { if constexpr (GATHER) { unsigned o_[2] = {last ? gn[h][0] : gc[h][0], last ? gn[h][1] : gc[h][1]}; PG8_STAGE(bufoff, gbase, o_); } else { PG8_STAGE(bufoff, (gbase) + (h) * hstepA, voffA); } } while (0)
#define PG8_LD32(p_) __builtin_shufflevector(*(const LAS i32x4*)(p_), *(const LAS i32x4*)((p_) + 1024), 0, 1, 2, 3, 4, 5, 6, 7)
#define PG8_LDA(dst, b, h) do { if constexpr (FP8) { _Pragma("unroll") for (int m = 0; m < 4; ++m) dst##8[m] = PG8_LD32(lds + PG8_SA(b, h) + aoff + m * 2048); } \
        else { _Pragma("unroll") for (int m = 0; m < 4; ++m) _Pragma("unroll") for (int k = 0; k < 2; ++k) dst[m][k] = *(const LAS bf16x8*)(lds + PG8_SA(b, h) + aoff + m * 2048 + k * 1024); } } while (0)
#define PG8_LDB(dst, b, h) do { if constexpr (FP8) { _Pragma("unroll") for (int n = 0; n < 2; ++n) dst##8[n] = PG8_LD32(lds + PG8_SB(b, h) + boff + n * 2048); } \
        else { _Pragma("unroll") for (int n = 0; n < 2; ++n) _Pragma("unroll") for (int k = 0; k < 2; ++k) dst[n][k] = *(const LAS bf16x8*)(lds + PG8_SB(b, h) + boff + n * 2048 + k * 1024); } } while (0)
#define PG8_MMA(ai, bj, At, Bt) do { __builtin_amdgcn_s_setprio(1); \
        if constexpr (FP8) { _Pragma("unroll") for (int m = 0; m < 4; ++m) _Pragma("unroll") for (int n = 0; n < 2; ++n) \
            asm volatile("v_mfma_scale_f32_16x16x128_f8f6f4 %0, %1, %2, %0, %3, %4 op_sel_hi:[0,0,0]" : "+v"(acc[ai][bj][m][n]) : "v"(Bt##8[n]), "v"(At##8[m]), "v"(scalew), "v"(scale1)); } \
        else { _Pragma("unroll") for (int m = 0; m < 4; ++m) _Pragma("unroll") for (int n = 0; n < 2; ++n) _Pragma("unroll") for (int k = 0; k < 2; ++k) \
            acc[ai][bj][m][n] = __builtin_amdgcn_mfma_f32_16x16x32_bf16(Bt[n][k], At[m][k], acc[ai][bj][m][n], 0, 0, 0); } \
        __builtin_amdgcn_s_setprio(0); } while (0)
#define PG8_WAIT_V(n) asm volatile("s_waitcnt vmcnt(" #n ")" ::: "memory")
#define PG8_WAIT_L(n) asm volatile("s_waitcnt lgkmcnt(" #n ")" ::: "memory")
#define PG8_BAR __builtin_amdgcn_s_barrier()
#define PG8_SCHED __builtin_amdgcn_sched_barrier(0)
    SUBDECL;
    Unit cur, nxt; int ui = 0;
    if (!S.next(0, cur)) return;
    f32x4 acc[2][2][4][2];
#pragma unroll
    for (int a = 0; a < 2; ++a)
#pragma unroll
        for (int b = 0; b < 2; ++b)
#pragma unroll
            for (int m = 0; m < 4; ++m)
#pragma unroll
                for (int n = 0; n < 2; ++n) acc[a][b][m][n] = (f32x4){0.f, 0.f, 0.f, 0.f};
    int scale1 = 0x7F7F7F7F, scalew = 0x79797979; asm volatile("" : "+v"(scale1), "+v"(scalew));
    bf16x8 At[4][2], B0[2][2], B1[2][2]; i32x8 At8[4], B08[2], B18[2];
    const char* cA = cur.A; const char* cB = cur.B;
    if constexpr (GATHER) { PG8_GLOAD(gc, cur.pm); asm volatile("s_waitcnt vmcnt(0)" ::: "memory"); }
    PG8_STAGE(PG8_SB(0, 0), cB, voffB); PG8_STAGE(PG8_SB(0, 1), cB + hstepB, voffB); PG8_STAGEA(PG8_SA(0, 0), cA, 0, gc); PG8_STAGEA(PG8_SA(0, 1), cA, 1, gc);
    if (wr == 1) PG8_BAR;
    PG8_WAIT_V(2); PG8_BAR;
    PG8_STAGE(PG8_SB(1, 0), cB + kstep, voffB); PG8_STAGEA(PG8_SA(1, 0), cA + kstep, 0, gc); PG8_STAGE(PG8_SB(1, 1), cB + hstepB + kstep, voffB);
    PG8_WAIT_V(6); PG8_BAR;
    for (;;) {
        const bool has_next = S.next(ui + 1, nxt);
        const char* nA = has_next ? nxt.A : cA; const char* nB = has_next ? nxt.B : cB;
        if constexpr (GATHER) { PG8_GLOAD(gn, (has_next ? nxt.pm : cur.pm)); asm volatile("s_waitcnt vmcnt(0)" ::: "memory"); }
        for (int t = 0; t < nt; t += 2) {
            const bool last = (t == nt - 2);
            const char* a1 = cA + (size_t)(t + 1) * kstep;
            const char* a2 = last ? nA : cA + (size_t)(t + 2) * kstep; const char* b2 = last ? nB : cB + (size_t)(t + 2) * kstep;
            const char* a3 = a2 + kstep; const char* b3 = b2 + kstep;
            PG8_LDB(B0, 0, 0); PG8_LDB(B1, 0, 1); PG8_SCHED; PG8_LDA(At, 0, 0); PG8_STAGEA(PG8_SA(1, 1), a1, 1, gc);
            PG8_WAIT_V(8); PG8_WAIT_L(0); PG8_BAR; PG8_MMA(0, 0, At, B0); PG8_MMA(0, 1, At, B1); PG8_BAR; PG8_SCHED;
            PG8_LDA(At, 0, 1); PG8_STAGE(PG8_SB(0, 0), b2, voffB); PG8_STAGE(PG8_SB(0, 1), b2 + hstepB, voffB); PG8_STAGEA2(PG8_SA(0, 0), a2, 0);
            PG8_WAIT_V(8); PG8_WAIT_L(0); PG8_BAR; PG8_MMA(1, 0, At, B0); PG8_MMA(1, 1, At, B1); PG8_BAR; PG8_SCHED;
            PG8_LDB(B0, 1, 0); PG8_LDB(B1, 1, 1); PG8_SCHED; PG8_LDA(At, 1, 0); PG8_STAGEA2(PG8_SA(0, 1), a2, 1);
            PG8_WAIT_V(8); PG8_WAIT_L(0); PG8_BAR; PG8_MMA(0, 0, At, B0); PG8_MMA(0, 1, At, B1); PG8_BAR; PG8_SCHED;
            PG8_LDA(At, 1, 1); PG8_STAGE(PG8_SB(1, 0), b3, voffB); PG8_STAGE(PG8_SB(1, 1), b3 + hstepB, voffB); PG8_STAGEA2(PG8_SA(1, 0), a3, 0);
            PG8_WAIT_V(8); PG8_WAIT_L(0); PG8_BAR; PG8_MMA(1, 0, At, B0); PG8_MMA(1, 1, At, B1); PG8_BAR; PG8_SCHED;
        }
        if (wr == 0) PG8_BAR;
        if constexpr (FP8) asm volatile("s_nop 15\n\ts_nop 15" ::: "memory");
        if constexpr (FP8 && GATHER) SUBT0(10);
        E(acc, cur, wr, wc, fr, fq);
        if constexpr (FP8 && GATHER) SUBT1(10);
        if (!has_next) break;
#pragma unroll
        for (int a = 0; a < 2; ++a)
#pragma unroll
            for (int b = 0; b < 2; ++b)
#pragma unroll
                for (int m = 0; m < 4; ++m)
#pragma unroll
                    for (int n = 0; n < 2; ++n) acc[a][b][m][n] = (f32x4){0.f, 0.f, 0.f, 0.f};
        cur = nxt; cA = nA; cB = nB; ++ui;
        if constexpr (GATHER) {
#pragma unroll
            for (int _h = 0; _h < 2; ++_h)
#pragma unroll
                for (int _i = 0; _i < 2; ++_i) gc[_h][_i] = gn[_h][_i]; }
        if (wr == 1) PG8_BAR;
    }
    PG8_WAIT_V(0);
    PG8_BAR;
    if constexpr (FP8 && GATHER) SUBSPIN;
#undef PG8_SA
#undef PG8_SB
#undef PG8_STAGE
#undef PG8_STAGEA
#undef PG8_STAGEA2
#undef PG8_GLOAD
#undef PG8_LDA
#undef PG8_LDB
#undef PG8_MMA
#undef PG8_LD32
#undef PG8_WAIT_V
#undef PG8_WAIT_L
#undef PG8_BAR
#undef PG8_SCHED
}
}


#define XB_TMO      128
#define XB_XCNT(j)  (256  + 64 * (j))
#define XB_XSUB(j)  (1280 + 64 * (j))
#define XB_XGEN(j)  (2304 + 64 * (j))
#define XB_TOP      3328
#define XB_TOPGEN   3392
#define XCD_BAR_WORDS 3456
#define XB_SPIN_CAP (1u << 20)
__device__ __forceinline__ unsigned xb_ld(unsigned* p)              { return __hip_atomic_load(p, __ATOMIC_RELAXED, __HIP_MEMORY_SCOPE_AGENT); }
__device__ __forceinline__ unsigned xb_add(unsigned* p, unsigned v) { return __hip_atomic_fetch_add(p, v, __ATOMIC_RELAXED, __HIP_MEMORY_SCOPE_AGENT); }
__device__ __forceinline__ unsigned xb_xcc_id() { return (unsigned)__builtin_amdgcn_s_getreg((3 << 11) | 20) & 0xFu; }
#define XB_SPIN(cond, bar) do { unsigned _sp = 0; while (cond) { __builtin_amdgcn_s_sleep(1); \
    if ((++_sp & 255u) == 0u) { if (xb_ld(&(bar)[XB_TMO])) break; if (_sp > XB_SPIN_CAP) { atomicAdd(&(bar)[XB_TMO], 1u); break; } } } } while (0)
struct XcdBarrier { unsigned* bar; unsigned x; volatile LAS unsigned* st; };
__device__ __forceinline__ XcdBarrier xcd_barrier_post(unsigned* bar, volatile LAS unsigned* st) {
    XcdBarrier b; b.bar = bar; b.x = xb_xcc_id(); b.st = st;
    if (threadIdx.x == 0) (void)xb_add(&bar[XB_XCNT(b.x)], 1u);
    return b;
}
__device__ __forceinline__ void xcd_barrier_complete(unsigned* bar, unsigned x, unsigned& nloc, unsigned& nx) {
    const unsigned G = gridDim.x * gridDim.y * gridDim.z;
    unsigned sum, cnt, mine, sp = 0u;
    for (;;) {
        sum = 0u; cnt = 0u; mine = 0u;
#pragma unroll
        for (unsigned j = 0; j < 16; ++j) { const unsigned c = xb_ld(&bar[XB_XCNT(j)]); sum += c; cnt += (c > 0u) ? 1u : 0u; mine = (j == x) ? c : mine; }
        if (sum == G) break;
        __builtin_amdgcn_s_sleep(1);
        if ((++sp & 255u) == 0u) { if (xb_ld(&bar[XB_TMO])) break; if (sp > XB_SPIN_CAP) { atomicAdd(&bar[XB_TMO], 1u); break; } }
    }
    nloc = mine > 0u ? mine : 1u; nx = cnt > 0u ? cnt : 1u;
}
__device__ __forceinline__ void xcd_barrier(const XcdBarrier& b) {
    asm volatile("s_waitcnt vmcnt(0)" ::: "memory");
    __syncthreads();
    if (threadIdx.x == 0) {
        unsigned* bar = b.bar;
        __builtin_amdgcn_s_waitcnt(0);
        unsigned nloc = b.st[0], nx = b.st[1];
        if (nloc == 0u) { xcd_barrier_complete(bar, b.x, nloc, nx); b.st[0] = nloc; b.st[1] = nx; }
        const unsigned old = xb_add(&bar[XB_XSUB(b.x)], 1u);
        const unsigned gen = old / nloc;
        if (old + 1u == (gen + 1u) * nloc) {
            __builtin_amdgcn_fence(__ATOMIC_RELEASE, "agent");
            asm volatile("s_waitcnt vmcnt(0)" ::: "memory");
            const unsigned og = xb_add(&bar[XB_TOP], 1u);
            const unsigned tg = og / nx;
            if (og + 1u == (tg + 1u) * nx) xb_add(&bar[XB_TOPGEN], 1u);
            else XB_SPIN(xb_ld(&bar[XB_TOPGEN]) == tg, bar);
            __builtin_amdgcn_fence(__ATOMIC_ACQUIRE, "agent");
            xb_add(&bar[XB_XGEN(b.x)], 1u);
            asm volatile("s_waitcnt vmcnt(0)" ::: "memory");
        } else {
            XB_SPIN(xb_ld(&bar[XB_XGEN(b.x)]) == gen, bar);
            __builtin_amdgcn_fence(__ATOMIC_ACQUIRE, "agent");
            asm volatile("s_waitcnt vmcnt(0)" ::: "memory");
        }
    }
    __syncthreads();
}

struct Args {
    const float* in[25]; float* out; unsigned char* ws; int ph_lo, ph_hi;
};

struct Ctx { LAS unsigned char* lds; int tid, lane, wave, gw, NGW, G; };


__device__ __forceinline__ void tr_item(const float* W, int ldw, int scol0, int k0, bf16_t* WT, int ldt, int drow0, int dk0, LAS float* scr, int lane) {
#pragma unroll 8
    for (int i = 0; i < 32; ++i) { const int kk = 2 * i + (lane >> 5); scr[kk * 33 + (lane & 31)] = W[(size_t)(k0 + kk) * ldw + scol0 + (lane & 31)]; }
    asm volatile("s_waitcnt lgkmcnt(0)" ::: "memory");
    const int c = lane & 7;
#pragma unroll
    for (int j = 0; j < 4; ++j) { const int n = (lane >> 3) + 8 * j; const LAS float* s = scr + (8 * c) * 33 + n;
        u32x4 o; o.x = cvt_pk_bf16(s[0 * 33], s[1 * 33]); o.y = cvt_pk_bf16(s[2 * 33], s[3 * 33]); o.z = cvt_pk_bf16(s[4 * 33], s[5 * 33]); o.w = cvt_pk_bf16(s[6 * 33], s[7 * 33]);
        *(u32x4*)(WT + (size_t)(drow0 + n) * ldt + dk0 + k0 + 8 * c) = o; }
    asm volatile("s_waitcnt lgkmcnt(0)" ::: "memory");
}
__device__ __forceinline__ void tr_item8(const float* W, int ldw, int scol0, int k0, unsigned char* WT, int ldt, int drow0, LAS float* scr, int lane) {
#pragma unroll 8
    for (int i = 0; i < 32; ++i) { const int kk = 2 * i + (lane >> 5); scr[kk * 33 + (lane & 31)] = __builtin_nontemporal_load(&W[(size_t)(k0 + kk) * ldw + scol0 + (lane & 31)]) * W8_SCALE; }
    asm volatile("s_waitcnt lgkmcnt(0)" ::: "memory");
    const int c = lane & 3;
#pragma unroll
    for (int j = 0; j < 2; ++j) { const int n = (lane >> 2) + 16 * j; const LAS float* s = scr + (16 * c) * 33 + n;
        u32x4 o; o.x = pk4_fp8(s[0 * 33], s[1 * 33], s[2 * 33], s[3 * 33]); o.y = pk4_fp8(s[4 * 33], s[5 * 33], s[6 * 33], s[7 * 33]);
        o.z = pk4_fp8(s[8 * 33], s[9 * 33], s[10 * 33], s[11 * 33]); o.w = pk4_fp8(s[12 * 33], s[13 * 33], s[14 * 33], s[15 * 33]);
        *(u32x4*)(WT + (size_t)(drow0 + n) * ldt + k0 + 16 * c) = o; }
    asm volatile("s_waitcnt lgkmcnt(0)" ::: "memory");
}
__device__ __forceinline__ void tr_item_gate(const float* W, int scol0, int k0, bf16_t* WT, int ri, int wcn, int kb, LAS float* scr, int lane) {
#pragma unroll 8
    for (int i = 0; i < 32; ++i) { const int kk = 2 * i + (lane >> 5); scr[kk * 33 + (lane & 31)] = W[(size_t)(k0 + kk) * 128 + scol0 + (lane & 31)]; }
    asm volatile("s_waitcnt lgkmcnt(0)" ::: "memory");
    const int c = lane & 7;
#pragma unroll
    for (int j = 0; j < 4; ++j) { const int n = (lane >> 3) + 8 * j; const LAS float* s = scr + (8 * c) * 33 + n;
        u32x4 o; o.x = cvt_pk_bf16(s[0 * 33], s[1 * 33]); o.y = cvt_pk_bf16(s[2 * 33], s[3 * 33]); o.z = cvt_pk_bf16(s[4 * 33], s[5 * 33]); o.w = cvt_pk_bf16(s[6 * 33], s[7 * 33]);
        const int nbb = (n >> 4) & 1, fr = n & 15, ks = 2 * kb + (c >> 2), fq = c & 3;
        *(u32x4*)(WT + ((size_t)((((wcn * 2 + nbb) * 2 + ri) * 4 + ks) * 64 + fq * 16 + fr)) * 8) = o; }
    asm volatile("s_waitcnt lgkmcnt(0)" ::: "memory");
}
__device__ __forceinline__ int gu_src_col(int nrow, int H) { return ((nrow & 255) >> 7) * H + (nrow >> 8) * 128 + (nrow & 127); }

__device__ __forceinline__ void p0_convert(const Args& a, const Ctx& c) {
    unsigned char* ws = a.ws;
    LAS float* scr = (LAS float*)(c.lds + c.wave * 16384);
    constexpr int I_POOL = 4 * (256 / 64) * (256 / 32);
    constexpr int I_GU = (D / 64) * (2 * DFF / 32);
    constexpr int I_DN = (DFF / 64) * (D / 32);
    constexpr int I_IN = (D / 64) * (2 * DR / 32);
    constexpr int I_GT = 40 * 2 * 4;
    constexpr int I_OUT = (DR / 64) * (D / 32);
    constexpr int NITEMS = I_POOL + I_GU + I_DN + I_IN + I_GT + I_OUT;
    for (int it = c.gw; it < NITEMS; it += c.NGW) {
        int r = it;
        if (r < I_POOL) { continue; } r -= I_POOL;
        if (r < I_GU) { const int nblk = 2 * DFF / 32, kb = r / nblk, nb = r % nblk;
            tr_item8(a.in[10], 2 * DFF, gu_src_col(32 * nb, DFF), 64 * kb, ws + W_GUT, D, 32 * nb, scr, c.lane); continue; } r -= I_GU;
        if (r < I_DN) { const int nblk = D / 32, kb = r / nblk, nb = r % nblk;
            tr_item8(a.in[11], D, 32 * nb, 64 * kb, ws + W_DT, DFF, 32 * nb, scr, c.lane); continue; } r -= I_DN;
        if (r < I_IN) { const int nblk = 2 * DR / 32, kb = r / nblk, nb = r % nblk;
            tr_item(a.in[12], 2 * DR, 32 * nb, 64 * kb, (bf16_t*)(ws + W_INT), D, 32 * nb, 0, scr, c.lane); continue; } r -= I_IN;
        if (r < I_GT) { const int mat = r / 8, q = r % 8, kb = q / 4, nb = q % 4; const int which = mat / 20, dh = mat % 20, dir = dh / 10, head = dh % 10;
            const float* W = (which ? a.in[17] : a.in[15]) + (size_t)(dir * 10 + head) * 16384;
            tr_item_gate(W, 32 * nb, 64 * kb, (bf16_t*)(ws + W_GT) + (size_t)(head * 2 + dir) * 32768, which, nb, kb, scr, c.lane); continue; } r -= I_GT;
        if (r < I_OUT) { const int nblk = D / 32, kb = r / nblk, nb = r % nblk;
            tr_item(a.in[20], D, 32 * nb, 64 * kb, (bf16_t*)(ws + W_OUTT), DR, 32 * nb, 0, scr, c.lane); continue; } r -= I_OUT;
        { (void)r; }
    }
    for (int i = c.gw * 64 + c.lane; i < 8 * 8 * 8 * 64; i += c.NGW * 64) { const int ln = i & 63, nb = (i >> 6) & 7, ks = (i >> 9) & 7, w = i >> 12, ii = ln & 15, fqq = ln >> 4, g = w >> 1;
        const int col = 128 * w + 32 * (nb >> 1) + 8 * (ii >> 2) + 4 * (nb & 1) + (ii & 3), dd = col - 256 * g, k = 32 * ks + 8 * fqq;
        const float* src = a.in[8] + (size_t)g * 65536 + (size_t)k * 256 + dd;
        u32x4 o; o.x = cvt_pk_bf16(src[0], src[256]); o.y = cvt_pk_bf16(src[512], src[768]); o.z = cvt_pk_bf16(src[1024], src[1280]); o.w = cvt_pk_bf16(src[1536], src[1792]);
        *(u32x4*)((bf16_t*)(ws + W_POOLT) + (size_t)i * 8) = o; }
    for (int i = c.gw * 64 + c.lane; i < 2 * DR; i += c.NGW * 64) ((float*)(ws + WS_SP))[i] = -8.0f * log1pf(__expf(-a.in[19][i]));
}

__device__ __forceinline__ void moe_convert_queue(const Args& a, const Ctx& c, int max_grabs) {
    constexpr int I_MGU1 = (D / 64) * (2 * DE / 32);
    constexpr int I_MDN1 = (DE / 64) * (D / 32);
    constexpr int NQ = NE * I_MGU1 + NE * I_MDN1, GRAB = 64;
    unsigned char* ws = a.ws;
    LAS float* scr = (LAS float*)(c.lds + c.wave * 16384);
    LAS int* slot = (LAS int*)(c.lds + 131072);
    unsigned* ctr = (unsigned*)(ws + WS_CTL) + 20 * 64;
    for (int gi = 0; gi < max_grabs; ++gi) {
        __syncthreads();
        if (c.tid == 0) slot[0] = (int)atomicAdd(ctr, (unsigned)GRAB);
        __syncthreads();
        const int base = slot[0];
        if (base >= NQ) break;
#pragma unroll 1
        for (int k = 0; k < GRAB / NWAVES; ++k) { int r = base + k * NWAVES + c.wave; if (r >= NQ) break;
            if (r < NE * I_MGU1) { const int e = r / I_MGU1, q = r % I_MGU1, nblk = 2 * DE / 32, kb = q / nblk, nb = q % nblk;
                tr_item8(a.in[22] + (size_t)e * D * 2 * DE, 2 * DE, gu_src_col(32 * nb, DE), 64 * kb, ws + W_MGUT + (size_t)e * 2 * DE * D, D, 32 * nb, scr, c.lane); continue; } r -= NE * I_MGU1;
            { const int e = r / I_MDN1, q = r % I_MDN1, nblk = D / 32, kb = q / nblk, nb = q % nblk;
                tr_item8(a.in[23] + (size_t)e * DE * D, D, 32 * nb, 64 * kb, ws + W_MDT + (size_t)e * D * DE, DE, 32 * nb, scr, c.lane); } }
    }
}

__device__ __forceinline__ void p0_adaln(const Args& a, const Ctx& c) {
    if ((int)blockIdx.x >= 192) return;
    const int layer = blockIdx.x / 96, col0 = (blockIdx.x % 96) * 64;
    LAS float* s = (LAS float*)c.lds;
    LAS float* red = (LAS float*)(c.lds + 17 * 1024 * 4);
    for (int i = c.tid; i < 17 * 1024; i += NTHREADS) { const int b = i >> 10, k = i & 1023; const float v = b < NB ? a.in[1][b * D + k] : a.in[3][k]; s[i] = v / (1.0f + __expf(-v)); }
    __syncthreads();
    const int ks = c.lane >> 4, cq = c.lane & 15;
    const float* W = a.in[4] + (size_t)layer * D * 6 * D + col0 + 4 * cq;
    f32x4 acc[17];
#pragma unroll
    for (int b = 0; b < 17; ++b) acc[b] = (f32x4){0.f, 0.f, 0.f, 0.f};
    const int k0 = c.wave * 128 + ks;
#pragma unroll 8
    for (int kk = 0; kk < 32; ++kk) { const int k = k0 + 4 * kk; const f32x4 w = __builtin_nontemporal_load((const f32x4*)(W + (size_t)k * 6 * D));
#pragma unroll
        for (int b = 0; b < 17; ++b) acc[b] += w * s[b * 1024 + k]; }
#pragma unroll
    for (int b = 0; b < 17; ++b) {
#pragma unroll
        for (int j = 0; j < 4; ++j) { float v = acc[b][j]; v += __shfl_xor(v, 16); v += __shfl_xor(v, 32); acc[b][j] = v; }
        if (ks == 0) *(LAS f32x4*)(red + (c.wave * 17 + b) * 64 + 4 * cq) = acc[b]; }
    __syncthreads();
    float* mod = (float*)(a.ws + WS_MOD) + (size_t)layer * 17 * 6144;
    for (int i = c.tid; i < 17 * 64; i += NTHREADS) { const int b = i >> 6, l = i & 63; float v = a.in[5][layer * 6 * D + col0 + l];
#pragma unroll
        for (int w = 0; w < 8; ++w) v += red[(w * 17 + b) * 64 + l];
        mod[b * 6144 + col0 + l] = v; }
    __syncthreads();
}

constexpr int PL_PITCH = 2064;
constexpr int PL_RS = 64 * PL_PITCH, PL_SS = PL_RS + 512;
template <int W>
__device__ __forceinline__ void pool_cols(const float* seqc  , LAS const float* rs, int t0, int L, int ntok, float g0, float g1, LAS unsigned char* lds, int col) {
    float r0[16], r1[16]; float S0 = 0.f, S1 = 0.f;
#pragma unroll
    for (int i = 0; i < 16; ++i) { r0[i] = 0.f; r1[i] = 0.f; }
    LAS unsigned char* pd = lds + col * 2 - (W / 2 - 1 + 8) * PL_PITCH;
#pragma unroll 1
    for (int so = 0; so < ntok + 16; so += 16) {
#pragma unroll
        for (int i = 0; i < 16; ++i) { const int s = so + i;
            const int t = t0 - 8 + s; float v0 = 0.f, v1 = 0.f;
            { const bool ok = t >= 0 && t < L; const int tc = min(max(t, 0), L - 1);
              const f32x2 xv = *(const f32x2*)(seqc + (size_t)tc * D); const float r = rs[s]; v0 = ok ? xv.x * r : 0.f; v1 = ok ? xv.y * r : 0.f; }
            r0[i] = v0; r1[i] = v1; S0 += v0; S1 += v1;
            const int p = s - W / 2 + 1;
            if (p >= 8 && p < 8 + ntok) { const int tp = t0 - 8 + p; const int lo = max(tp - W / 2, 0), hi = min(tp - W / 2 + W, L); const float inv = __builtin_amdgcn_rcpf((float)(hi - lo));
                *(LAS unsigned*)pd = cvt_pk_bf16((S0 * inv - r0[(i - W / 2 + 1) & 15]) * g0, (S1 * inv - r1[(i - W / 2 + 1) & 15]) * g1); }
            pd += PL_PITCH;
            if (s - W + 1 >= 0) { S0 -= r0[(i - W + 1) & 15]; S1 -= r1[(i - W + 1) & 15]; } }
    }
}
__device__ __forceinline__ void pool_fused(const Args& a, const Ctx& c) {
    LAS unsigned char* lds = c.lds;
    LAS float* rs = (LAS float*)(lds + PL_RS); LAS float* rowss = (LAS float*)(lds + PL_SS);
    const float* g1n = a.in[6]; const float* g2n = a.in[7]; const float* pscale = a.in[9];
    const float* mod0 = (const float*)(a.ws + WS_MOD);
    const bf16_t* PW = (const bf16_t*)(a.ws + W_POOLT);
    unsigned char* H2 = a.ws + R_HB;
    const int tid = c.tid, lane = c.lane, w = c.wave, g = w >> 1;
    SUBDECL;
    for (int tile = blockIdx.x; tile < 512 + NZ / 16; tile += c.G) {
        int fr = lane & 15, fq = lane >> 4; asm volatile("" : "+v"(fr), "+v"(fq));
        const bool isx = tile < 512; const int L = isx ? 64 : 256, ntok = isx ? 64 : 16, nm = ntok >> 4;
        const int t0 = isx ? 0 : ((tile - 512) & 15) * 16;
        const float* seq = isx ? a.in[0] + (size_t)tile * 64 * D : a.in[2] + (size_t)((tile - 512) >> 4) * CL * D;
        float* outp = isx ? a.out + (size_t)tile * 64 * D : (float*)(a.ws + WS_ZRES) + ((size_t)((tile - 512) >> 4) * CL + t0) * D;
        const int b = isx ? (tile >> 5) : NB;
        const size_t orow0 = isx ? (size_t)tile * 64 : (size_t)NX + (size_t)((tile - 512) >> 4) * CL + t0;
        const float* mb = mod0 + (size_t)b * 6144;
        __syncthreads();
        SUBT0(1);
        { const int slo = max(0, 8 - t0), shi = min(ntok + 16, L + 8 - t0);
          for (int sb = slo + w; sb < shi; sb += 4 * NWAVES) {
              f32x4 v[4][4];
#pragma unroll
              for (int r = 0; r < 4; ++r) { const int s = sb + r * NWAVES;
                  if (s < shi) { const f32x4* xr = (const f32x4*)(seq + (size_t)(t0 - 8 + s) * D) + lane;
#pragma unroll
                      for (int j = 0; j < 4; ++j) v[r][j] = xr[64 * j]; }
                  else {
#pragma unroll
                      for (int j = 0; j < 4; ++j) v[r][j] = (f32x4){0.f, 0.f, 0.f, 0.f}; } }
#pragma unroll
              for (int r = 0; r < 4; ++r) { const int s = sb + r * NWAVES; float ss = 0.f;
#pragma unroll
                  for (int j = 0; j < 4; ++j) ss += (v[r][j].x * v[r][j].x + v[r][j].y * v[r][j].y) + (v[r][j].z * v[r][j].z + v[r][j].w * v[r][j].w);
                  ss = wave_sum(ss); if (lane == 0 && s < shi) rs[s] = rsqrtf(ss * (1.0f / D) + EPS); } } }
        __syncthreads();
        SUBT1(1); SUBT0(2);
        { const int col = 2 * tid;
          const f32x2 gg = *(const f32x2*)(g1n + col), sc = *(const f32x2*)(mb + 1024 + col);
          const float ga = gg.x * (1.0f + sc.x), gb = gg.y * (1.0f + sc.y);
          const float* src = seq + col;
          const int grp = __builtin_amdgcn_readfirstlane(col >> 8);
          if (grp == 0) pool_cols<2>(src, rs, t0, L, ntok, ga, gb, lds, col);
          else if (grp == 1) pool_cols<4>(src, rs, t0, L, ntok, ga, gb, lds, col);
          else if (grp == 2) pool_cols<8>(src, rs, t0, L, ntok, ga, gb, lds, col);
          else pool_cols<16>(src, rs, t0, L, ntok, ga, gb, lds, col); }
        __syncthreads();
        SUBT1(2); SUBT0(3);
        float ssq[4] = {0.f, 0.f, 0.f, 0.f};
#pragma unroll 1
        for (int half = 0; half < 2; ++half) {
            f32x4 acc[4][4];
#pragma unroll
            for (int m = 0; m < 4; ++m)
#pragma unroll
                for (int nb = 0; nb < 4; ++nb) acc[m][nb] = (f32x4){0.f, 0.f, 0.f, 0.f};
            { const bf16_t* pw = PW + (size_t)w * 8 * 8 * 512 + (size_t)half * 4 * 512 + lane * 8;
              bf16x8 bA[4], bB[4];
#pragma unroll
              for (int nb = 0; nb < 4; ++nb) bA[nb] = *(const bf16x8*)(pw + nb * 512);
#pragma unroll 1
              for (int ks = 0; ks < 8; ks += 2) {
#pragma unroll
                  for (int nb = 0; nb < 4; ++nb) bB[nb] = *(const bf16x8*)(pw + ((ks + 1) * 8 + nb) * 512);
                  { const int sw = (32 * g + 4 * ks + fq) << 4; bf16x8 af[4];
#pragma unroll
                    for (int m = 0; m < 4; ++m) if (m < nm) af[m] = *(const LAS bf16x8*)(lds + (16 * m + fr) * PL_PITCH + sw);
#pragma unroll
                    for (int m = 0; m < 4; ++m) if (m < nm)
#pragma unroll
                        for (int nb = 0; nb < 4; ++nb) acc[m][nb] = __builtin_amdgcn_mfma_f32_16x16x32_bf16(bA[nb], af[m], acc[m][nb], 0, 0, 0); }
                  if (ks + 2 < 8) {
#pragma unroll
                      for (int nb = 0; nb < 4; ++nb) bA[nb] = *(const bf16x8*)(pw + ((ks + 2) * 8 + nb) * 512); }
                  { const int sw = (32 * g + 4 * (ks + 1) + fq) << 4; bf16x8 af[4];
#pragma unroll
                    for (int m = 0; m < 4; ++m) if (m < nm) af[m] = *(const LAS bf16x8*)(lds + (16 * m + fr) * PL_PITCH + sw);
#pragma unroll
                    for (int m = 0; m < 4; ++m) if (m < nm)
#pragma unroll
                        for (int nb = 0; nb < 4; ++nb) acc[m][nb] = __builtin_amdgcn_mfma_f32_16x16x32_bf16(bB[nb], af[m], acc[m][nb], 0, 0, 0); } } }
#pragma unroll
            for (int pp = 0; pp < 2; ++pp) { const int col0 = 128 * w + 32 * (2 * half + pp) + 8 * fq;
                const f32x4 ga0 = *(const f32x4*)(mb + 2048 + col0) * *(const f32x4*)(pscale + col0), ga1 = *(const f32x4*)(mb + 2048 + col0 + 4) * *(const f32x4*)(pscale + col0 + 4);
#pragma unroll
                for (int m = 0; m < 4; ++m) if (m < nm) { const int tok = 16 * m + fr;
                    const f32x4 x0 = *(const f32x4*)(seq + (size_t)(t0 + tok) * D + col0), x1 = *(const f32x4*)(seq + (size_t)(t0 + tok) * D + col0 + 4);
                    const f32x4 o0 = x0 + ga0 * acc[m][2 * pp], o1 = x1 + ga1 * acc[m][2 * pp + 1];
                    *(f32x4*)(outp + (size_t)tok * D + col0) = o0; *(f32x4*)(outp + (size_t)tok * D + col0 + 4) = o1;
                    ssq[m] += (o0.x * o0.x + o0.y * o0.y) + (o0.z * o0.z + o0.w * o0.w) + (o1.x * o1.x + o1.y * o1.y) + (o1.z * o1.z + o1.w * o1.w); } }
        }
#pragma unroll
        for (int m = 0; m < 4; ++m) if (m < nm) { float v = ssq[m]; v += __shfl_xor(v, 16); v += __shfl_xor(v, 32); if (fq == 0) rowss[w * 64 + 16 * m + fr] = v; }
        __syncthreads();
        SUBT1(3); SUBT0(4);
        float rstd2[4];
#pragma unroll
        for (int m = 0; m < 4; ++m) { float t = 1.f;
            if (m < nm) { t = 0.f;
#pragma unroll
            for (int ww = 0; ww < 8; ++ww) t += rowss[ww * 64 + 16 * m + fr]; }
            rstd2[m] = rsqrtf(t * (1.0f / D) + EPS); }
#pragma unroll 2
        for (int p = 0; p < 4; ++p) { const int col0 = 128 * w + 32 * p + 8 * fq;
            const f32x4 gm0 = *(const f32x4*)(g2n + col0) * (*(const f32x4*)(mb + 4096 + col0) + 1.0f), gm1 = *(const f32x4*)(g2n + col0 + 4) * (*(const f32x4*)(mb + 4096 + col0 + 4) + 1.0f);
            const f32x4 sh0 = *(const f32x4*)(mb + 3072 + col0), sh1 = *(const f32x4*)(mb + 3072 + col0 + 4);
#pragma unroll
            for (int m = 0; m < 4; ++m) if (m < nm) { const int tok = 16 * m + fr;
                const f32x4 v0 = *(const f32x4*)(outp + (size_t)tok * D + col0), v1 = *(const f32x4*)(outp + (size_t)tok * D + col0 + 4);
                const f32x4 h0 = v0 * rstd2[m] * gm0 + sh0, h1 = v1 * rstd2[m] * gm1 + sh1;
                u32x2 o; o.x = pk4_fp8(h0.x, h0.y, h0.z, h0.w); o.y = pk4_fp8(h1.x, h1.y, h1.z, h1.w);
                *(u32x2*)(H2 + (orow0 + tok) * D + col0) = o; } }
        SUBT1(4);
    }
    SUBSPIN;
}

__device__ __forceinline__ void norm_mod_rows(const float* X, const float* Z, int nrows, const float* gvec, const float* modl, int sh_off, int sc_off, bf16_t* out, const Ctx& c) {
    const int RPW = ((nrows + c.NGW - 1) / c.NGW + 1) & ~1, rbeg = c.gw * RPW, rend = min(nrows, rbeg + RPW);
    f32x4 gm[4], shv[4]; int bcur = -1;
    for (int row0 = rbeg; row0 < rend; row0 += 2) {
        f32x4 v[2][4]; float ss[2];
#pragma unroll
        for (int r = 0; r < 2; ++r) { const int row = row0 + r; const float* src = row < NX ? X + (size_t)row * D : Z + (size_t)(row - NX) * D;
            const f32x4* xr = (const f32x4*)src + c.lane; ss[r] = 0.f;
#pragma unroll
            for (int j = 0; j < 4; ++j) v[r][j] = xr[64 * j]; }
        const int b = row0 < NX ? row0 / SEQ : NB;
        if (b != bcur) { bcur = b; const float* mb = modl + (size_t)b * 6144;
#pragma unroll
            for (int j = 0; j < 4; ++j) { const int col = 4 * (c.lane + 64 * j); gm[j] = *(const f32x4*)(gvec + col) * (*(const f32x4*)(mb + sc_off + col) + 1.0f); shv[j] = *(const f32x4*)(mb + sh_off + col); } }
#pragma unroll
        for (int r = 0; r < 2; ++r)
#pragma unroll
            for (int j = 0; j < 4; ++j) ss[r] += (v[r][j].x * v[r][j].x + v[r][j].y * v[r][j].y) + (v[r][j].z * v[r][j].z + v[r][j].w * v[r][j].w);
#pragma unroll
        for (int r = 0; r < 2; ++r) { const int row = row0 + r;
            const float rstd = rsqrtf(wave_sum(ss[r]) * (1.0f / D) + EPS);
#pragma unroll
            for (int j = 0; j < 4; ++j) { const int col = 4 * (c.lane + 64 * j);
                const f32x4 h = v[r][j] * rstd * gm[j] + shv[j];
                u32x2 w; w.x = cvt_pk_bf16(h.x, h.y); w.y = cvt_pk_bf16(h.z, h.w);
                *(u32x2*)(out + (size_t)row * D + col) = w; } }
    }
}

constexpr int LRU_NCK = 288;
constexpr int L_A = 0, L_LAB = 32768, L_B = 32768, L_HF = 100352, L_SEG = 133120, L_CARRY = 141312;
constexpr int LAB_PITCH = 528;
template <int MODE>
__device__ __forceinline__ void lru_pass(const Args& a, const Ctx& c) {
    const bf16_t* GU2 = (const bf16_t*)(a.ws + R_GU2); const bf16_t* GT3 = (const bf16_t*)(a.ws + W_GT);
    float* CAg = (float*)(a.ws + WS_CHUNK); float* CBg = CAg + (size_t)2 * LRU_NCK * DR;
    const float* SP = (const float*)(a.ws + WS_SP);
    bf16_t* Yg = (bf16_t*)(a.ws + R_Y);
    const float* cw = a.in[13]; const float* cb = a.in[14];
    LAS unsigned char* lds = c.lds;
    const int tid = c.tid, lane = c.lane, wid = c.wave, wr = wid >> 2, wc = wid & 3, fr = lane & 15, fq = lane >> 4;
    const int nunits = (MODE == 1 ? LRU_NCK : 256) * 10;
    const int tq = tid >> 4, c8 = tid & 15;
    SUBDECL;
    u32x4 uw[7]; bf16x8 bq[2][2][4];
#define LRU_LOAD_U(L_) do { const int head_ = (L_) % 10, ck_ = (L_) / 10; const bool isx_ = ck_ < 256; const int jj_ = isx_ ? (ck_ & 15) : ((ck_ - 256) & 1); \
        const int Ls_ = isx_ ? SEQ : CL; const size_t r0_ = isx_ ? (size_t)ck_ * 128 : (size_t)NX + (size_t)(ck_ - 256) * 128; \
        _Pragma("unroll") for (int i = 0; i < 7; ++i) { const int t = jj_ * 128 + 4 * tq + i - 2; const bool ok_ = t >= 0 && t < Ls_; const int tc_ = min(max(t, 0), Ls_ - 1); \
            const u32x4 ld_ = *(const u32x4*)(GU2 + (r0_ - jj_ * 128 + tc_) * (size_t)(2 * DR) + DR + head_ * 128 + 8 * c8);     \
            uw[i].x = ok_ ? ld_.x : 0u; uw[i].y = ok_ ? ld_.y : 0u; uw[i].z = ok_ ? ld_.z : 0u; uw[i].w = ok_ ? ld_.w : 0u; } } while (0)
#define LRU_LOAD_B(L_, dir_) do { const bf16_t* src_ = GT3 + ((size_t)(((L_) % 10) * 2 + (dir_)) * 4 + wc) * 8192 + lane * 8; \
        _Pragma("unroll") for (int nb = 0; nb < 2; ++nb) _Pragma("unroll") for (int ri = 0; ri < 2; ++ri) _Pragma("unroll") for (int ks = 0; ks < 4; ++ks) \
            bq[nb][ri][ks] = *(const bf16x8*)(src_ + ((nb * 2 + ri) * 4 + ks) * 512); } while (0)
    if ((int)blockIdx.x < nunits) { LRU_LOAD_U((int)blockIdx.x); }
    for (int L = blockIdx.x; L < nunits; L += c.G) {
        const int head = L % 10, ck = L / 10;
        const bool isx = ck < 256; const int bb_ = isx ? (ck >> 4) : ((ck - 256) >> 1), jj = isx ? (ck & 15) : ((ck - 256) & 1);
        const size_t r0 = isx ? (size_t)ck * 128 : (size_t)NX + (size_t)(ck - 256) * 128;
        const bool has_next = L + c.G < nunits;
        __syncthreads();
        LRU_LOAD_B(L, 0);
        SUBT0(21);
        { const int ch = head * 128 + 8 * c8;
          float wv[4][8], bv[8];
#pragma unroll
          for (int k = 0; k < 4; ++k) { const f32x4 w0 = *(const f32x4*)(cw + k * DR + ch), w1 = *(const f32x4*)(cw + k * DR + ch + 4);
              wv[k][0] = w0.x; wv[k][1] = w0.y; wv[k][2] = w0.z; wv[k][3] = w0.w; wv[k][4] = w1.x; wv[k][5] = w1.y; wv[k][6] = w1.z; wv[k][7] = w1.w; }
          { const f32x4 b0 = *(const f32x4*)(cb + ch), b1 = *(const f32x4*)(cb + ch + 4); bv[0] = b0.x; bv[1] = b0.y; bv[2] = b0.z; bv[3] = b0.w; bv[4] = b1.x; bv[5] = b1.y; bv[6] = b1.z; bv[7] = b1.w; }
#pragma unroll
          for (int o = 0; o < 4; ++o) { float acc[8];
#pragma unroll
              for (int j = 0; j < 8; ++j) acc[j] = bv[j];
#pragma unroll
              for (int k = 0; k < 4; ++k) { const u32x4 u = uw[o + k];
                  acc[0] += wv[k][0] * bf_lo(u.x); acc[1] += wv[k][1] * bf_hi(u.x); acc[2] += wv[k][2] * bf_lo(u.y); acc[3] += wv[k][3] * bf_hi(u.y);
                  acc[4] += wv[k][4] * bf_lo(u.z); acc[5] += wv[k][5] * bf_hi(u.z); acc[6] += wv[k][6] * bf_lo(u.w); acc[7] += wv[k][7] * bf_hi(u.w); }
              u32x4 w; w.x = cvt_pk_bf16(acc[0], acc[1]); w.y = cvt_pk_bf16(acc[2], acc[3]); w.z = cvt_pk_bf16(acc[4], acc[5]); w.w = cvt_pk_bf16(acc[6], acc[7]);
              const int tok = 4 * tq + o;
              *(LAS u32x4*)(lds + L_A + tok * 256 + ((c8 ^ (tok & 15)) << 4)) = w; } }
        if (MODE == 2 && tid < 128) { const int dir = tid >> 6, cp = tid & 63; const int n = dir == 0 ? 2 + jj : 2 + (15 - jj);
            const size_t cbase = (size_t)dir * LRU_NCK * DR + head * 128 + 2 * cp;
            f32x2 Av[17], Bv[17];
#pragma unroll
            for (int q = 0; q < 17; ++q) { int idx; if (dir == 0) idx = q < 2 ? 256 + 2 * bb_ + q : 16 * bb_ + q - 2; else idx = q < 2 ? 256 + 2 * bb_ + 1 - q : 16 * bb_ + 15 - (q - 2);
                if (q < n) { Av[q] = *(const f32x2*)(CAg + cbase + (size_t)idx * DR); Bv[q] = *(const f32x2*)(CBg + cbase + (size_t)idx * DR); } else { Av[q] = (f32x2){1.f, 1.f}; Bv[q] = (f32x2){0.f, 0.f}; } }
            f32x2 cc = (f32x2){0.f, 0.f};
#pragma unroll
            for (int q = 0; q < 17; ++q) cc = Av[q] * cc + Bv[q];
            *(LAS f32x2*)(lds + L_CARRY + (dir * 128 + 2 * cp) * 4) = cc; }
        __syncthreads();
        SUBT1(21);
        u32x4 gw[4];
#pragma unroll
        for (int dir = 0; dir < 2; ++dir) {
            f32x4 brv[2], biv[2], spv[2];
#pragma unroll
            for (int nb = 0; nb < 2; ++nb) { const int ch = dir * DR + head * 128 + 32 * wc + 16 * nb + 4 * fq;
                brv[nb] = *(const f32x4*)(a.in[16] + ch); biv[nb] = *(const f32x4*)(a.in[18] + ch); spv[nb] = *(const f32x4*)(SP + ch); }
            SUBT0(22);
            f32x4 acc[4][2][2];
#pragma unroll
            for (int m = 0; m < 4; ++m)
#pragma unroll
                for (int nb = 0; nb < 2; ++nb)
#pragma unroll
                    for (int ri = 0; ri < 2; ++ri) acc[m][nb][ri] = (f32x4){0.f, 0.f, 0.f, 0.f};
#pragma unroll
            for (int ks = 0; ks < 4; ++ks) { const int sw = ((ks * 4 + fq) ^ fr) << 4;
                bf16x8 af[4];
#pragma unroll
                for (int m = 0; m < 4; ++m) af[m] = *(const LAS bf16x8*)(lds + L_A + (64 * wr + 16 * m + fr) * 256 + sw);
#pragma unroll
                for (int m = 0; m < 4; ++m)
#pragma unroll
                    for (int nb = 0; nb < 2; ++nb)
#pragma unroll
                        for (int ri = 0; ri < 2; ++ri) acc[m][nb][ri] = __builtin_amdgcn_mfma_f32_16x16x32_bf16(bq[nb][ri][ks], af[m], acc[m][nb][ri], 0, 0, 0); }
            SUBT1(22); SUBT0(23);
            if (dir == 0) { LRU_LOAD_B(L, 1); }
            else { if (has_next) { LRU_LOAD_U(L + c.G); }
                if (MODE == 2) {
#pragma unroll
                    for (int i = 0; i < 4; ++i) { const int p = tid + 512 * i, tok = p >> 4, c16 = p & 15; gw[i] = *(const u32x4*)(GU2 + (r0 + tok) * (size_t)(2 * DR) + head * 128 + c16 * 8); } } }
#pragma unroll
            for (int nb = 0; nb < 2; ++nb) { const int chl = 32 * wc + 16 * nb + 4 * fq;
#pragma unroll
                for (int m = 0; m < 4; ++m) { const int tok = 64 * wr + 16 * m + fr;
                    const u32x2 uq = *(const LAS u32x2*)(lds + L_A + tok * 256 + (((chl >> 3) ^ (tok & 15)) << 4) + (chl & 7) * 2);
                    const float uv[4] = {bf_lo(uq.x), bf_hi(uq.x), bf_lo(uq.y), bf_hi(uq.y)};
                    u32x4 w;
#pragma unroll
                    for (int j = 0; j < 4; ++j) {
                        const float er = 1.0f + fast_exp(-(acc[m][nb][0][j] + brv[nb][j])), ei = 1.0f + fast_exp(-(acc[m][nb][1][j] + biv[nb][j]));
                        const float R = __builtin_amdgcn_rcpf(er * ei), r = ei * R, ig = er * R;
                        const float l = r * spv[nb][j], y = 2.0f * l;
                        float em = -y * (1.0f + y * (0.5f + y * (1.0f / 6.0f + y * (1.0f / 24.0f))));
                        if (__builtin_expect(y <= -0.3f, 0)) em = 1.0f - fast_exp(y);
                        w[j] = cvt_pk_bf16(l, __builtin_amdgcn_sqrtf(em) * ig * uv[j]); }
                    *(LAS u32x4*)(lds + L_LAB + tok * LAB_PITCH + chl * 4) = w; } }
            __syncthreads();
            SUBT1(23); SUBT0(24);
            if (MODE == 1 && isx) {
                unsigned char* dstg = a.ws + R_LABG + ((size_t)(ck * 10 + head) * 2 + dir) * 65536;
#pragma unroll
                for (int i = 0; i < 8; ++i) { const int p = tid + 512 * i; __builtin_nontemporal_store(*(const LAS u32x4*)(lds + L_LAB + (p >> 5) * LAB_PITCH + (p & 31) * 16), (u32x4*)(dstg + (size_t)p * 16)); } }
            { const int sg = wid, cp = lane;
              float s0 = 0.f, s1 = 0.f, h0 = 0.f, h1 = 0.f;
#pragma unroll
              for (int i = 0; i < 16; ++i) { const int t = 16 * sg + (dir ? 15 - i : i);
                  const u32x2 e = *(const LAS u32x2*)(lds + L_LAB + t * LAB_PITCH + cp * 8);
                  const float l0 = bf_lo(e.x), l1 = bf_lo(e.y); s0 += l0; s1 += l1;
                  h0 = fast_exp(l0) * h0 + bf_hi(e.x); h1 = fast_exp(l1) * h1 + bf_hi(e.y); }
              *(LAS f32x4*)(lds + L_SEG + (sg * 64 + cp) * 16) = (f32x4){fast_exp(s0), fast_exp(s1), h0, h1};
              if (MODE == 2 && dir == 1) {
#pragma unroll
                  for (int i = 0; i < 4; ++i) { const int p = tid + 512 * i; *(LAS u32x4*)(lds + L_A + p * 16) = gw[i]; } }
              __syncthreads();
              if (MODE == 1) {
                  if (sg == 0) { float c0 = 0.f, c1 = 0.f, A0 = 1.f, A1 = 1.f;
#pragma unroll
                      for (int q = 0; q < 8; ++q) { const int s_ = dir ? 7 - q : q; const f32x4 sv = *(const LAS f32x4*)(lds + L_SEG + (s_ * 64 + cp) * 16);
                          c0 = sv.x * c0 + sv.z; c1 = sv.y * c1 + sv.w; A0 *= sv.x; A1 *= sv.y; }
                      const size_t o = ((size_t)dir * LRU_NCK + ck) * DR + head * 128 + 2 * cp;
                      *(f32x2*)(CAg + o) = (f32x2){A0, A1}; *(f32x2*)(CBg + o) = (f32x2){c0, c1}; }
              } else {
                  const f32x2 cin = *(const LAS f32x2*)(lds + L_CARRY + (dir * 128 + 2 * cp) * 4);
                  float c0 = cin.x, c1 = cin.y;
#pragma unroll
                  for (int q = 0; q < 7; ++q) { const int s_ = dir ? 7 - q : q; const bool use = dir ? (s_ > sg) : (s_ < sg);
                      if (use) { const f32x4 sv = *(const LAS f32x4*)(lds + L_SEG + (s_ * 64 + cp) * 16); c0 = sv.x * c0 + sv.z; c1 = sv.y * c1 + sv.w; } }
                  h0 = c0; h1 = c1;
                  if (dir == 0) {
#pragma unroll
                      for (int i = 0; i < 16; ++i) { const int t = 16 * sg + i;
                          const u32x2 e = *(const LAS u32x2*)(lds + L_LAB + t * LAB_PITCH + cp * 8);
                          h0 = fast_exp(bf_lo(e.x)) * h0 + bf_hi(e.x); h1 = fast_exp(bf_lo(e.y)) * h1 + bf_hi(e.y);
                          *(LAS unsigned*)(lds + L_HF + t * 256 + cp * 4) = cvt_pk_bf16(h0, h1); }
                  } else {
#pragma unroll
                      for (int i = 0; i < 16; ++i) { const int t = 16 * sg + 15 - i;
                          const u32x2 e = *(const LAS u32x2*)(lds + L_LAB + t * LAB_PITCH + cp * 8);
                          h0 = fast_exp(bf_lo(e.x)) * h0 + bf_hi(e.x); h1 = fast_exp(bf_lo(e.y)) * h1 + bf_hi(e.y);
                          const unsigned fw = *(const LAS unsigned*)(lds + L_HF + t * 256 + cp * 4), gt = *(const LAS unsigned*)(lds + L_A + t * 256 + cp * 4);
                          *(LAS unsigned*)(lds + L_HF + t * 256 + cp * 4) = cvt_pk_bf16((h0 + bf_lo(fw)) * gelu_tanh(bf_lo(gt)), (h1 + bf_hi(fw)) * gelu_tanh(bf_hi(gt))); }
                      __syncthreads();
#pragma unroll
                      for (int i = 0; i < 4; ++i) { const int p = tid + 512 * i, tok = p >> 4, c16 = p & 15;
                          *(u32x4*)(Yg + (r0 + tok) * (size_t)DR + head * 128 + c16 * 8) = *(const LAS u32x4*)(lds + L_HF + p * 16); }
                  }
              }
            }
            SUBT1(24);
            if (dir == 0) __syncthreads();
        }
    }
    SUBSPIN;
#undef LRU_LOAD_U
#undef LRU_LOAD_B
}

__device__ __forceinline__ void lru_scan2(const Args& a, const Ctx& c) {
    const bf16_t* GU2 = (const bf16_t*)(a.ws + R_GU2);
    const float* CAg = (const float*)(a.ws + WS_CHUNK); const float* CBg = CAg + (size_t)2 * LRU_NCK * DR;
    bf16_t* Yg = (bf16_t*)(a.ws + R_Y);
    LAS unsigned char* lds = c.lds;
    const int tid = c.tid, lane = c.lane, wid = c.wave;
    const int nunits = 256 * 10;
    u32x4 lab[8], gw[4];
#define LRU_LOAD_LAB(L_, dir_) do { const unsigned char* src_ = a.ws + R_LABG + ((size_t)(L_) * 2 + (dir_)) * 65536; \
        _Pragma("unroll") for (int i = 0; i < 8; ++i) lab[i] = __builtin_nontemporal_load((const u32x4*)(src_ + (size_t)(tid + 512 * i) * 16)); } while (0)
    if ((int)blockIdx.x < nunits) { LRU_LOAD_LAB((int)blockIdx.x, 0); }
    for (int L = blockIdx.x; L < nunits; L += c.G) {
        const int head = L % 10, ck = L / 10, bb_ = ck >> 4, jj = ck & 15;
        const size_t r0 = (size_t)ck * 128;
        const bool has_next = L + c.G < nunits;
        __syncthreads();
        if (tid < 128) { const int dir = tid >> 6, cp = tid & 63; const int n = dir == 0 ? 2 + jj : 2 + (15 - jj);
            const size_t cbase = (size_t)dir * LRU_NCK * DR + head * 128 + 2 * cp;
            f32x2 Av[17], Bv[17];
#pragma unroll
            for (int q = 0; q < 17; ++q) { int idx; if (dir == 0) idx = q < 2 ? 256 + 2 * bb_ + q : 16 * bb_ + q - 2; else idx = q < 2 ? 256 + 2 * bb_ + 1 - q : 16 * bb_ + 15 - (q - 2);
                if (q < n) { Av[q] = *(const f32x2*)(CAg + cbase + (size_t)idx * DR); Bv[q] = *(const f32x2*)(CBg + cbase + (size_t)idx * DR); } else { Av[q] = (f32x2){1.f, 1.f}; Bv[q] = (f32x2){0.f, 0.f}; } }
            f32x2 cc = (f32x2){0.f, 0.f};
#pragma unroll
            for (int q = 0; q < 17; ++q) cc = Av[q] * cc + Bv[q];
            *(LAS f32x2*)(lds + L_CARRY + (dir * 128 + 2 * cp) * 4) = cc; }
#pragma unroll
        for (int dir = 0; dir < 2; ++dir) {
#pragma unroll
            for (int i = 0; i < 8; ++i) { const int p = tid + 512 * i; *(LAS u32x4*)(lds + L_LAB + (p >> 5) * LAB_PITCH + (p & 31) * 16) = lab[i]; }
            if (dir == 0) { LRU_LOAD_LAB(L, 1); }
            else { if (has_next) { LRU_LOAD_LAB(L + c.G, 0); }
#pragma unroll
                for (int i = 0; i < 4; ++i) { const int p = tid + 512 * i, tok = p >> 4, c16 = p & 15; gw[i] = *(const u32x4*)(GU2 + (r0 + tok) * (size_t)(2 * DR) + head * 128 + c16 * 8); } }
            __syncthreads();
            const int sg = wid, cp = lane;
            float s0 = 0.f, s1 = 0.f, h0 = 0.f, h1 = 0.f;
#pragma unroll
            for (int i = 0; i < 16; ++i) { const int t = 16 * sg + (dir ? 15 - i : i);
                const u32x2 e = *(const LAS u32x2*)(lds + L_LAB + t * LAB_PITCH + cp * 8);
                const float l0 = bf_lo(e.x), l1 = bf_lo(e.y); s0 += l0; s1 += l1;
                h0 = fast_exp(l0) * h0 + bf_hi(e.x); h1 = fast_exp(l1) * h1 + bf_hi(e.y); }
            *(LAS f32x4*)(lds + L_SEG + (sg * 64 + cp) * 16) = (f32x4){fast_exp(s0), fast_exp(s1), h0, h1};
            if (dir == 1) {
#pragma unroll
                for (int i = 0; i < 4; ++i) { const int p = tid + 512 * i; *(LAS u32x4*)(lds + L_A + p * 16) = gw[i]; } }
            __syncthreads();
            const f32x2 cin = *(const LAS f32x2*)(lds + L_CARRY + (dir * 128 + 2 * cp) * 4);
            float c0 = cin.x, c1 = cin.y;
#pragma unroll
            for (int q = 0; q < 7; ++q) { const int s_ = dir ? 7 - q : q; const bool use = dir ? (s_ > sg) : (s_ < sg);
                if (use) { const f32x4 sv = *(const LAS f32x4*)(lds + L_SEG + (s_ * 64 + cp) * 16); c0 = sv.x * c0 + sv.z; c1 = sv.y * c1 + sv.w; } }
            h0 = c0; h1 = c1;
            if (dir == 0) {
#pragma unroll
                for (int i = 0; i < 16; ++i) { const int t = 16 * sg + i;
                    const u32x2 e = *(const LAS u32x2*)(lds + L_LAB + t * LAB_PITCH + cp * 8);
                    h0 = fast_exp(bf_lo(e.x)) * h0 + bf_hi(e.x); h1 = fast_exp(bf_lo(e.y)) * h1 + bf_hi(e.y);
                    *(LAS unsigned*)(lds + L_HF + t * 256 + cp * 4) = cvt_pk_bf16(h0, h1); }
                __syncthreads();
            } else {
#pragma unroll
                for (int i = 0; i < 16; ++i) { const int t = 16 * sg + 15 - i;
                    const u32x2 e = *(const LAS u32x2*)(lds + L_LAB + t * LAB_PITCH + cp * 8);
                    h0 = fast_exp(bf_lo(e.x)) * h0 + bf_hi(e.x); h1 = fast_exp(bf_lo(e.y)) * h1 + bf_hi(e.y);
                    const unsigned fw = *(const LAS unsigned*)(lds + L_HF + t * 256 + cp * 4), gt = *(const LAS unsigned*)(lds + L_A + t * 256 + cp * 4);
                    *(LAS unsigned*)(lds + L_HF + t * 256 + cp * 4) = cvt_pk_bf16((h0 + bf_lo(fw)) * gelu_tanh(bf_lo(gt)), (h1 + bf_hi(fw)) * gelu_tanh(bf_hi(gt))); }
                __syncthreads();
#pragma unroll
                for (int i = 0; i < 4; ++i) { const int p = tid + 512 * i, tok = p >> 4, c16 = p & 15;
                    *(u32x4*)(Yg + (r0 + tok) * (size_t)DR + head * 128 + c16 * 8) = *(const LAS u32x4*)(lds + L_HF + p * 16); }
            }
        }
    }
#undef LRU_LOAD_LAB
}

__device__ __forceinline__ void p12_route(const Args& a, const Ctx& c) {
    LAS unsigned* lcnt = (LAS unsigned*)c.lds;
    if (c.tid < NE) lcnt[c.tid] = 0u;
    __syncthreads();
    const float* X = a.out; const float* gvec = a.in[7] + D; const float* modl = (const float*)(a.ws + WS_MOD) + (size_t)17 * 6144; const float* WR = a.in[21];
    unsigned char* H4 = a.ws + R_H4;
    int* tok_e = (int*)(a.ws + WS_ROUTE); float* tok_w = (float*)(a.ws + WS_ROUTE + (size_t)NX * 8);
    { int* slot_tok = (int*)(a.ws + WS_SLOTTOK); for (int i = blockIdx.x * NTHREADS + c.tid; i < NSLOT; i += c.G * NTHREADS) slot_tok[i] = 0; }
    f32x4 wa[4][4], wb[4][4];
#pragma unroll
    for (int j = 0; j < 4; ++j)
#pragma unroll
        for (int q = 0; q < 4; ++q) { const int col = 4 * (c.lane + 64 * j) + q; wa[j][q] = *(const f32x4*)(WR + (size_t)col * 8); wb[j][q] = *(const f32x4*)(WR + (size_t)col * 8 + 4); }
    const int RPW = (NX + c.NGW - 1) / c.NGW, rbeg = c.gw * RPW, rend = min(NX, rbeg + RPW);
    f32x4 vnx[4], gm[4], shv[4];
    if (rbeg < NX) { const f32x4* xr = (const f32x4*)(X + (size_t)rbeg * D) + c.lane;
#pragma unroll
        for (int j = 0; j < 4; ++j) vnx[j] = xr[64 * j]; }
    int bcur = -1;
    for (int row = rbeg; row < rend; ++row) {
        const int b = row / SEQ; f32x4 v[4]; float ss = 0.f;
#pragma unroll
        for (int j = 0; j < 4; ++j) v[j] = vnx[j];
        if (row + 1 < rend) { const f32x4* xr = (const f32x4*)(X + (size_t)(row + 1) * D) + c.lane;
#pragma unroll
            for (int j = 0; j < 4; ++j) vnx[j] = xr[64 * j]; }
        if (b != bcur) { bcur = b; const float* mb = modl + (size_t)b * 6144;
#pragma unroll
            for (int j = 0; j < 4; ++j) { const int col = 4 * (c.lane + 64 * j); gm[j] = *(const f32x4*)(gvec + col) * (*(const f32x4*)(mb + 4096 + col) + 1.0f); shv[j] = *(const f32x4*)(mb + 3072 + col); } }
#pragma unroll
        for (int j = 0; j < 4; ++j) ss += (v[j].x * v[j].x + v[j].y * v[j].y) + (v[j].z * v[j].z + v[j].w * v[j].w);
        const float rstd = rsqrtf(wave_sum(ss) * (1.0f / D) + EPS);
        f32x4 la = (f32x4){0.f, 0.f, 0.f, 0.f}, lb = (f32x4){0.f, 0.f, 0.f, 0.f};
#pragma unroll
        for (int j = 0; j < 4; ++j) { const int col = 4 * (c.lane + 64 * j);
            const f32x4 h = v[j] * rstd * gm[j] + shv[j];
            *(unsigned*)(H4 + (size_t)row * D + col) = pk4_fp8(h.x, h.y, h.z, h.w);
#pragma unroll
            for (int q = 0; q < 4; ++q) { la += wa[j][q] * h[q]; lb += wb[j][q] * h[q]; } }
        float lg[8] = {la.x, la.y, la.z, la.w, lb.x, lb.y, lb.z, lb.w};
#pragma unroll
        for (int e = 0; e < 8; ++e) lg[e] = wave_sum(lg[e]);
        int e0 = 0; float l0 = lg[0];
#pragma unroll
        for (int e = 1; e < 8; ++e) if (lg[e] > l0) { l0 = lg[e]; e0 = e; }
        int e1 = -1; float l1 = -3.0e38f;
#pragma unroll
        for (int e = 0; e < 8; ++e) if (e != e0 && lg[e] > l1) { l1 = lg[e]; e1 = e; }
        if (c.lane == 0) { const float w0 = 1.0f / (1.0f + __expf(l1 - l0));
            tok_e[row * 2] = e0; tok_e[row * 2 + 1] = e1; tok_w[row * 2] = w0; tok_w[row * 2 + 1] = 1.0f - w0;
            atomicAdd((unsigned*)&lcnt[e0], 1u); atomicAdd((unsigned*)&lcnt[e1], 1u); }
    }
    __syncthreads();
    if (c.tid < NE) atomicAdd((unsigned*)(a.ws + WS_CTL) + c.tid * 64, lcnt[c.tid]);
}

__device__ __forceinline__ void p13_assign(const Args& a, const Ctx& c) {
    unsigned* ctl = (unsigned*)(a.ws + WS_CTL);
    unsigned cnt[8], pst[8]; unsigned run = 0;
#pragma unroll
    for (int e = 0; e < 8; ++e) { cnt[e] = __hip_atomic_load(ctl + e * 64, __ATOMIC_RELAXED, __HIP_MEMORY_SCOPE_AGENT); pst[e] = run; run += (cnt[e] + 255u) & ~255u; }
    if (blockIdx.x == 0 && c.tid == 0) { int* tile_e = (int*)(a.ws + WS_TILEE);
        for (int e = 0; e < 8; ++e) { const unsigned nt_ = ((cnt[e] + 255u) >> 8); for (unsigned j = 0; j < nt_; ++j) tile_e[(pst[e] >> 8) + j] = e; }
        ctl[16 * 64] = run >> 8; }
    const int* tok_e = (const int*)(a.ws + WS_ROUTE); int* tok_slot = (int*)(a.ws + WS_ROUTE + (size_t)NX * 16); int* slot_tok = (int*)(a.ws + WS_SLOTTOK);
    LAS unsigned* wcnt = (LAS unsigned*)c.lds;
    for (int blk = blockIdx.x; blk < NX * 2 / NTHREADS; blk += c.G) {
        const int p = blk * NTHREADS + c.tid; const int e = tok_e[p];
        unsigned rank = 0;
        __syncthreads();
#pragma unroll
        for (int q = 0; q < 8; ++q) { const unsigned long long m = __ballot(e == q); if (e == q) rank = (unsigned)__popcll(m & ((1ull << c.lane) - 1ull)); if (c.lane == 0) wcnt[c.wave * 8 + q] = (unsigned)__popcll(m); }
        __syncthreads();
        if (c.tid < 8) { unsigned tot = 0;
#pragma unroll
            for (int w = 0; w < 8; ++w) tot += wcnt[w * 8 + c.tid];
            wcnt[64 + c.tid] = tot ? atomicAdd(ctl + (8 + c.tid) * 64, tot) : 0u; }
        __syncthreads();
        unsigned off = wcnt[64 + e] + rank;
        for (int w = 0; w < c.wave; ++w) off += wcnt[w * 8 + e];
        const unsigned slot = pst[e] + off;
        tok_slot[p] = (int)slot; slot_tok[slot] = p >> 1;
    }
}

__device__ __forceinline__ void p16_final(const Args& a, const Ctx& c, int gw, int NGW, int mode, int slot_thresh) {
    const float* modl = (const float*)(a.ws + WS_MOD) + (size_t)17 * 6144; const float* fg = a.in[24];
    const float* tok_w = (const float*)(a.ws + WS_ROUTE + (size_t)NX * 8); const int* tok_slot = (const int*)(a.ws + WS_ROUTE + (size_t)NX * 16);
    const bf16_t* YS = (const bf16_t*)(a.ws + R_HP);
    const int RPW = ((NX + NGW - 1) / NGW + 1) & ~1, rbeg = gw * RPW, rend = min(NX, rbeg + RPW);
    f32x4 g2v[4], fgv[4]; int bcur = -1;
#pragma unroll
    for (int j = 0; j < 4; ++j) fgv[j] = *(const f32x4*)(fg + 4 * (c.lane + 64 * j));
    for (int row0 = rbeg; row0 < rend; row0 += 2) {
        f32x4 v[2][4]; u32x2 ya[2][4], yb[2][4]; float w0[2], w1[2]; bool go[2];
#pragma unroll
        for (int r = 0; r < 2; ++r) { const int row = row0 + r; const f32x4* xr = (const f32x4*)(a.out + (size_t)row * D) + c.lane;
            const int s0 = tok_slot[row * 2], s1 = tok_slot[row * 2 + 1];
            go[r] = mode == 0 || ((max(s0, s1) >= slot_thresh) == (mode == 2));
            if (go[r]) { w0[r] = tok_w[row * 2]; w1[r] = tok_w[row * 2 + 1];
                const u32x2* y0 = (const u32x2*)(YS + (size_t)s0 * D) + c.lane; const u32x2* y1 = (const u32x2*)(YS + (size_t)s1 * D) + c.lane;
#pragma unroll
                for (int j = 0; j < 4; ++j) { v[r][j] = xr[64 * j]; ya[r][j] = __builtin_nontemporal_load(y0 + 64 * j); yb[r][j] = __builtin_nontemporal_load(y1 + 64 * j); } } }
        const int b = row0 / SEQ;
        if (b != bcur) { bcur = b;
#pragma unroll
            for (int j = 0; j < 4; ++j) g2v[j] = *(const f32x4*)(modl + (size_t)b * 6144 + 5120 + 4 * (c.lane + 64 * j)); }
#pragma unroll
        for (int r = 0; r < 2; ++r) if (go[r]) { const int row = row0 + r; f32x4* xr = (f32x4*)(a.out + (size_t)row * D) + c.lane; float ss = 0.f;
#pragma unroll
            for (int j = 0; j < 4; ++j) { const u32x2 a0 = ya[r][j], a1 = yb[r][j];
                const f32x4 y0v = (f32x4){bf_lo(a0.x), bf_hi(a0.x), bf_lo(a0.y), bf_hi(a0.y)}, y1v = (f32x4){bf_lo(a1.x), bf_hi(a1.x), bf_lo(a1.y), bf_hi(a1.y)};
                v[r][j] = v[r][j] + g2v[j] * (y0v * w0[r] + y1v * w1[r]);
                ss += (v[r][j].x * v[r][j].x + v[r][j].y * v[r][j].y) + (v[r][j].z * v[r][j].z + v[r][j].w * v[r][j].w); }
            const float rstd = rsqrtf(wave_sum(ss) * (1.0f / D) + EPS);
#pragma unroll
            for (int j = 0; j < 4; ++j) xr[64 * j] = v[r][j] * rstd * fgv[j]; }
    }
}

__global__ void __launch_bounds__(NTHREADS, 2) trunk_fwd(Args a) {
    extern __shared__ __attribute__((aligned(16))) unsigned char lds_raw[];
    Ctx c; c.lds = (LAS unsigned char*)lds_raw; c.tid = threadIdx.x; c.lane = c.tid & 63; c.wave = __builtin_amdgcn_readfirstlane(c.tid >> 6);
    c.G = gridDim.x; c.gw = blockIdx.x * NWAVES + c.wave; c.NGW = c.G * NWAVES;
    unsigned char* ws = a.ws;
    const float* mod0 = (const float*)(ws + WS_MOD); const float* mod1 = mod0 + (size_t)17 * 6144;
    float* ZR = (float*)(ws + WS_ZRES);
    const int lo = a.ph_lo, hi = a.ph_hi;
#define IN(k) (lo <= (k) && (k) < hi)
    volatile LAS unsigned* MISC = (volatile LAS unsigned*)(c.lds + LDS_BYTES - 64);
    if (c.tid < 16) MISC[c.tid] = 0u;
    __syncthreads();
    XcdBarrier bar; bar.bar = (unsigned*)(ws + WS_BAR); bar.x = 0; bar.st = MISC;
    if (hi - lo > 1) bar = xcd_barrier_post((unsigned*)(ws + WS_BAR), MISC);
#ifdef PROBE_PH
    unsigned long long pt0 = 0, pt1 = 0;
#define PSTAMP(k) do { if ((k) == PROBE_PH) pt0 = __builtin_amdgcn_s_memrealtime(); if ((k) == PROBE_PH_END + 1) pt1 = __builtin_amdgcn_s_memrealtime(); } while (0)
#else
#define PSTAMP(k) do { } while (0)
#endif
#define SEAM(k) do { if (IN(k) && IN((k) + 1)) { xcd_barrier(bar); } PSTAMP((k) + 1); } while (0)
    PSTAMP(0);

    if (IN(0)) { p0_adaln(a, c); p0_convert(a, c); } SEAM(0);
    if (IN(1)) { pool_fused(a, c); } SEAM(1);
    PSTAMP(3); PSTAMP(4);
    if (IN(4)) {
        pg8::Prob P{(const bf16_t*)(ws + R_HB), (const bf16_t*)(ws + W_GUT), NT / 256, 2 * DFF / 256, D, D, D, 0, 0, nullptr, 0, nullptr, c.G, (int)blockIdx.x};
        P.esz = 1;
        pg8::EpiSwiGLU8 E{ws + R_HID, DFF};
        pg8::gemm_phase<pg8::EpiSwiGLU8, false, true>(c.lds, P, E);
        if ((int)blockIdx.x >= (NT / 256 * (2 * DFF / 256)) % c.G) moe_convert_queue(a, c, 1);
    } SEAM(4);
    if (IN(5)) {
        pg8::Prob P{(const bf16_t*)(ws + R_HID), (const bf16_t*)(ws + W_DT), NT / 256, D / 256, DFF, DFF, DFF, 0, 0, nullptr, 0, nullptr, c.G, (int)blockIdx.x};
        P.esz = 1;
        pg8::EpiResid E{a.out, a.out, ZR, ZR, mod0 + 5120, nullptr};
        pg8::gemm_phase<pg8::EpiResid, false, true>(c.lds, P, E);
        if ((int)blockIdx.x >= (NT / 256 * (D / 256)) % c.G) moe_convert_queue(a, c, 3);
    } SEAM(5);
    if (IN(6)) { norm_mod_rows(a.out, ZR, NT, a.in[6] + D, mod1, 0, 1024, (bf16_t*)(ws + R_H3), c); } SEAM(6);
    if (IN(7)) {
        pg8::Prob P{(const bf16_t*)(ws + R_H3), (const bf16_t*)(ws + W_INT), NT / 256, 2 * DR / 256, D, D, D, 0, 0, nullptr, 0, nullptr, c.G, (int)blockIdx.x};
        pg8::EpiBf16 E{(bf16_t*)(ws + R_GU2), 2 * DR};
        pg8::gemm_phase(c.lds, P, E);
    } SEAM(7);
    if (IN(8)) { lru_pass<1>(a, c); } SEAM(8);
    if (IN(9)) { lru_scan2(a, c); } SEAM(9);
    PSTAMP(11); PSTAMP(12);
    if (IN(12)) {
        pg8::Prob P{(const bf16_t*)(ws + R_Y), (const bf16_t*)(ws + W_OUTT), NX / 256, D / 256, DR, DR, DR, 0, 0, nullptr, 0, nullptr, c.G, (int)blockIdx.x};
        pg8::EpiResid E{a.out, a.out, ZR, ZR, mod1 + 2048, nullptr};
        pg8::gemm_phase(c.lds, P, E);
    } SEAM(12);
    if (IN(13)) { p12_route(a, c); } SEAM(13);
    if (IN(14)) { p13_assign(a, c); moe_convert_queue(a, c, 1 << 20); } SEAM(14);
    if (IN(15)) {
        const int mt = (int)__hip_atomic_load((unsigned*)(ws + WS_CTL) + 16 * 64, __ATOMIC_RELAXED, __HIP_MEMORY_SCOPE_AGENT);
        pg8::Prob P{(const bf16_t*)(ws + R_H4), (const bf16_t*)(ws + W_MGUT), mt, 2 * DE / 256, D, D, D, 0, 0, (const int*)(ws + WS_TILEE), (size_t)2 * DE * D, (const int*)(ws + WS_SLOTTOK), c.G, (int)blockIdx.x};
        P.esz = 1;
        pg8::EpiSwiGLU8 E{ws + R_MH, DE};
        pg8::gemm_phase<pg8::EpiSwiGLU8, true, true>(c.lds, P, E);
    } SEAM(15);
    if (IN(16)) {
        const int mt = (int)__hip_atomic_load((unsigned*)(ws + WS_CTL) + 16 * 64, __ATOMIC_RELAXED, __HIP_MEMORY_SCOPE_AGENT), main_mt = (mt / 64) * 64;
        pg8::Prob P{(const bf16_t*)(ws + R_MH), (const bf16_t*)(ws + W_MDT), main_mt, D / 256, DE, DE, DE, 0, 0, (const int*)(ws + WS_TILEE), (size_t)D * DE, nullptr, c.G, (int)blockIdx.x};
        P.esz = 1;
        pg8::EpiBf16 E{(bf16_t*)(ws + R_HP), D};
        pg8::gemm_phase<pg8::EpiBf16, false, true>(c.lds, P, E);
    } SEAM(16);
    if (IN(17)) {
        const int mt = (int)__hip_atomic_load((unsigned*)(ws + WS_CTL) + 16 * 64, __ATOMIC_RELAXED, __HIP_MEMORY_SCOPE_AGENT), main_mt = (mt / 64) * 64, ntail = (mt - main_mt) * 4;
        if (ntail >= c.G || (int)blockIdx.x < ntail) {
            pg8::Prob P{(const bf16_t*)(ws + R_MH), (const bf16_t*)(ws + W_MDT), mt - main_mt, D / 256, DE, DE, DE, 0, 0, (const int*)(ws + WS_TILEE), (size_t)D * DE, nullptr, c.G, (int)blockIdx.x};
            P.esz = 1; P.pm_off = main_mt;
            pg8::EpiBf16 E{(bf16_t*)(ws + R_HP), D};
            pg8::gemm_phase<pg8::EpiBf16, false, true>(c.lds, P, E);
        } else {
            p16_final(a, c, ((int)blockIdx.x - ntail) * NWAVES + c.wave, (c.G - ntail) * NWAVES, 1, main_mt * 256);
        }
    } SEAM(17);
    if (IN(18)) {
        const int mt = (int)__hip_atomic_load((unsigned*)(ws + WS_CTL) + 16 * 64, __ATOMIC_RELAXED, __HIP_MEMORY_SCOPE_AGENT), main_mt = (mt / 64) * 64, ntail = (mt - main_mt) * 4;
        p16_final(a, c, c.gw, c.NGW, ntail < c.G ? 2 : 0, main_mt * 256);
    }
#ifdef PROBE_PH
    if (PROBE_PH_END + 1 > NPHASES) pt1 = __builtin_amdgcn_s_memrealtime();
    { const unsigned long long tend = __builtin_amdgcn_s_memrealtime(), dt = (pt1 - pt0) * PROBE_MULT;
      while (__builtin_amdgcn_s_memrealtime() - tend < dt) __builtin_amdgcn_s_sleep(8); }
#endif
#undef IN
#undef SEAM
}

extern "C" void kernel_launch(void* const* d_in, const int* in_sizes, int n_in, void* d_out, int out_size, void* d_ws, size_t ws_size, hipStream_t stream) {
    static int grid = 0;
    if (grid == 0) {
        if (n_in != 25 || out_size != NX * D || ws_size < WS_NEED) { fprintf(stderr, "kernel_launch: unexpected shapes (n_in %d out %d ws %zu, need %zu)\n", n_in, out_size, ws_size, (size_t)WS_NEED); grid = -1; return; }
        int dev = 0, cus = 0, per_cu = 0;
        hipGetDevice(&dev); hipDeviceGetAttribute(&cus, hipDeviceAttributeMultiprocessorCount, dev);
        if (hipFuncSetAttribute((const void*)trunk_fwd, hipFuncAttributeMaxDynamicSharedMemorySize, LDS_BYTES) != hipSuccess) { fprintf(stderr, "kernel_launch: hipFuncSetAttribute failed\n"); grid = -1; return; }
        if (hipOccupancyMaxActiveBlocksPerMultiprocessor(&per_cu, (const void*)trunk_fwd, NTHREADS, LDS_BYTES) != hipSuccess || per_cu < 1) { fprintf(stderr, "kernel_launch: occupancy query says %d\n", per_cu); per_cu = 1; }
        (void)hipGetLastError();
        grid = cus;
    }
    if (grid < 0) return;
    hipMemsetAsync((char*)d_ws + WS_CTL, 0, CTL_BYTES, stream);
    Args a{};
    for (int i = 0; i < 25; ++i) a.in[i] = (const float*)d_in[i];
    a.out = (float*)d_out; a.ws = (unsigned char*)d_ws;
#if MK_SINGLE
    a.ph_lo = 0; a.ph_hi = NPHASES + 1;
    hipLaunchKernelGGL(trunk_fwd, dim3(grid), dim3(NTHREADS), LDS_BYTES, stream, a);
#else
    for (int ph = 0; ph <= NPHASES; ++ph) { a.ph_lo = ph; a.ph_hi = ph + 1;
        hipLaunchKernelGGL(trunk_fwd, dim3(grid), dim3(NTHREADS), LDS_BYTES, stream, a); }
#endif
}
```

```cpp
#include <hip/hip_runtime.h>
#include <cstdio>
#include <cstdint>

#define LAS __attribute__((address_space(3)))
typedef unsigned short bf16_t;
typedef short bf16x8 __attribute__((ext_vector_type(8)));
typedef float f32x4 __attribute__((ext_vector_type(4)));
typedef float f32x2 __attribute__((ext_vector_type(2)));
typedef unsigned u32x4 __attribute__((ext_vector_type(4)));
typedef unsigned u32x2 __attribute__((ext_vector_type(2)));
typedef int i32x4 __attribute__((ext_vector_type(4)));
typedef int i32x8 __attribute__((ext_vector_type(8)));

#ifndef MK_SINGLE
#define MK_SINGLE 1
#endif

constexpr int D = 1024, NB = 16, SEQ = 2048, CL = 256, NX = NB * SEQ, NZ = NB * CL, NT = NX + NZ;
constexpr int DFF = 2816, DR = 1280, DE = 3584, NE = 8;
constexpr int NSLOT = (NX * 2 / 256 + NE) * 256;
constexpr int NWAVES = 8, NTHREADS = 512;
constexpr float EPS = 1e-6f;
constexpr int NPHASES = 18;
constexpr int LDS_BYTES = 147456;

constexpr size_t MiB = 1024 * 1024;
constexpr size_t WS_CTL = 0;
constexpr size_t CTL_BYTES = 32768;
constexpr size_t WS_BAR = 16384;
constexpr size_t WS_TILEE = 8192;
constexpr size_t WS_MOD = 64 * 1024;
constexpr size_t WS_SP = 900 * 1024;
constexpr size_t WS_ROUTE = 1 * MiB;
constexpr size_t WS_SLOTTOK = 2 * MiB;
constexpr size_t WS_CHUNK = 3 * MiB;
constexpr size_t WS_ZRES = 9 * MiB;
constexpr size_t WS_W = 25 * MiB;
constexpr size_t W_POOLT = WS_W;
constexpr size_t W_GUT = W_POOLT + (size_t)1024 * 256 * 2;
constexpr size_t W_DT = W_GUT + (size_t)5632 * 1024 * 2;
constexpr size_t W_INT = W_DT + (size_t)1024 * 2816 * 2;
constexpr size_t W_GT = W_INT + (size_t)2560 * 1024 * 2;
constexpr size_t W_OUTT = W_GT + (size_t)5120 * 256 * 2;
constexpr size_t W_MGUT = W_OUTT + (size_t)1024 * 1280 * 2;
constexpr size_t W_MDT = W_MGUT + (size_t)8 * 7168 * 1024 * 2;
constexpr size_t W_END = W_MDT + (size_t)8 * 1024 * 3584 * 2;
constexpr size_t WS_R = 221 * MiB;
static_assert(W_END <= WS_R, "weights overflow");
constexpr size_t R_HB = WS_R;
constexpr size_t R_HID = WS_R + 72 * MiB;
constexpr size_t R_GU2 = WS_R;
constexpr size_t R_Y = WS_R + 180 * MiB;
constexpr size_t R_H3 = WS_R + 270 * MiB;
constexpr size_t R_LABG = WS_R + 270 * MiB;
constexpr size_t R_HP = WS_R;
constexpr size_t R_MH = WS_R + 132 * MiB;
constexpr size_t R_H4 = WS_R;
constexpr size_t WS_NEED = WS_R + 630 * MiB;
static_assert(R_MH + (size_t)NSLOT * DE * 2 <= WS_NEED, "MH overflow");
static_assert(WS_NEED <= (size_t)896 * MiB, "workspace");

__device__ __forceinline__ unsigned cvt_pk_bf16(float lo, float hi) { unsigned r; asm volatile("v_cvt_pk_bf16_f32 %0, %1, %2" : "=v"(r) : "v"(lo), "v"(hi)); return r; }
__device__ __forceinline__ unsigned pk4_fp8(float a, float b, float c, float d) { int w = 0; w = __builtin_amdgcn_cvt_pk_fp8_f32(a, b, w, false); w = __builtin_amdgcn_cvt_pk_fp8_f32(c, d, w, true); return (unsigned)w; }
constexpr float W8_SCALE = 64.0f;
__device__ __forceinline__ float bf_lo(unsigned u) { return __uint_as_float(u << 16); }
__device__ __forceinline__ float bf_hi(unsigned u) { return __uint_as_float(u & 0xffff0000u); }
__device__ __forceinline__ float wave_sum(float v) {
#pragma unroll
    for (int o = 1; o < 64; o <<= 1) v += __shfl_xor(v, o);
    return v;
}
__device__ __forceinline__ float fast_exp(float x) { return __builtin_amdgcn_exp2f(x * 1.44269504089f); }
__device__ __forceinline__ float sigmoidf_(float x) { return __builtin_amdgcn_rcpf(1.0f + fast_exp(-x)); }
__device__ __forceinline__ float siluf_(float x) { return x * sigmoidf_(x); }
__device__ __forceinline__ float gelu_tanh(float x) {
    const float u = 0.7978845608f * (x + 0.044715f * x * x * x);
    const float t = 1.0f - 2.0f * __builtin_amdgcn_rcpf(fast_exp(2.0f * u) + 1.0f);
    return 0.5f * x * (1.0f + t);
}

#ifdef PROBE_SUB
#define SUBT0(id) do { if ((id) == PROBE_SUB) psub_t0 = __builtin_amdgcn_s_memrealtime(); } while (0)
#define SUBT1(id) do { if ((id) == PROBE_SUB) psub_acc += __builtin_amdgcn_s_memrealtime() - psub_t0; } while (0)
#define SUBDECL unsigned long long psub_t0 = 0, psub_acc = 0
#define SUBSPIN do { const unsigned long long te_ = __builtin_amdgcn_s_memrealtime(); while (__builtin_amdgcn_s_memrealtime() - te_ < psub_acc) __builtin_amdgcn_s_sleep(8); } while (0)
#else
#define SUBT0(id) do { } while (0)
#define SUBT1(id) do { } while (0)
#define SUBDECL do { } while (0)
#define SUBSPIN do { } while (0)
#endif
namespace pg8 {
constexpr int BM = 256, BK = 64, HALF = 128, HTB = HALF * BK * 2, STAGE_BYTES = 8 * HTB, NXCD = 8, WGM = 8;
__device__ __forceinline__ int lds_byte(int r, int c) { const int st = (r >> 4) * 2 + (c >> 5), rr = r & 15, cc = c & 31, ob = rr * 64 + cc * 2; return st * 1024 + (ob ^ (((ob >> 9) & 1) << 5)); }
__device__ __forceinline__ void stage_rc(int b, int& R, int& C) { const int st = b / 1024, sb = b % 1024, swz = sb ^ (((sb >> 9) & 1) << 5); R = (st >> 1) * 16 + swz / 64; C = (st & 1) * 32 + (swz % 64) / 2; }
__device__ __forceinline__ int perm32(int rho) { const int n = rho >> 4, i = rho & 15; return 8 * (i >> 2) + 4 * n + (i & 3); }

struct Unit { int pm, pn; const char* A; const char* B; };

struct Prob {
    const bf16_t* A; const bf16_t* Bt; int nM, nN, K, lda, ldb;
    int grp, kshr;
    const int* tile_e; size_t estride;
    const int* rowidx;
    int G, c;
    int pm_off = 0;
    int esz = 2;
    __device__ __forceinline__ bool next(int i, Unit& u) const {
        const int nwg = nM * nN; const long L = (long)i * G + c; if (L >= nwg) return false;
        int wgid = (int)L; { const int q = nwg / NXCD, r = nwg % NXCD, xcd = wgid % NXCD, off = wgid / NXCD; wgid = (xcd < r ? xcd * (q + 1) : r * (q + 1) + (xcd - r) * q) + off; }
        const int nig = WGM * nN, gid = wgid / nig, fm = gid * WGM, gsz = (nM - fm) < WGM ? (nM - fm) : WGM;
        u.pm = fm + ((wgid % nig) % gsz) + pm_off; u.pn = (wgid % nig) / gsz;
        u.A = rowidx ? (const char*)A : (const char*)A + ((size_t)u.pm * BM * lda + (grp ? (size_t)((u.pn >> kshr) * 256) : (size_t)0)) * esz;
        size_t bo = (size_t)u.pn * BM * ldb;
        if (tile_e) bo += (size_t)tile_e[u.pm] * estride;
        u.B = (const char*)Bt + bo * esz;
        return true;
    }
};

struct EpiBf16 {
    static constexpr bool PERM = true;
    bf16_t* O; int ldc; float sc = 1.0f;
    __device__ __forceinline__ void operator()(const f32x4 (&acc)[2][2][4][2], const Unit& u, int wr, int wc, int fr, int fq) const {
        const int row0 = u.pm * BM + wr * 64 + fr, col0 = u.pn * BM + wc * 32 + 8 * fq;
#pragma unroll
        for (int ai = 0; ai < 2; ++ai)
#pragma unroll
            for (int m = 0; m < 4; ++m) { bf16_t* rowp = O + (size_t)(row0 + ai * HALF + m * 16) * ldc + col0;
#pragma unroll
                for (int bj = 0; bj < 2; ++bj) { const f32x4 v0 = acc[ai][bj][m][0] * sc, v1 = acc[ai][bj][m][1] * sc;
                    u32x4 w; w.x = cvt_pk_bf16(v0[0], v0[1]); w.y = cvt_pk_bf16(v0[2], v0[3]); w.z = cvt_pk_bf16(v1[0], v1[1]); w.w = cvt_pk_bf16(v1[2], v1[3]);
                    *(u32x4*)(rowp + bj * HALF) = w; } }
    }
};
struct EpiSwiGLU {
    static constexpr bool PERM = true;
    bf16_t* O; int ldc;
    __device__ __forceinline__ void operator()(const f32x4 (&acc)[2][2][4][2], const Unit& u, int wr, int wc, int fr, int fq) const {
        const int row0 = u.pm * BM + wr * 64 + fr, col0 = u.pn * HALF + wc * 32 + 8 * fq;
#pragma unroll
        for (int ai = 0; ai < 2; ++ai)
#pragma unroll
            for (int m = 0; m < 4; ++m) { bf16_t* rowp = O + (size_t)(row0 + ai * HALF + m * 16) * ldc + col0;
                float v[8];
#pragma unroll
                for (int n = 0; n < 2; ++n)
#pragma unroll
                    for (int j = 0; j < 4; ++j) v[n * 4 + j] = siluf_(acc[ai][0][m][n][j]) * acc[ai][1][m][n][j];
                u32x4 w; w.x = cvt_pk_bf16(v[0], v[1]); w.y = cvt_pk_bf16(v[2], v[3]); w.z = cvt_pk_bf16(v[4], v[5]); w.w = cvt_pk_bf16(v[6], v[7]);
                *(u32x4*)rowp = w; }
    }
};
struct EpiSwiGLU8 {
    static constexpr bool PERM = true;
    unsigned char* O; int ldc;
    __device__ __forceinline__ void operator()(const f32x4 (&acc)[2][2][4][2], const Unit& u, int wr, int wc, int fr, int fq) const {
        const int row0 = u.pm * BM + wr * 64 + fr, col0 = u.pn * HALF + wc * 32 + 8 * (fq & ~1); const bool odd = fq & 1;
#pragma unroll
        for (int ai = 0; ai < 2; ++ai)
#pragma unroll
            for (int mp = 0; mp < 2; ++mp) { u32x2 w[2];
#pragma unroll
                for (int q = 0; q < 2; ++q) { const int m = 2 * mp + q; float v[8];
#pragma unroll
                    for (int n = 0; n < 2; ++n)
#pragma unroll
                        for (int j = 0; j < 4; ++j) v[n * 4 + j] = siluf_(acc[ai][0][m][n][j]) * acc[ai][1][m][n][j];
                    w[q].x = pk4_fp8(v[0], v[1], v[2], v[3]); w[q].y = pk4_fp8(v[4], v[5], v[6], v[7]); }
                const u32x2 send = odd ? w[0] : w[1];
                u32x2 recv; recv.x = (unsigned)__shfl_xor((int)send.x, 16); recv.y = (unsigned)__shfl_xor((int)send.y, 16);
                const int m = 2 * mp + (odd ? 1 : 0);
                u32x4 o; if (odd) { o.x = recv.x; o.y = recv.y; o.z = w[1].x; o.w = w[1].y; } else { o.x = w[0].x; o.y = w[0].y; o.z = recv.x; o.w = recv.y; }
                *(u32x4*)(O + (size_t)(row0 + ai * HALF + m * 16) * ldc + col0) = o; }
    }
};
struct EpiResid {
    static constexpr bool PERM = false;
    const float* xb; float* xo; const float* zb; float* zo; const float* gate  ; const float* colscale; float sc = 1.0f;
    __device__ __forceinline__ void operator()(const f32x4 (&acc)[2][2][4][2], const Unit& u, int wr, int wc, int fr, int fq) const {
        const bool isx = u.pm < NX / BM; const int b = isx ? (u.pm >> 3) : NB;
        const float* base = isx ? xb + (size_t)u.pm * BM * D : zb + (size_t)(u.pm - NX / BM) * BM * D;
        float* out = isx ? xo + (size_t)u.pm * BM * D : zo + (size_t)(u.pm - NX / BM) * BM * D;
        const int col0 = u.pn * BM + wc * 32 + 4 * fq;
        f32x4 gv[2][2];
#pragma unroll
        for (int bj = 0; bj < 2; ++bj)
#pragma unroll
            for (int n = 0; n < 2; ++n) { const int col = col0 + bj * HALF + n * 16; gv[bj][n] = *(const f32x4*)(gate + (size_t)b * 6144 + col) * sc; if (colscale) gv[bj][n] = gv[bj][n] * *(const f32x4*)(colscale + col); }
#pragma unroll
        for (int ai = 0; ai < 2; ++ai)
#pragma unroll
            for (int m = 0; m < 4; ++m) { const size_t off = (size_t)(ai * HALF + wr * 64 + m * 16 + fr) * D + col0;
#pragma unroll
                for (int bj = 0; bj < 2; ++bj)
#pragma unroll
                    for (int n = 0; n < 2; ++n) { const f32x4 bs = *(const f32x4*)(base + off + bj * HALF + n * 16);
                        *(f32x4*)(out + off + bj * HALF + n * 16) = bs + gv[bj][n] * acc[ai][bj][m][n]; } }
    }
};
template <class Epi, bool GATHER = false, bool FP8 = false>
__device__ __forceinline__ void gemm_phase(LAS unsigned char* lds, const Prob& S, const Epi& E) {
    const int tid = threadIdx.x, wid = __builtin_amdgcn_readfirstlane(tid >> 6), lane = tid & 63, wr = wid >> 2, wc = wid & 3, fr = lane & 15, fq = lane >> 4;
    const int ESZ = FP8 ? 1 : 2;
    const int K = S.K, nt = K * ESZ / (BK * 2);
    unsigned voffA[2], voffB[2];
#pragma unroll
    for (int i = 0; i < 2; ++i) { int R, C; stage_rc(tid * 16 + i * 8192, R, C); const int Rb = Epi::PERM ? ((R & ~31) + perm32(R & 31)) : R;
        voffA[i] = (unsigned)(R * S.lda * ESZ + C * 2); voffB[i] = (unsigned)(Rb * S.ldb * ESZ + C * 2); }
    const size_t kstep = (size_t)(BK * 2);
    const size_t hstepA = GATHER ? (size_t)0 : (size_t)HALF * S.lda * ESZ, hstepB = (size_t)HALF * S.ldb * ESZ;
    unsigned gc[2][2], gn[2][2];
#define PG8_GLOAD(dst, pm_) do { _Pragma("unroll") for (int _i = 0; _i < 2; ++_i) { int R_, C_; stage_rc(tid * 16 + _i * 8192, R_, C_); _Pragma("unroll") for (int _h = 0; _h < 2; ++_h) \
        dst[_h][_i] = (unsigned)S.rowidx[(pm_) * BM + _h * HALF + R_] * (unsigned)(S.lda * ESZ) + (unsigned)(C_ * 2); } } while (0)
    const unsigned ldsw = (unsigned)wid * 1024u;
    const int aoff = lds_byte(wr * 64 + fr, fq * 8), boff = lds_byte(wc * 32 + fr, fq * 8);
#define PG8_SA(b, h) (((b) * 2 + (h)) * HTB)
#define PG8_SB(b, h) ((4 + (b) * 2 + (h)) * HTB)
#define PG8_STAGE(bufoff, gbase, voff) do { _Pragma("unroll") for (int _i = 0; _i < 2; ++_i) \
        __builtin_amdgcn_global_load_lds((const unsigned*)((const char*)(gbase) + (voff)[_i]), (LAS unsigned*)(lds + (bufoff) + ldsw + _i * 8192), 16, 0, 0); } while (0)
#define PG8_STAGEA(bufoff, gbase, h, offs) do { if constexpr (GATHER) { PG8_STAGE(bufoff, gbase, offs[h]); } else { PG8_STAGE(bufoff, (gbase) + (h) * hstepA, voffA); } } while (0)
#define PG8_STAGEA2(bufoff, gbase, h) do { if constexpr (GATHER) { unsigned o_[2] = {last ? gn[h][0] : gc[h][0], last ? gn[h][1] : gc[h][1]}; PG8_STAGE(bufoff, gbase, o_); } else { PG8_STAGE(bufoff, (gbase) + (h) * hstepA, voffA); } } while (0)
#define PG8_LD32(p_) __builtin_shufflevector(*(const LAS i32x4*)(p_), *(const LAS i32x4*)((p_) + 1024), 0, 1, 2, 3, 4, 5, 6, 7)
#define PG8_LDA(dst, b, h) do { if constexpr (FP8) { _Pragma("unroll") for (int m = 0; m < 4; ++m) dst##8[m] = PG8_LD32(lds + PG8_SA(b, h) + aoff + m * 2048); } \
        else { _Pragma("unroll") for (int m = 0; m < 4; ++m) _Pragma("unroll") for (int k = 0; k < 2; ++k) dst[m][k] = *(const LAS bf16x8*)(lds + PG8_SA(b, h) + aoff + m * 2048 + k * 1024); } } while (0)
#define PG8_LDB(dst, b, h) do { if constexpr (FP8) { _Pragma("unroll") for (int n = 0; n < 2; ++n) dst##8[n] = PG8_LD32(lds + PG8_SB(b, h) + boff + n * 2048); } \
        else { _Pragma("unroll") for (int n = 0; n < 2; ++n) _Pragma("unroll") for (int k = 0; k < 2; ++k) dst[n][k] = *(const LAS bf16x8*)(lds + PG8_SB(b, h) + boff + n * 2048 + k * 1024); } } while (0)
#define PG8_MMA(ai, bj, At, Bt) do { __builtin_amdgcn_s_setprio(1); \
        if constexpr (FP8) { _Pragma("unroll") for (int m = 0; m < 4; ++m) _Pragma("unroll") for (int n = 0; n < 2; ++n) \
            asm volatile("v_mfma_scale_f32_16x16x128_f8f6f4 %0, %1, %2, %0, %3, %4 op_sel_hi:[0,0,0]" : "+v"(acc[ai][bj][m][n]) : "v"(Bt##8[n]), "v"(At##8[m]), "v"(scalew), "v"(scale1)); } \
        else { _Pragma("unroll") for (int m = 0; m < 4; ++m) _Pragma("unroll") for (int n = 0; n < 2; ++n) _Pragma("unroll") for (int k = 0; k < 2; ++k) \
            acc[ai][bj][m][n] = __builtin_amdgcn_mfma_f32_16x16x32_bf16(Bt[n][k], At[m][k], acc[ai][bj][m][n], 0, 0, 0); } \
        __builtin_amdgcn_s_setprio(0); } while (0)
#define PG8_WAIT_V(n) asm volatile("s_waitcnt vmcnt(" #n ")" ::: "memory")
#define PG8_WAIT_L(n) asm volatile("s_waitcnt lgkmcnt(" #n ")" ::: "memory")
#define PG8_BAR __builtin_amdgcn_s_barrier()
#define PG8_SCHED __builtin_amdgcn_sched_barrier(0)
    SUBDECL;
    Unit cur, nxt; int ui = 0;
    if (!S.next(0, cur)) return;
    f32x4 acc[2][2][4][2];
#pragma unroll
    for (int a = 0; a < 2; ++a)
#pragma unroll
        for (int b = 0; b < 2; ++b)
#pragma unroll
            for (int m = 0; m < 4; ++m)
#pragma unroll
                for (int n = 0; n < 2; ++n) acc[a][b][m][n] = (f32x4){0.f, 0.f, 0.f, 0.f};
    int scale1 = 0x7F7F7F7F, scalew = 0x79797979; asm volatile("" : "+v"(scale1), "+v"(scalew));
    bf16x8 At[4][2], B0[2][2], B1[2][2]; i32x8 At8[4], B08[2], B18[2];
    const char* cA = cur.A; const char* cB = cur.B;
    if constexpr (GATHER) { PG8_GLOAD(gc, cur.pm); asm volatile("s_waitcnt vmcnt(0)" ::: "memory"); }
    PG8_STAGE(PG8_SB(0, 0), cB, voffB); PG8_STAGE(PG8_SB(0, 1), cB + hstepB, voffB); PG8_STAGEA(PG8_SA(0, 0), cA, 0, gc); PG8_STAGEA(PG8_SA(0, 1), cA, 1, gc);
    if (wr == 1) PG8_BAR;
    PG8_WAIT_V(2); PG8_BAR;
    PG8_STAGE(PG8_SB(1, 0), cB + kstep, voffB); PG8_STAGEA(PG8_SA(1, 0), cA + kstep, 0, gc); PG8_STAGE(PG8_SB(1, 1), cB + hstepB + kstep, voffB);
    PG8_WAIT_V(6); PG8_BAR;
    for (;;) {
        const bool has_next = S.next(ui + 1, nxt);
        const char* nA = has_next ? nxt.A : cA; const char* nB = has_next ? nxt.B : cB;
        if constexpr (GATHER) { PG8_GLOAD(gn, (has_next ? nxt.pm : cur.pm)); asm volatile("s_waitcnt vmcnt(0)" ::: "memory"); }
        for (int t = 0; t < nt; t += 2) {
            const bool last = (t == nt - 2);
            const char* a1 = cA + (size_t)(t + 1) * kstep;
            const char* a2 = last ? nA : cA + (size_t)(t + 2) * kstep; const char* b2 = last ? nB : cB + (size_t)(t + 2) * kstep;
            const char* a3 = a2 + kstep; const char* b3 = b2 + kstep;
            PG8_LDB(B0, 0, 0); PG8_LDB(B1, 0, 1); PG8_SCHED; PG8_LDA(At, 0, 0); PG8_STAGEA(PG8_SA(1, 1), a1, 1, gc);
            PG8_WAIT_V(8); PG8_WAIT_L(0); PG8_BAR; PG8_MMA(0, 0, At, B0); PG8_MMA(0, 1, At, B1); PG8_BAR; PG8_SCHED;
            PG8_LDA(At, 0, 1); PG8_STAGE(PG8_SB(0, 0), b2, voffB); PG8_STAGE(PG8_SB(0, 1), b2 + hstepB, voffB); PG8_STAGEA2(PG8_SA(0, 0), a2, 0);
            PG8_WAIT_V(8); PG8_WAIT_L(0); PG8_BAR; PG8_MMA(1, 0, At, B0); PG8_MMA(1, 1, At, B1); PG8_BAR; PG8_SCHED;
            PG8_LDB(B0, 1, 0); PG8_LDB(B1, 1, 1); PG8_SCHED; PG8_LDA(At, 1, 0); PG8_STAGEA2(PG8_SA(0, 1), a2, 1);
            PG8_WAIT_V(8); PG8_WAIT_L(0); PG8_BAR; PG8_MMA(0, 0, At, B0); PG8_MMA(0, 1, At, B1); PG8_BAR; PG8_SCHED;
            PG8_LDA(At, 1, 1); PG8_STAGE(PG8_SB(1, 0), b3, voffB); PG8_STAGE(PG8_SB(1, 1), b3 + hstepB, voffB); PG8_STAGEA2(PG8_SA(1, 0), a3, 0);
            PG8_WAIT_V(8); PG8_WAIT_L(0); PG8_BAR; PG8_MMA(1, 0, At, B0); PG8_MMA(1, 1, At, B1); PG8_BAR; PG8_SCHED;
        }
        if (wr == 0) PG8_BAR;
        if constexpr (FP8) asm volatile("s_nop 15\n\ts_nop 15" ::: "memory");
        if constexpr (FP8 && GATHER) SUBT0(10);
        E(acc, cur, wr, wc, fr, fq);
        if constexpr (FP8 && GATHER) SUBT1(10);
        if (!has_next) break;
#pragma unroll
        for (int a = 0; a < 2; ++a)
#pragma unroll
            for (int b = 0; b < 2; ++b)
#pragma unroll
                for (int m = 0; m < 4; ++m)
#pragma unroll
                    for (int n = 0; n < 2; ++n) acc[a][b][m][n] = (f32x4){0.f, 0.f, 0.f, 0.f};
        cur = nxt; cA = nA; cB = nB; ++ui;
        if constexpr (GATHER) {
#pragma unroll
            for (int _h = 0; _h < 2; ++_h)
#pragma unroll
                for (int _i = 0; _i < 2; ++_i) gc[_h][_i] = gn[_h][_i]; }
        if (wr == 1) PG8_BAR;
    }
    PG8_WAIT_V(0);
    PG8_BAR;
    if constexpr (FP8 && GATHER) SUBSPIN;
#undef PG8_SA
#undef PG8_SB
#undef PG8_STAGE
#undef PG8_STAGEA
#undef PG8_STAGEA2
#undef PG8_GLOAD
#undef PG8_LDA
#undef PG8_LDB
#undef PG8_MMA
#undef PG8_LD32
#undef PG8_WAIT_V
#undef PG8_WAIT_L
#undef PG8_BAR
#undef PG8_SCHED
}
}


#define XB_TMO      128
#define XB_XCNT(j)  (256  + 64 * (j))
#define XB_XSUB(j)  (1280 + 64 * (j))
#define XB_XGEN(j)  (2304 + 64 * (j))
#define XB_TOP      3328
#define XB_TOPGEN   3392
#define XCD_BAR_WORDS 3456
#define XB_SPIN_CAP (1u << 20)
__device__ __forceinline__ unsigned xb_ld(unsigned* p)              { return __hip_atomic_load(p, __ATOMIC_RELAXED, __HIP_MEMORY_SCOPE_AGENT); }
__device__ __forceinline__ unsigned xb_add(unsigned* p, unsigned v) { return __hip_atomic_fetch_add(p, v, __ATOMIC_RELAXED, __HIP_MEMORY_SCOPE_AGENT); }
__device__ __forceinline__ unsigned xb_xcc_id() { return (unsigned)__builtin_amdgcn_s_getreg((3 << 11) | 20) & 0xFu; }
#define XB_SPIN(cond, bar) do { unsigned _sp = 0; while (cond) { __builtin_amdgcn_s_sleep(1); \
    if ((++_sp & 255u) == 0u) { if (xb_ld(&(bar)[XB_TMO])) break; if (_sp > XB_SPIN_CAP) { atomicAdd(&(bar)[XB_TMO], 1u); break; } } } } while (0)
struct XcdBarrier { unsigned* bar; unsigned x; volatile LAS unsigned* st; };
__device__ __forceinline__ XcdBarrier xcd_barrier_post(unsigned* bar, volatile LAS unsigned* st) {
    XcdBarrier b; b.bar = bar; b.x = xb_xcc_id(); b.st = st;
    if (threadIdx.x == 0) (void)xb_add(&bar[XB_XCNT(b.x)], 1u);
    return b;
}
__device__ __forceinline__ void xcd_barrier_complete(unsigned* bar, unsigned x, unsigned& nloc, unsigned& nx) {
    const unsigned G = gridDim.x * gridDim.y * gridDim.z;
    unsigned sum, cnt, mine, sp = 0u;
    for (;;) {
        sum = 0u; cnt = 0u; mine = 0u;
#pragma unroll
        for (unsigned j = 0; j < 16; ++j) { const unsigned c = xb_ld(&bar[XB_XCNT(j)]); sum += c; cnt += (c > 0u) ? 1u : 0u; mine = (j == x) ? c : mine; }
        if (sum == G) break;
        __builtin_amdgcn_s_sleep(1);
        if ((++sp & 255u) == 0u) { if (xb_ld(&bar[XB_TMO])) break; if (sp > XB_SPIN_CAP) { atomicAdd(&bar[XB_TMO], 1u); break; } }
    }
    nloc = mine > 0u ? mine : 1u; nx = cnt > 0u ? cnt : 1u;
}
__device__ __forceinline__ void xcd_barrier(const XcdBarrier& b) {
    asm volatile("s_waitcnt vmcnt(0)" ::: "memory");
    __syncthreads();
    if (threadIdx.x == 0) {
        unsigned* bar = b.bar;
        __builtin_amdgcn_s_waitcnt(0);
        unsigned nloc = b.st[0], nx = b.st[1];
        if (nloc == 0u) { xcd_barrier_complete(bar, b.x, nloc, nx); b.st[0] = nloc; b.st[1] = nx; }
        const unsigned old = xb_add(&bar[XB_XSUB(b.x)], 1u);
        const unsigned gen = old / nloc;
        if (old + 1u == (gen + 1u) * nloc) {
            __builtin_amdgcn_fence(__ATOMIC_RELEASE, "agent");
            asm volatile("s_waitcnt vmcnt(0)" ::: "memory");
            const unsigned og = xb_add(&bar[XB_TOP], 1u);
            const unsigned tg = og / nx;
            if (og + 1u == (tg + 1u) * nx) xb_add(&bar[XB_TOPGEN], 1u);
            else XB_SPIN(xb_ld(&bar[XB_TOPGEN]) == tg, bar);
            __builtin_amdgcn_fence(__ATOMIC_ACQUIRE, "agent");
            xb_add(&bar[XB_XGEN(b.x)], 1u);
            asm volatile("s_waitcnt vmcnt(0)" ::: "memory");
        } else {
            XB_SPIN(xb_ld(&bar[XB_XGEN(b.x)]) == gen, bar);
            __builtin_amdgcn_fence(__ATOMIC_ACQUIRE, "agent");
            asm volatile("s_waitcnt vmcnt(0)" ::: "memory");
        }
    }
    __syncthreads();
}

struct Args {
    const float* in[25]; float* out; unsigned char* ws; int ph_lo, ph_hi;
};

struct Ctx { LAS unsigned char* lds; int tid, lane, wave, gw, NGW, G; };


__device__ __forceinline__ void tr_item(const float* W, int ldw, int scol0, int k0, bf16_t* WT, int ldt, int drow0, int dk0, LAS float* scr, int lane) {
#pragma unroll 8
    for (int i = 0; i < 32; ++i) { const int kk = 2 * i + (lane >> 5); scr[kk * 33 + (lane & 31)] = W[(size_t)(k0 + kk) * ldw + scol0 + (lane & 31)]; }
    asm volatile("s_waitcnt lgkmcnt(0)" ::: "memory");
    const int c = lane & 7;
#pragma unroll
    for (int j = 0; j < 4; ++j) { const int n = (lane >> 3) + 8 * j; const LAS float* s = scr + (8 * c) * 33 + n;
        u32x4 o; o.x = cvt_pk_bf16(s[0 * 33], s[1 * 33]); o.y = cvt_pk_bf16(s[2 * 33], s[3 * 33]); o.z = cvt_pk_bf16(s[4 * 33], s[5 * 33]); o.w = cvt_pk_bf16(s[6 * 33], s[7 * 33]);
        *(u32x4*)(WT + (size_t)(drow0 + n) * ldt + dk0 + k0 + 8 * c) = o; }
    asm volatile("s_waitcnt lgkmcnt(0)" ::: "memory");
}
__device__ __forceinline__ void tr_item8(const float* W, int ldw, int scol0, int k0, unsigned char* WT, int ldt, int drow0, LAS float* scr, int lane) {
#pragma unroll 8
    for (int i = 0; i < 32; ++i) { const int kk = 2 * i + (lane >> 5); scr[kk * 33 + (lane & 31)] = __builtin_nontemporal_load(&W[(size_t)(k0 + kk) * ldw + scol0 + (lane & 31)]) * W8_SCALE; }
    asm volatile("s_waitcnt lgkmcnt(0)" ::: "memory");
    const int c = lane & 3;
#pragma unroll
    for (int j = 0; j < 2; ++j) { const int n = (lane >> 2) + 16 * j; const LAS float* s = scr + (16 * c) * 33 + n;
        u32x4 o; o.x = pk4_fp8(s[0 * 33], s[1 * 33], s[2 * 33], s[3 * 33]); o.y = pk4_fp8(s[4 * 33], s[5 * 33], s[6 * 33], s[7 * 33]);
        o.z = pk4_fp8(s[8 * 33], s[9 * 33], s[10 * 33], s[11 * 33]); o.w = pk4_fp8(s[12 * 33], s[13 * 33], s[14 * 33], s[15 * 33]);
        *(u32x4*)(WT + (size_t)(drow0 + n) * ldt + k0 + 16 * c) = o; }
    asm volatile("s_waitcnt lgkmcnt(0)" ::: "memory");
}
__device__ __forceinline__ void tr_item_gate(const float* W, int scol0, int k0, bf16_t* WT, int ri, int wcn, int kb, LAS float* scr, int lane) {
#pragma unroll 8
    for (int i = 0; i < 32; ++i) { const int kk = 2 * i + (lane >> 5); scr[kk * 33 + (lane & 31)] = W[(size_t)(k0 + kk) * 128 + scol0 + (lane & 31)]; }
    asm volatile("s_waitcnt lgkmcnt(0)" ::: "memory");
    const int c = lane & 7;
#pragma unroll
    for (int j = 0; j < 4; ++j) { const int n = (lane >> 3) + 8 * j; const LAS float* s = scr + (8 * c) * 33 + n;
        u32x4 o; o.x = cvt_pk_bf16(s[0 * 33], s[1 * 33]); o.y = cvt_pk_bf16(s[2 * 33], s[3 * 33]); o.z = cvt_pk_bf16(s[4 * 33], s[5 * 33]); o.w = cvt_pk_bf16(s[6 * 33], s[7 * 33]);
        const int nbb = (n >> 4) & 1, fr = n & 15, ks = 2 * kb + (c >> 2), fq = c & 3;
        *(u32x4*)(WT + ((size_t)((((wcn * 2 + nbb) * 2 + ri) * 4 + ks) * 64 + fq * 16 + fr)) * 8) = o; }
    asm volatile("s_waitcnt lgkmcnt(0)" ::: "memory");
}
__device__ __forceinline__ int gu_src_col(int nrow, int H) { return ((nrow & 255) >> 7) * H + (nrow >> 8) * 128 + (nrow & 127); }

__device__ __forceinline__ void p0_convert(const Args& a, const Ctx& c) {
    unsigned char* ws = a.ws;
    LAS float* scr = (LAS float*)(c.lds + c.wave * 16384);
    constexpr int I_POOL = 4 * (256 / 64) * (256 / 32);
    constexpr int I_GU = (D / 64) * (2 * DFF / 32);
    constexpr int I_DN = (DFF / 64) * (D / 32);
    constexpr int I_IN = (D / 64) * (2 * DR / 32);
    constexpr int I_GT = 40 * 2 * 4;
    constexpr int I_OUT = (DR / 64) * (D / 32);
    constexpr int NITEMS = I_POOL + I_GU + I_DN + I_IN + I_GT + I_OUT;
    for (int it = c.gw; it < NITEMS; it += c.NGW) {
        int r = it;
        if (r < I_POOL) { continue; } r -= I_POOL;
        if (r < I_GU) { const int nblk = 2 * DFF / 32, kb = r / nblk, nb = r % nblk;
            tr_item8(a.in[10], 2 * DFF, gu_src_col(32 * nb, DFF), 64 * kb, ws + W_GUT, D, 32 * nb, scr, c.lane); continue; } r -= I_GU;
        if (r < I_DN) { const int nblk = D / 32, kb = r / nblk, nb = r % nblk;
            tr_item8(a.in[11], D, 32 * nb, 64 * kb, ws + W_DT, DFF, 32 * nb, scr, c.lane); continue; } r -= I_DN;
        if (r < I_IN) { const int nblk = 2 * DR / 32, kb = r / nblk, nb = r % nblk;
            tr_item(a.in[12], 2 * DR, 32 * nb, 64 * kb, (bf16_t*)(ws + W_INT), D, 32 * nb, 0, scr, c.lane); continue; } r -= I_IN;
        if (r < I_GT) { const int mat = r / 8, q = r % 8, kb = q / 4, nb = q % 4; const int which = mat / 20, dh = mat % 20, dir = dh / 10, head = dh % 10;
            const float* W = (which ? a.in[17] : a.in[15]) + (size_t)(dir * 10 + head) * 16384;
            tr_item_gate(W, 32 * nb, 64 * kb, (bf16_t*)(ws + W_GT) + (size_t)(head * 2 + dir) * 32768, which, nb, kb, scr, c.lane); continue; } r -= I_GT;
        if (r < I_OUT) { const int nblk = D / 32, kb = r / nblk, nb = r % nblk;
            tr_item(a.in[20], D, 32 * nb, 64 * kb, (bf16_t*)(ws + W_OUTT), DR, 32 * nb, 0, scr, c.lane); continue; } r -= I_OUT;
        { (void)r; }
    }
    for (int i = c.gw * 64 + c.lane; i < 8 * 8 * 8 * 64; i += c.NGW * 64) { const int ln = i & 63, nb = (i >> 6) & 7, ks = (i >> 9) & 7, w = i >> 12, ii = ln & 15, fqq = ln >> 4, g = w >> 1;
        const int col = 128 * w + 32 * (nb >> 1) + 8 * (ii >> 2) + 4 * (nb & 1) + (ii & 3), dd = col - 256 * g, k = 32 * ks + 8 * fqq;
        const float* src = a.in[8] + (size_t)g * 65536 + (size_t)k * 256 + dd;
        u32x4 o; o.x = cvt_pk_bf16(src[0], src[256]); o.y = cvt_pk_bf16(src[512], src[768]); o.z = cvt_pk_bf16(src[1024], src[1280]); o.w = cvt_pk_bf16(src[1536], src[1792]);
        *(u32x4*)((bf16_t*)(ws + W_POOLT) + (size_t)i * 8) = o; }
    for (int i = c.gw * 64 + c.lane; i < 2 * DR; i += c.NGW * 64) ((float*)(ws + WS_SP))[i] = -8.0f * log1pf(__expf(-a.in[19][i]));
}

__device__ __forceinline__ void moe_convert_queue(const Args& a, const Ctx& c, int max_grabs) {
    constexpr int I_MGU1 = (D / 64) * (2 * DE / 32);
    constexpr int I_MDN1 = (DE / 64) * (D / 32);
    constexpr int NQ = NE * I_MGU1 + NE * I_MDN1, GRAB = 64;
    unsigned char* ws = a.ws;
    LAS float* scr = (LAS float*)(c.lds + c.wave * 16384);
    LAS int* slot = (LAS int*)(c.lds + 131072);
    unsigned* ctr = (unsigned*)(ws + WS_CTL) + 20 * 64;
    for (int gi = 0; gi < max_grabs; ++gi) {
        __syncthreads();
        if (c.tid == 0) slot[0] = (int)atomicAdd(ctr, (unsigned)GRAB);
        __syncthreads();
        const int base = slot[0];
        if (base >= NQ) break;
#pragma unroll 1
        for (int k = 0; k < GRAB / NWAVES; ++k) { int r = base + k * NWAVES + c.wave; if (r >= NQ) break;
            if (r < NE * I_MGU1) { const int e = r / I_MGU1, q = r % I_MGU1, nblk = 2 * DE / 32, kb = q / nblk, nb = q % nblk;
                tr_item8(a.in[22] + (size_t)e * D * 2 * DE, 2 * DE, gu_src_col(32 * nb, DE), 64 * kb, ws + W_MGUT + (size_t)e * 2 * DE * D, D, 32 * nb, scr, c.lane); continue; } r -= NE * I_MGU1;
            { const int e = r / I_MDN1, q = r % I_MDN1, nblk = D / 32, kb = q / nblk, nb = q % nblk;
                tr_item8(a.in[23] + (size_t)e * DE * D, D, 32 * nb, 64 * kb, ws + W_MDT + (size_t)e * D * DE, DE, 32 * nb, scr, c.lane); } }
    }
}

__device__ __forceinline__ void p0_adaln(const Args& a, const Ctx& c) {
    if ((int)blockIdx.x >= 192) return;
    const int layer = blockIdx.x / 96, col0 = (blockIdx.x % 96) * 64;
    LAS float* s = (LAS float*)c.lds;
    LAS float* red = (LAS float*)(c.lds + 17 * 1024 * 4);
    for (int i = c.tid; i < 17 * 1024; i += NTHREADS) { const int b = i >> 10, k = i & 1023; const float v = b < NB ? a.in[1][b * D + k] : a.in[3][k]; s[i] = v / (1.0f + __expf(-v)); }
    __syncthreads();
    const int ks = c.lane >> 4, cq = c.lane & 15;
    const float* W = a.in[4] + (size_t)layer * D * 6 * D + col0 + 4 * cq;
    f32x4 acc[17];
#pragma unroll
    for (int b = 0; b < 17; ++b) acc[b] = (f32x4){0.f, 0.f, 0.f, 0.f};
    const int k0 = c.wave * 128 + ks;
#pragma unroll 8
    for (int kk = 0; kk < 32; ++kk) { const int k = k0 + 4 * kk; const f32x4 w = *(const f32x4*)(W + (size_t)k * 6 * D);
#pragma unroll
        for (int b = 0; b < 17; ++b) acc[b] += w * s[b * 1024 + k]; }
#pragma unroll
    for (int b = 0; b < 17; ++b) {
#pragma unroll
        for (int j = 0; j < 4; ++j) { float v = acc[b][j]; v += __shfl_xor(v, 16); v += __shfl_xor(v, 32); acc[b][j] = v; }
        if (ks == 0) *(LAS f32x4*)(red + (c.wave * 17 + b) * 64 + 4 * cq) = acc[b]; }
    __syncthreads();
    float* mod = (float*)(a.ws + WS_MOD) + (size_t)layer * 17 * 6144;
    for (int i = c.tid; i < 17 * 64; i += NTHREADS) { const int b = i >> 6, l = i & 63; float v = a.in[5][layer * 6 * D + col0 + l];
#pragma unroll
        for (int w = 0; w < 8; ++w) v += red[(w * 17 + b) * 64 + l];
        mod[b * 6144 + col0 + l] = v; }
    __syncthreads();
}

constexpr int PL_PITCH = 2064;
constexpr int PL_RS = 64 * PL_PITCH, PL_SS = PL_RS + 512;
template <int W>
__device__ __forceinline__ void pool_cols(int roff, int nrows, int t0, int L, int ntok, float g0, float g1, LAS unsigned char* lds, int col) {
    float r0[16], r1[16]; float S0 = 0.f, S1 = 0.f;
#pragma unroll
    for (int i = 0; i < 16; ++i) { r0[i] = 0.f; r1[i] = 0.f; }
    LAS unsigned char* pd = lds + col * 2 - (W / 2 - 1 + 8) * PL_PITCH;
#pragma unroll 1
    for (int so = 0; so < ntok + 16; so += 16) {
#pragma unroll
        for (int i = 0; i < 16; ++i) { const int s = so + i;
            const int r = s - roff; const bool ok = r >= 0 && r < nrows; const int rc = min(max(r, 0), nrows - 1);
            const unsigned hv = *(const LAS unsigned*)(lds + rc * PL_PITCH + col * 2);
            const float v0 = ok ? bf_lo(hv) : 0.f, v1 = ok ? bf_hi(hv) : 0.f;
            r0[i] = v0; r1[i] = v1; S0 += v0; S1 += v1;
            const int p = s - W / 2 + 1;
            if (p >= 8 && p < 8 + ntok) { const int tp = t0 - 8 + p; const int lo = max(tp - W / 2, 0), hi = min(tp - W / 2 + W, L); const float inv = __builtin_amdgcn_rcpf((float)(hi - lo));
                *(LAS unsigned*)pd = cvt_pk_bf16((S0 * inv - r0[(i - W / 2 + 1) & 15]) * g0, (S1 * inv - r1[(i - W / 2 + 1) & 15]) * g1); }
            pd += PL_PITCH;
            if (s - W + 1 >= 0) { S0 -= r0[(i - W + 1) & 15]; S1 -= r1[(i - W + 1) & 15]; } }
    }
}
__device__ __forceinline__ void pool_fused(const Args& a, const Ctx& c) {
    LAS unsigned char* lds = c.lds;
    LAS float* rs = (LAS float*)(lds + PL_RS); LAS float* rowss = (LAS float*)(lds + PL_SS);
    const float* g1n = a.in[6]; const float* g2n = a.in[7]; const float* pscale = a.in[9];
    const float* mod0 = (const float*)(a.ws + WS_MOD);
    const bf16_t* PW = (const bf16_t*)(a.ws + W_POOLT);
    unsigned char* H2 = a.ws + R_HB;
    const int tid = c.tid, lane = c.lane, w = c.wave, g = w >> 1;
    SUBDECL;
    for (int tile = blockIdx.x; tile < 512 + NZ / 16; tile += c.G) {
        int fr = lane & 15, fq = lane >> 4; asm volatile("" : "+v"(fr), "+v"(fq));
        const bool isx = tile < 512; const int L = isx ? 64 : 256, ntok = isx ? 64 : 16, nm = ntok >> 4;
        const int t0 = isx ? 0 : ((tile - 512) & 15) * 16;
        const float* seq = isx ? a.in[0] + (size_t)tile * 64 * D : a.in[2] + (size_t)((tile - 512) >> 4) * CL * D;
        float* outp = isx ? a.out + (size_t)tile * 64 * D : (float*)(a.ws + WS_ZRES) + ((size_t)((tile - 512) >> 4) * CL + t0) * D;
        const int b = isx ? (tile >> 5) : NB;
        const size_t orow0 = isx ? (size_t)tile * 64 : (size_t)NX + (size_t)((tile - 512) >> 4) * CL + t0;
        const float* mb = mod0 + (size_t)b * 6144;
        __syncthreads();
        SUBT0(1);
        const int roff = isx ? 8 : 0, nrows = isx ? 64 : 32;
        for (int rb = w; rb < nrows; rb += 4 * NWAVES) {
            f32x4 v[4][4];
#pragma unroll
            for (int q = 0; q < 4; ++q) { const int r = rb + q * NWAVES, t = t0 - 8 + r + roff; const bool ok = r < nrows && t >= 0 && t < L;
                const f32x4* xr = (const f32x4*)(seq + (size_t)min(max(t, 0), L - 1) * D) + lane;
#pragma unroll
                for (int j = 0; j < 4; ++j) { const f32x4 ld = xr[64 * j]; v[q][j] = ok ? ld : (f32x4){0.f, 0.f, 0.f, 0.f}; } }
#pragma unroll
            for (int q = 0; q < 4; ++q) { const int r = rb + q * NWAVES; float ss = 0.f;
#pragma unroll
                for (int j = 0; j < 4; ++j) ss += (v[q][j].x * v[q][j].x + v[q][j].y * v[q][j].y) + (v[q][j].z * v[q][j].z + v[q][j].w * v[q][j].w);
                const float rstd = rsqrtf(wave_sum(ss) * (1.0f / D) + EPS);
                if (r < nrows) {
#pragma unroll
                    for (int j = 0; j < 4; ++j) { const f32x4 h = v[q][j] * rstd; u32x2 o; o.x = cvt_pk_bf16(h.x, h.y); o.y = cvt_pk_bf16(h.z, h.w);
                        *(LAS u32x2*)(lds + r * PL_PITCH + 8 * (lane + 64 * j)) = o; } } } }
        __syncthreads();
        { const int col = 2 * tid;
          const f32x2 gg = *(const f32x2*)(g1n + col), sc = *(const f32x2*)(mb + 1024 + col);
          const float ga = gg.x * (1.0f + sc.x), gb = gg.y * (1.0f + sc.y);
          const int grp = __builtin_amdgcn_readfirstlane(col >> 8);
          if (grp == 0) pool_cols<2>(roff, nrows, t0, L, ntok, ga, gb, lds, col);
          else if (grp == 1) pool_cols<4>(roff, nrows, t0, L, ntok, ga, gb, lds, col);
          else if (grp == 2) pool_cols<8>(roff, nrows, t0, L, ntok, ga, gb, lds, col);
          else pool_cols<16>(roff, nrows, t0, L, ntok, ga, gb, lds, col); }
        __syncthreads();
        SUBT1(2); SUBT0(3);
        float ssq[4] = {0.f, 0.f, 0.f, 0.f};
#pragma unroll 1
        for (int half = 0; half < 2; ++half) {
            f32x4 acc[4][4];
#pragma unroll
            for (int m = 0; m < 4; ++m)
#pragma unroll
                for (int nb = 0; nb < 4; ++nb) acc[m][nb] = (f32x4){0.f, 0.f, 0.f, 0.f};
            { const bf16_t* pw = PW + (size_t)w * 8 * 8 * 512 + (size_t)half * 4 * 512 + lane * 8;
              bf16x8 bA[4], bB[4];
#pragma unroll
              for (int nb = 0; nb < 4; ++nb) bA[nb] = *(const bf16x8*)(pw + nb * 512);
#pragma unroll 1
              for (int ks = 0; ks < 8; ks += 2) {
#pragma unroll
                  for (int nb = 0; nb < 4; ++nb) bB[nb] = *(const bf16x8*)(pw + ((ks + 1) * 8 + nb) * 512);
                  { const int sw = (32 * g + 4 * ks + fq) << 4; bf16x8 af[4];
#pragma unroll
                    for (int m = 0; m < 4; ++m) if (m < nm) af[m] = *(const LAS bf16x8*)(lds + (16 * m + fr) * PL_PITCH + sw);
#pragma unroll
                    for (int m = 0; m < 4; ++m) if (m < nm)
#pragma unroll
                        for (int nb = 0; nb < 4; ++nb) acc[m][nb] = __builtin_amdgcn_mfma_f32_16x16x32_bf16(bA[nb], af[m], acc[m][nb], 0, 0, 0); }
                  if (ks + 2 < 8) {
#pragma unroll
                      for (int nb = 0; nb < 4; ++nb) bA[nb] = *(const bf16x8*)(pw + ((ks + 2) * 8 + nb) * 512); }
                  { const int sw = (32 * g + 4 * (ks + 1) + fq) << 4; bf16x8 af[4];
#pragma unroll
                    for (int m = 0; m < 4; ++m) if (m < nm) af[m] = *(const LAS bf16x8*)(lds + (16 * m + fr) * PL_PITCH + sw);
#pragma unroll
                    for (int m = 0; m < 4; ++m) if (m < nm)
#pragma unroll
                        for (int nb = 0; nb < 4; ++nb) acc[m][nb] = __builtin_amdgcn_mfma_f32_16x16x32_bf16(bB[nb], af[m], acc[m][nb], 0, 0, 0); } } }
#pragma unroll
            for (int pp = 0; pp < 2; ++pp) { const int col0 = 128 * w + 32 * (2 * half + pp) + 8 * fq;
                const f32x4 ga0 = *(const f32x4*)(mb + 2048 + col0) * *(const f32x4*)(pscale + col0), ga1 = *(const f32x4*)(mb + 2048 + col0 + 4) * *(const f32x4*)(pscale + col0 + 4);
#pragma unroll
                for (int m = 0; m < 4; ++m) if (m < nm) { const int tok = 16 * m + fr;
                    const f32x4 x0 = *(const f32x4*)(seq + (size_t)(t0 + tok) * D + col0), x1 = *(const f32x4*)(seq + (size_t)(t0 + tok) * D + col0 + 4);
                    const f32x4 o0 = x0 + ga0 * acc[m][2 * pp], o1 = x1 + ga1 * acc[m][2 * pp + 1];
                    *(f32x4*)(outp + (size_t)tok * D + col0) = o0; *(f32x4*)(outp + (size_t)tok * D + col0 + 4) = o1;
                    ssq[m] += (o0.x * o0.x + o0.y * o0.y) + (o0.z * o0.z + o0.w * o0.w) + (o1.x * o1.x + o1.y * o1.y) + (o1.z * o1.z + o1.w * o1.w); } }
        }
#pragma unroll
        for (int m = 0; m < 4; ++m) if (m < nm) { float v = ssq[m]; v += __shfl_xor(v, 16); v += __shfl_xor(v, 32); if (fq == 0) rowss[w * 64 + 16 * m + fr] = v; }
        __syncthreads();
        SUBT1(3); SUBT0(4);
        float rstd2[4];
#pragma unroll
        for (int m = 0; m < 4; ++m) { float t = 1.f;
            if (m < nm) { t = 0.f;
#pragma unroll
            for (int ww = 0; ww < 8; ++ww) t += rowss[ww * 64 + 16 * m + fr]; }
            rstd2[m] = rsqrtf(t * (1.0f / D) + EPS); }
#pragma unroll 2
        for (int p = 0; p < 4; ++p) { const int col0 = 128 * w + 32 * p + 8 * fq;
            const f32x4 gm0 = *(const f32x4*)(g2n + col0) * (*(const f32x4*)(mb + 4096 + col0) + 1.0f), gm1 = *(const f32x4*)(g2n + col0 + 4) * (*(const f32x4*)(mb + 4096 + col0 + 4) + 1.0f);
            const f32x4 sh0 = *(const f32x4*)(mb + 3072 + col0), sh1 = *(const f32x4*)(mb + 3072 + col0 + 4);
#pragma unroll
            for (int m = 0; m < 4; ++m) if (m < nm) { const int tok = 16 * m + fr;
                const f32x4 v0 = *(const f32x4*)(outp + (size_t)tok * D + col0), v1 = *(const f32x4*)(outp + (size_t)tok * D + col0 + 4);
                const f32x4 h0 = v0 * rstd2[m] * gm0 + sh0, h1 = v1 * rstd2[m] * gm1 + sh1;
                u32x2 o; o.x = pk4_fp8(h0.x, h0.y, h0.z, h0.w); o.y = pk4_fp8(h1.x, h1.y, h1.z, h1.w);
                *(u32x2*)(H2 + (orow0 + tok) * D + col0) = o; } }
        SUBT1(4);
    }
    SUBSPIN;
}

__device__ __forceinline__ void norm_mod_rows(const float* X, const float* Z, int nrows, const float* gvec, const float* modl, int sh_off, int sc_off, bf16_t* out, const Ctx& c) {
    const int RPW = ((nrows + c.NGW - 1) / c.NGW + 1) & ~1, rbeg = c.gw * RPW, rend = min(nrows, rbeg + RPW);
    f32x4 gm[4], shv[4]; int bcur = -1;
    for (int row0 = rbeg; row0 < rend; row0 += 2) {
        f32x4 v[2][4]; float ss[2];
#pragma unroll
        for (int r = 0; r < 2; ++r) { const int row = row0 + r; const float* src = row < NX ? X + (size_t)row * D : Z + (size_t)(row - NX) * D;
            const f32x4* xr = (const f32x4*)src + c.lane; ss[r] = 0.f;
#pragma unroll
            for (int j = 0; j < 4; ++j) v[r][j] = xr[64 * j]; }
        const int b = row0 < NX ? row0 / SEQ : NB;
        if (b != bcur) { bcur = b; const float* mb = modl + (size_t)b * 6144;
#pragma unroll
            for (int j = 0; j < 4; ++j) { const int col = 4 * (c.lane + 64 * j); gm[j] = *(const f32x4*)(gvec + col) * (*(const f32x4*)(mb + sc_off + col) + 1.0f); shv[j] = *(const f32x4*)(mb + sh_off + col); } }
#pragma unroll
        for (int r = 0; r < 2; ++r)
#pragma unroll
            for (int j = 0; j < 4; ++j) ss[r] += (v[r][j].x * v[r][j].x + v[r][j].y * v[r][j].y) + (v[r][j].z * v[r][j].z + v[r][j].w * v[r][j].w);
#pragma unroll
        for (int r = 0; r < 2; ++r) { const int row = row0 + r;
            const float rstd = rsqrtf(wave_sum(ss[r]) * (1.0f / D) + EPS);
#pragma unroll
            for (int j = 0; j < 4; ++j) { const int col = 4 * (c.lane + 64 * j);
                const f32x4 h = v[r][j] * rstd * gm[j] + shv[j];
                u32x2 w; w.x = cvt_pk_bf16(h.x, h.y); w.y = cvt_pk_bf16(h.z, h.w);
                *(u32x2*)(out + (size_t)row * D + col) = w; } }
    }
}

constexpr int LRU_NCK = 288;
constexpr int L_A = 0, L_LAB = 32768, L_B = 32768, L_HF = 100352, L_SEG = 133120, L_CARRY = 141312;
constexpr int LAB_PITCH = 528;
template <int MODE>
__device__ __forceinline__ void lru_pass(const Args& a, const Ctx& c) {
    const bf16_t* GU2 = (const bf16_t*)(a.ws + R_GU2); const bf16_t* GT3 = (const bf16_t*)(a.ws + W_GT);
    float* CAg = (float*)(a.ws + WS_CHUNK); float* CBg = CAg + (size_t)2 * LRU_NCK * DR;
    const float* SP = (const float*)(a.ws + WS_SP);
    bf16_t* Yg = (bf16_t*)(a.ws + R_Y);
    const float* cw = a.in[13]; const float* cb = a.in[14];
    LAS unsigned char* lds = c.lds;
    const int tid = c.tid, lane = c.lane, wid = c.wave, wr = wid >> 2, wc = wid & 3, fr = lane & 15, fq = lane >> 4;
    const int nunits = (MODE == 1 ? LRU_NCK : 256) * 10;
    const int tq = tid >> 4, c8 = tid & 15;
    SUBDECL;
    u32x4 uw[7]; bf16x8 bq[2][2][4];
#define LRU_LOAD_U(L_) do { const int head_ = (L_) % 10, ck_ = (L_) / 10; const bool isx_ = ck_ < 256; const int jj_ = isx_ ? (ck_ & 15) : ((ck_ - 256) & 1); \
        const int Ls_ = isx_ ? SEQ : CL; const size_t r0_ = isx_ ? (size_t)ck_ * 128 : (size_t)NX + (size_t)(ck_ - 256) * 128; \
        _Pragma("unroll") for (int i = 0; i < 7; ++i) { const int t = jj_ * 128 + 4 * tq + i - 2; const bool ok_ = t >= 0 && t < Ls_; const int tc_ = min(max(t, 0), Ls_ - 1); \
            const u32x4 ld_ = *(const u32x4*)(GU2 + (r0_ - jj_ * 128 + tc_) * (size_t)(2 * DR) + DR + head_ * 128 + 8 * c8);     \
            uw[i].x = ok_ ? ld_.x : 0u; uw[i].y = ok_ ? ld_.y : 0u; uw[i].z = ok_ ? ld_.z : 0u; uw[i].w = ok_ ? ld_.w : 0u; } } while (0)
#define LRU_LOAD_B(L_, dir_) do { const bf16_t* src_ = GT3 + ((size_t)(((L_) % 10) * 2 + (dir_)) * 4 + wc) * 8192 + lane * 8; \
        _Pragma("unroll") for (int nb = 0; nb < 2; ++nb) _Pragma("unroll") for (int ri = 0; ri < 2; ++ri) _Pragma("unroll") for (int ks = 0; ks < 4; ++ks) \
            bq[nb][ri][ks] = *(const bf16x8*)(src_ + ((nb * 2 + ri) * 4 + ks) * 512); } while (0)
    if ((int)blockIdx.x < nunits) { LRU_LOAD_U((int)blockIdx.x); }
    for (int L = blockIdx.x; L < nunits; L += c.G) {
        const int head = L % 10, ck = L / 10;
        const bool isx = ck < 256; const int bb_ = isx ? (ck >> 4) : ((ck - 256) >> 1), jj = isx ? (ck & 15) : ((ck - 256) & 1);
        const size_t r0 = isx ? (size_t)ck * 128 : (size_t)NX + (size_t)(ck - 256) * 128;
        const bool has_next = L + c.G < nunits;
        __syncthreads();
        LRU_LOAD_B(L, 0);
        SUBT0(21);
        { const int ch = head * 128 + 8 * c8;
          float wv[4][8], bv[8];
#pragma unroll
          for (int k = 0; k < 4; ++k) { const f32x4 w0 = *(const f32x4*)(cw + k * DR + ch), w1 = *(const f32x4*)(cw + k * DR + ch + 4);
              wv[k][0] = w0.x; wv[k][1] = w0.y; wv[k][2] = w0.z; wv[k][3] = w0.w; wv[k][4] = w1.x; wv[k][5] = w1.y; wv[k][6] = w1.z; wv[k][7] = w1.w; }
          { const f32x4 b0 = *(const f32x4*)(cb + ch), b1 = *(const f32x4*)(cb + ch + 4); bv[0] = b0.x; bv[1] = b0.y; bv[2] = b0.z; bv[3] = b0.w; bv[4] = b1.x; bv[5] = b1.y; bv[6] = b1.z; bv[7] = b1.w; }
#pragma unroll
          for (int o = 0; o < 4; ++o) { float acc[8];
#pragma unroll
              for (int j = 0; j < 8; ++j) acc[j] = bv[j];
#pragma unroll
              for (int k = 0; k < 4; ++k) { const u32x4 u = uw[o + k];
                  acc[0] += wv[k][0] * bf_lo(u.x); acc[1] += wv[k][1] * bf_hi(u.x); acc[2] += wv[k][2] * bf_lo(u.y); acc[3] += wv[k][3] * bf_hi(u.y);
                  acc[4] += wv[k][4] * bf_lo(u.z); acc[5] += wv[k][5] * bf_hi(u.z); acc[6] += wv[k][6] * bf_lo(u.w); acc[7] += wv[k][7] * bf_hi(u.w); }
              u32x4 w; w.x = cvt_pk_bf16(acc[0], acc[1]); w.y = cvt_pk_bf16(acc[2], acc[3]); w.z = cvt_pk_bf16(acc[4], acc[5]); w.w = cvt_pk_bf16(acc[6], acc[7]);
              const int tok = 4 * tq + o;
              *(LAS u32x4*)(lds + L_A + tok * 256 + ((c8 ^ (tok & 15)) << 4)) = w; } }
        if (MODE == 2 && tid < 128) { const int dir = tid >> 6, cp = tid & 63; const int n = dir == 0 ? 2 + jj : 2 + (15 - jj);
            const size_t cbase = (size_t)dir * LRU_NCK * DR + head * 128 + 2 * cp;
            f32x2 Av[17], Bv[17];
#pragma unroll
            for (int q = 0; q < 17; ++q) { int idx; if (dir == 0) idx = q < 2 ? 256 + 2 * bb_ + q : 16 * bb_ + q - 2; else idx = q < 2 ? 256 + 2 * bb_ + 1 - q : 16 * bb_ + 15 - (q - 2);
                if (q < n) { Av[q] = *(const f32x2*)(CAg + cbase + (size_t)idx * DR); Bv[q] = *(const f32x2*)(CBg + cbase + (size_t)idx * DR); } else { Av[q] = (f32x2){1.f, 1.f}; Bv[q] = (f32x2){0.f, 0.f}; } }
            f32x2 cc = (f32x2){0.f, 0.f};
#pragma unroll
            for (int q = 0; q < 17; ++q) cc = Av[q] * cc + Bv[q];
            *(LAS f32x2*)(lds + L_CARRY + (dir * 128 + 2 * cp) * 4) = cc; }
        __syncthreads();
        SUBT1(21);
        u32x4 gw[4];
#pragma unroll
        for (int dir = 0; dir < 2; ++dir) {
            f32x4 brv[2], biv[2], spv[2];
#pragma unroll
            for (int nb = 0; nb < 2; ++nb) { const int ch = dir * DR + head * 128 + 32 * wc + 16 * nb + 4 * fq;
                brv[nb] = *(const f32x4*)(a.in[16] + ch); biv[nb] = *(const f32x4*)(a.in[18] + ch); spv[nb] = *(const f32x4*)(SP + ch); }
            SUBT0(22);
            f32x4 acc[4][2][2];
#pragma unroll
            for (int m = 0; m < 4; ++m)
#pragma unroll
                for (int nb = 0; nb < 2; ++nb)
#pragma unroll
                    for (int ri = 0; ri < 2; ++ri) acc[m][nb][ri] = (f32x4){0.f, 0.f, 0.f, 0.f};
#pragma unroll
            for (int ks = 0; ks < 4; ++ks) { const int sw = ((ks * 4 + fq) ^ fr) << 4;
                bf16x8 af[4];
#pragma unroll
                for (int m = 0; m < 4; ++m) af[m] = *(const LAS bf16x8*)(lds + L_A + (64 * wr + 16 * m + fr) * 256 + sw);
#pragma unroll
                for (int m = 0; m < 4; ++m)
#pragma unroll
                    for (int nb = 0; nb < 2; ++nb)
#pragma unroll
                        for (int ri = 0; ri < 2; ++ri) acc[m][nb][ri] = __builtin_amdgcn_mfma_f32_16x16x32_bf16(bq[nb][ri][ks], af[m], acc[m][nb][ri], 0, 0, 0); }
            SUBT1(22); SUBT0(23);
            if (dir == 0) { LRU_LOAD_B(L, 1); }
            else { if (has_next) { LRU_LOAD_U(L + c.G); }
                if (MODE == 2) {
#pragma unroll
                    for (int i = 0; i < 4; ++i) { const int p = tid + 512 * i, tok = p >> 4, c16 = p & 15; gw[i] = *(const u32x4*)(GU2 + (r0 + tok) * (size_t)(2 * DR) + head * 128 + c16 * 8); } } }
#pragma unroll
            for (int nb = 0; nb < 2; ++nb) { const int chl = 32 * wc + 16 * nb + 4 * fq;
#pragma unroll
                for (int m = 0; m < 4; ++m) { const int tok = 64 * wr + 16 * m + fr;
                    const u32x2 uq = *(const LAS u32x2*)(lds + L_A + tok * 256 + (((chl >> 3) ^ (tok & 15)) << 4) + (chl & 7) * 2);
                    const float uv[4] = {bf_lo(uq.x), bf_hi(uq.x), bf_lo(uq.y), bf_hi(uq.y)};
                    u32x4 w;
#pragma unroll
                    for (int j = 0; j < 4; ++j) {
                        const float er = 1.0f + fast_exp(-(acc[m][nb][0][j] + brv[nb][j])), ei = 1.0f + fast_exp(-(acc[m][nb][1][j] + biv[nb][j]));
                        const float R = __builtin_amdgcn_rcpf(er * ei), r = ei * R, ig = er * R;
                        const float l = r * spv[nb][j], y = 2.0f * l;
                        float em = -y * (1.0f + y * (0.5f + y * (1.0f / 6.0f + y * (1.0f / 24.0f))));
                        if (__builtin_expect(y <= -0.3f, 0)) em = 1.0f - fast_exp(y);
                        w[j] = cvt_pk_bf16(l, __builtin_amdgcn_sqrtf(em) * ig * uv[j]); }
                    *(LAS u32x4*)(lds + L_LAB + tok * LAB_PITCH + chl * 4) = w; } }
            __syncthreads();
            SUBT1(23); SUBT0(24);
            if (MODE == 1 && isx) {
                unsigned char* dstg = a.ws + R_LABG + ((size_t)(ck * 10 + head) * 2 + dir) * 65536;
#pragma unroll
                for (int i = 0; i < 8; ++i) { const int p = tid + 512 * i; *(u32x4*)(dstg + (size_t)p * 16) = *(const LAS u32x4*)(lds + L_LAB + (p >> 5) * LAB_PITCH + (p & 31) * 16); } }
            { const int sg = wid, cp = lane;
              float s0 = 0.f, s1 = 0.f, h0 = 0.f, h1 = 0.f;
#pragma unroll
              for (int i = 0; i < 16; ++i) { const int t = 16 * sg + (dir ? 15 - i : i);
                  const u32x2 e = *(const LAS u32x2*)(lds + L_LAB + t * LAB_PITCH + cp * 8);
                  const float l0 = bf_lo(e.x), l1 = bf_lo(e.y); s0 += l0; s1 += l1;
                  h0 = fast_exp(l0) * h0 + bf_hi(e.x); h1 = fast_exp(l1) * h1 + bf_hi(e.y); }
              *(LAS f32x4*)(lds + L_SEG + (sg * 64 + cp) * 16) = (f32x4){fast_exp(s0), fast_exp(s1), h0, h1};
              if (MODE == 2 && dir == 1) {
#pragma unroll
                  for (int i = 0; i < 4; ++i) { const int p = tid + 512 * i; *(LAS u32x4*)(lds + L_A + p * 16) = gw[i]; } }
              __syncthreads();
              if (MODE == 1) {
                  if (sg == 0) { float c0 = 0.f, c1 = 0.f, A0 = 1.f, A1 = 1.f;
#pragma unroll
                      for (int q = 0; q < 8; ++q) { const int s_ = dir ? 7 - q : q; const f32x4 sv = *(const LAS f32x4*)(lds + L_SEG + (s_ * 64 + cp) * 16);
                          c0 = sv.x * c0 + sv.z; c1 = sv.y * c1 + sv.w; A0 *= sv.x; A1 *= sv.y; }
                      const size_t o = ((size_t)dir * LRU_NCK + ck) * DR + head * 128 + 2 * cp;
                      *(f32x2*)(CAg + o) = (f32x2){A0, A1}; *(f32x2*)(CBg + o) = (f32x2){c0, c1}; }
              } else {
                  const f32x2 cin = *(const LAS f32x2*)(lds + L_CARRY + (dir * 128 + 2 * cp) * 4);
                  float c0 = cin.x, c1 = cin.y;
#pragma unroll
                  for (int q = 0; q < 7; ++q) { const int s_ = dir ? 7 - q : q; const bool use = dir ? (s_ > sg) : (s_ < sg);
                      if (use) { const f32x4 sv = *(const LAS f32x4*)(lds + L_SEG + (s_ * 64 + cp) * 16); c0 = sv.x * c0 + sv.z; c1 = sv.y * c1 + sv.w; } }
                  h0 = c0; h1 = c1;
                  if (dir == 0) {
#pragma unroll
                      for (int i = 0; i < 16; ++i) { const int t = 16 * sg + i;
                          const u32x2 e = *(const LAS u32x2*)(lds + L_LAB + t * LAB_PITCH + cp * 8);
                          h0 = fast_exp(bf_lo(e.x)) * h0 + bf_hi(e.x); h1 = fast_exp(bf_lo(e.y)) * h1 + bf_hi(e.y);
                          *(LAS unsigned*)(lds + L_HF + t * 256 + cp * 4) = cvt_pk_bf16(h0, h1); }
                  } else {
#pragma unroll
                      for (int i = 0; i < 16; ++i) { const int t = 16 * sg + 15 - i;
                          const u32x2 e = *(const LAS u32x2*)(lds + L_LAB + t * LAB_PITCH + cp * 8);
                          h0 = fast_exp(bf_lo(e.x)) * h0 + bf_hi(e.x); h1 = fast_exp(bf_lo(e.y)) * h1 + bf_hi(e.y);
                          const unsigned fw = *(const LAS unsigned*)(lds + L_HF + t * 256 + cp * 4), gt = *(const LAS unsigned*)(lds + L_A + t * 256 + cp * 4);
                          *(LAS unsigned*)(lds + L_HF + t * 256 + cp * 4) = cvt_pk_bf16((h0 + bf_lo(fw)) * gelu_tanh(bf_lo(gt)), (h1 + bf_hi(fw)) * gelu_tanh(bf_hi(gt))); }
                      __syncthreads();
#pragma unroll
                      for (int i = 0; i < 4; ++i) { const int p = tid + 512 * i, tok = p >> 4, c16 = p & 15;
                          *(u32x4*)(Yg + (r0 + tok) * (size_t)DR + head * 128 + c16 * 8) = *(const LAS u32x4*)(lds + L_HF + p * 16); }
                  }
              }
            }
            SUBT1(24);
            if (dir == 0) __syncthreads();
        }
    }
    SUBSPIN;
#undef LRU_LOAD_U
#undef LRU_LOAD_B
}

__device__ __forceinline__ void lru_scan2(const Args& a, const Ctx& c) {
    const bf16_t* GU2 = (const bf16_t*)(a.ws + R_GU2);
    const float* CAg = (const float*)(a.ws + WS_CHUNK); const float* CBg = CAg + (size_t)2 * LRU_NCK * DR;
    bf16_t* Yg = (bf16_t*)(a.ws + R_Y);
    LAS unsigned char* lds = c.lds;
    const int tid = c.tid, lane = c.lane, wid = c.wave;
    const int nunits = 256 * 10;
    u32x4 lab[8], gw[4];
#define LRU_LOAD_LAB(L_, dir_) do { const unsigned char* src_ = a.ws + R_LABG + ((size_t)(L_) * 2 + (dir_)) * 65536; \
        _Pragma("unroll") for (int i = 0; i < 8; ++i) lab[i] = __builtin_nontemporal_load((const u32x4*)(src_ + (size_t)(tid + 512 * i) * 16)); } while (0)
    if ((int)blockIdx.x < nunits) { LRU_LOAD_LAB((int)blockIdx.x, 0); }
    for (int L = blockIdx.x; L < nunits; L += c.G) {
        const int head = L % 10, ck = L / 10, bb_ = ck >> 4, jj = ck & 15;
        const size_t r0 = (size_t)ck * 128;
        const bool has_next = L + c.G < nunits;
        __syncthreads();
        if (tid < 128) { const int dir = tid >> 6, cp = tid & 63; const int n = dir == 0 ? 2 + jj : 2 + (15 - jj);
            const size_t cbase = (size_t)dir * LRU_NCK * DR + head * 128 + 2 * cp;
            f32x2 Av[17], Bv[17];
#pragma unroll
            for (int q = 0; q < 17; ++q) { int idx; if (dir == 0) idx = q < 2 ? 256 + 2 * bb_ + q : 16 * bb_ + q - 2; else idx = q < 2 ? 256 + 2 * bb_ + 1 - q : 16 * bb_ + 15 - (q - 2);
                if (q < n) { Av[q] = *(const f32x2*)(CAg + cbase + (size_t)idx * DR); Bv[q] = *(const f32x2*)(CBg + cbase + (size_t)idx * DR); } else { Av[q] = (f32x2){1.f, 1.f}; Bv[q] = (f32x2){0.f, 0.f}; } }
            f32x2 cc = (f32x2){0.f, 0.f};
#pragma unroll
            for (int q = 0; q < 17; ++q) cc = Av[q] * cc + Bv[q];
            *(LAS f32x2*)(lds + L_CARRY + (dir * 128 + 2 * cp) * 4) = cc; }
#pragma unroll
        for (int dir = 0; dir < 2; ++dir) {
#pragma unroll
            for (int i = 0; i < 8; ++i) { const int p = tid + 512 * i; *(LAS u32x4*)(lds + L_LAB + (p >> 5) * LAB_PITCH + (p & 31) * 16) = lab[i]; }
            if (dir == 0) { LRU_LOAD_LAB(L, 1); }
            else { if (has_next) { LRU_LOAD_LAB(L + c.G, 0); }
#pragma unroll
                for (int i = 0; i < 4; ++i) { const int p = tid + 512 * i, tok = p >> 4, c16 = p & 15; gw[i] = *(const u32x4*)(GU2 + (r0 + tok) * (size_t)(2 * DR) + head * 128 + c16 * 8); } }
            __syncthreads();
            const int sg = wid, cp = lane;
            float s0 = 0.f, s1 = 0.f, h0 = 0.f, h1 = 0.f;
#pragma unroll
            for (int i = 0; i < 16; ++i) { const int t = 16 * sg + (dir ? 15 - i : i);
                const u32x2 e = *(const LAS u32x2*)(lds + L_LAB + t * LAB_PITCH + cp * 8);
                const float l0 = bf_lo(e.x), l1 = bf_lo(e.y); s0 += l0; s1 += l1;
                h0 = fast_exp(l0) * h0 + bf_hi(e.x); h1 = fast_exp(l1) * h1 + bf_hi(e.y); }
            *(LAS f32x4*)(lds + L_SEG + (sg * 64 + cp) * 16) = (f32x4){fast_exp(s0), fast_exp(s1), h0, h1};
            if (dir == 1) {
#pragma unroll
                for (int i = 0; i < 4; ++i) { const int p = tid + 512 * i; *(LAS u32x4*)(lds + L_A + p * 16) = gw[i]; } }
            __syncthreads();
            const f32x2 cin = *(const LAS f32x2*)(lds + L_CARRY + (dir * 128 + 2 * cp) * 4);
            float c0 = cin.x, c1 = cin.y;
#pragma unroll
            for (int q = 0; q < 7; ++q) { const int s_ = dir ? 7 - q : q; const bool use = dir ? (s_ > sg) : (s_ < sg);
                if (use) { const f32x4 sv = *(const LAS f32x4*)(lds + L_SEG + (s_ * 64 + cp) * 16); c0 = sv.x * c0 + sv.z; c1 = sv.y * c1 + sv.w; } }
            h0 = c0; h1 = c1;
            if (dir == 0) {
#pragma unroll
                for (int i = 0; i < 16; ++i) { const int t = 16 * sg + i;
                    const u32x2 e = *(const LAS u32x2*)(lds + L_LAB + t * LAB_PITCH + cp * 8);
                    h0 = fast_exp(bf_lo(e.x)) * h0 + bf_hi(e.x); h1 = fast_exp(bf_lo(e.y)) * h1 + bf_hi(e.y);
                    *(LAS unsigned*)(lds + L_HF + t * 256 + cp * 4) = cvt_pk_bf16(h0, h1); }
                __syncthreads();
            } else {
#pragma unroll
                for (int i = 0; i < 16; ++i) { const int t = 16 * sg + 15 - i;
                    const u32x2 e = *(const LAS u32x2*)(lds + L_LAB + t * LAB_PITCH + cp * 8);
                    h0 = fast_exp(bf_lo(e.x)) * h0 + bf_hi(e.x); h1 = fast_exp(bf_lo(e.y)) * h1 + bf_hi(e.y);
                    const unsigned fw = *(const LAS unsigned*)(lds + L_HF + t * 256 + cp * 4), gt = *(const LAS unsigned*)(lds + L_A + t * 256 + cp * 4);
                    *(LAS unsigned*)(lds + L_HF + t * 256 + cp * 4) = cvt_pk_bf16((h0 + bf_lo(fw)) * gelu_tanh(bf_lo(gt)), (h1 + bf_hi(fw)) * gelu_tanh(bf_hi(gt))); }
                __syncthreads();
#pragma unroll
                for (int i = 0; i < 4; ++i) { const int p = tid + 512 * i, tok = p >> 4, c16 = p & 15;
                    *(u32x4*)(Yg + (r0 + tok) * (size_t)DR + head * 128 + c16 * 8) = *(const LAS u32x4*)(lds + L_HF + p * 16); }
            }
        }
    }
#undef LRU_LOAD_LAB
}

__device__ __forceinline__ void p12_route(const Args& a, const Ctx& c) {
    LAS unsigned* lcnt = (LAS unsigned*)c.lds;
    if (c.tid < NE) lcnt[c.tid] = 0u;
    __syncthreads();
    const float* X = a.out; const float* gvec = a.in[7] + D; const float* modl = (const float*)(a.ws + WS_MOD) + (size_t)17 * 6144; const float* WR = a.in[21];
    unsigned char* H4 = a.ws + R_H4;
    int* tok_e = (int*)(a.ws + WS_ROUTE); float* tok_w = (float*)(a.ws + WS_ROUTE + (size_t)NX * 8);
    { int* slot_tok = (int*)(a.ws + WS_SLOTTOK); for (int i = blockIdx.x * NTHREADS + c.tid; i < NSLOT; i += c.G * NTHREADS) slot_tok[i] = 0; }
    f32x4 wa[4][4], wb[4][4];
#pragma unroll
    for (int j = 0; j < 4; ++j)
#pragma unroll
        for (int q = 0; q < 4; ++q) { const int col = 4 * (c.lane + 64 * j) + q; wa[j][q] = *(const f32x4*)(WR + (size_t)col * 8); wb[j][q] = *(const f32x4*)(WR + (size_t)col * 8 + 4); }
    const int RPW = (NX + c.NGW - 1) / c.NGW, rbeg = c.gw * RPW, rend = min(NX, rbeg + RPW);
    f32x4 vnx[4], gm[4], shv[4];
    if (rbeg < NX) { const f32x4* xr = (const f32x4*)(X + (size_t)rbeg * D) + c.lane;
#pragma unroll
        for (int j = 0; j < 4; ++j) vnx[j] = xr[64 * j]; }
    int bcur = -1;
    for (int row = rbeg; row < rend; ++row) {
        const int b = row / SEQ; f32x4 v[4]; float ss = 0.f;
#pragma unroll
        for (int j = 0; j < 4; ++j) v[j] = vnx[j];
        if (row + 1 < rend) { const f32x4* xr = (const f32x4*)(X + (size_t)(row + 1) * D) + c.lane;
#pragma unroll
            for (int j = 0; j < 4; ++j) vnx[j] = xr[64 * j]; }
        if (b != bcur) { bcur = b; const float* mb = modl + (size_t)b * 6144;
#pragma unroll
            for (int j = 0; j < 4; ++j) { const int col = 4 * (c.lane + 64 * j); gm[j] = *(const f32x4*)(gvec + col) * (*(const f32x4*)(mb + 4096 + col) + 1.0f); shv[j] = *(const f32x4*)(mb + 3072 + col); } }
#pragma unroll
        for (int j = 0; j < 4; ++j) ss += (v[j].x * v[j].x + v[j].y * v[j].y) + (v[j].z * v[j].z + v[j].w * v[j].w);
        const float rstd = rsqrtf(wave_sum(ss) * (1.0f / D) + EPS);
        f32x4 la = (f32x4){0.f, 0.f, 0.f, 0.f}, lb = (f32x4){0.f, 0.f, 0.f, 0.f};
#pragma unroll
        for (int j = 0; j < 4; ++j) { const int col = 4 * (c.lane + 64 * j);
            const f32x4 h = v[j] * rstd * gm[j] + shv[j];
            *(unsigned*)(H4 + (size_t)row * D + col) = pk4_fp8(h.x, h.y, h.z, h.w);
#pragma unroll
            for (int q = 0; q < 4; ++q) { la += wa[j][q] * h[q]; lb += wb[j][q] * h[q]; } }
        float lg[8] = {la.x, la.y, la.z, la.w, lb.x, lb.y, lb.z, lb.w};
#pragma unroll
        for (int e = 0; e < 8; ++e) lg[e] = wave_sum(lg[e]);
        int e0 = 0; float l0 = lg[0];
#pragma unroll
        for (int e = 1; e < 8; ++e) if (lg[e] > l0) { l0 = lg[e]; e0 = e; }
        int e1 = -1; float l1 = -3.0e38f;
#pragma unroll
        for (int e = 0; e < 8; ++e) if (e != e0 && lg[e] > l1) { l1 = lg[e]; e1 = e; }
        if (c.lane == 0) { const float w0 = 1.0f / (1.0f + __expf(l1 - l0));
            tok_e[row * 2] = e0; tok_e[row * 2 + 1] = e1; tok_w[row * 2] = w0; tok_w[row * 2 + 1] = 1.0f - w0;
            atomicAdd((unsigned*)&lcnt[e0], 1u); atomicAdd((unsigned*)&lcnt[e1], 1u); }
    }
    __syncthreads();
    if (c.tid < NE) atomicAdd((unsigned*)(a.ws + WS_CTL) + c.tid * 64, lcnt[c.tid]);
}

__device__ __forceinline__ void p13_assign(const Args& a, const Ctx& c) {
    unsigned* ctl = (unsigned*)(a.ws + WS_CTL);
    unsigned cnt[8], pst[8]; unsigned run = 0;
#pragma unroll
    for (int e = 0; e < 8; ++e) { cnt[e] = __hip_atomic_load(ctl + e * 64, __ATOMIC_RELAXED, __HIP_MEMORY_SCOPE_AGENT); pst[e] = run; run += (cnt[e] + 255u) & ~255u; }
    if (blockIdx.x == 0 && c.tid == 0) { int* tile_e = (int*)(a.ws + WS_TILEE);
        for (int e = 0; e < 8; ++e) { const unsigned nt_ = ((cnt[e] + 255u) >> 8); for (unsigned j = 0; j < nt_; ++j) tile_e[(pst[e] >> 8) + j] = e; }
        ctl[16 * 64] = run >> 8; }
    const int* tok_e = (const int*)(a.ws + WS_ROUTE); int* tok_slot = (int*)(a.ws + WS_ROUTE + (size_t)NX * 16); int* slot_tok = (int*)(a.ws + WS_SLOTTOK);
    LAS unsigned* wcnt = (LAS unsigned*)c.lds;
    for (int blk = blockIdx.x; blk < NX * 2 / NTHREADS; blk += c.G) {
        const int p = blk * NTHREADS + c.tid; const int e = tok_e[p];
        unsigned rank = 0;
        __syncthreads();
#pragma unroll
        for (int q = 0; q < 8; ++q) { const unsigned long long m = __ballot(e == q); if (e == q) rank = (unsigned)__popcll(m & ((1ull << c.lane) - 1ull)); if (c.lane == 0) wcnt[c.wave * 8 + q] = (unsigned)__popcll(m); }
        __syncthreads();
        if (c.tid < 8) { unsigned tot = 0;
#pragma unroll
            for (int w = 0; w < 8; ++w) tot += wcnt[w * 8 + c.tid];
            wcnt[64 + c.tid] = tot ? atomicAdd(ctl + (8 + c.tid) * 64, tot) : 0u; }
        __syncthreads();
        unsigned off = wcnt[64 + e] + rank;
        for (int w = 0; w < c.wave; ++w) off += wcnt[w * 8 + e];
        const unsigned slot = pst[e] + off;
        tok_slot[p] = (int)slot; slot_tok[slot] = p >> 1;
    }
}

__device__ __forceinline__ void p16_final(const Args& a, const Ctx& c, int gw, int NGW, int mode, int slot_thresh) {
    const float* modl = (const float*)(a.ws + WS_MOD) + (size_t)17 * 6144; const float* fg = a.in[24];
    const float* tok_w = (const float*)(a.ws + WS_ROUTE + (size_t)NX * 8); const int* tok_slot = (const int*)(a.ws + WS_ROUTE + (size_t)NX * 16);
    const bf16_t* YS = (const bf16_t*)(a.ws + R_HP);
    const int RPW = ((NX + NGW - 1) / NGW + 1) & ~1, rbeg = gw * RPW, rend = min(NX, rbeg + RPW);
    f32x4 g2v[4], fgv[4]; int bcur = -1;
#pragma unroll
    for (int j = 0; j < 4; ++j) fgv[j] = *(const f32x4*)(fg + 4 * (c.lane + 64 * j));
    for (int row0 = rbeg; row0 < rend; row0 += 2) {
        f32x4 v[2][4]; u32x2 ya[2][4], yb[2][4]; float w0[2], w1[2]; bool go[2];
#pragma unroll
        for (int r = 0; r < 2; ++r) { const int row = row0 + r; const f32x4* xr = (const f32x4*)(a.out + (size_t)row * D) + c.lane;
            const int s0 = tok_slot[row * 2], s1 = tok_slot[row * 2 + 1];
            go[r] = mode == 0 || ((max(s0, s1) >= slot_thresh) == (mode == 2));
            if (go[r]) { w0[r] = tok_w[row * 2]; w1[r] = tok_w[row * 2 + 1];
                const u32x2* y0 = (const u32x2*)(YS + (size_t)s0 * D) + c.lane; const u32x2* y1 = (const u32x2*)(YS + (size_t)s1 * D) + c.lane;
#pragma unroll
                for (int j = 0; j < 4; ++j) { v[r][j] = xr[64 * j]; ya[r][j] = y0[64 * j]; yb[r][j] = y1[64 * j]; } } }
        const int b = row0 / SEQ;
        if (b != bcur) { bcur = b;
#pragma unroll
            for (int j = 0; j < 4; ++j) g2v[j] = *(const f32x4*)(modl + (size_t)b * 6144 + 5120 + 4 * (c.lane + 64 * j)); }
#pragma unroll
        for (int r = 0; r < 2; ++r) if (go[r]) { const int row = row0 + r; f32x4* xr = (f32x4*)(a.out + (size_t)row * D) + c.lane; float ss = 0.f;
#pragma unroll
            for (int j = 0; j < 4; ++j) { const u32x2 a0 = ya[r][j], a1 = yb[r][j];
                const f32x4 y0v = (f32x4){bf_lo(a0.x), bf_hi(a0.x), bf_lo(a0.y), bf_hi(a0.y)}, y1v = (f32x4){bf_lo(a1.x), bf_hi(a1.x), bf_lo(a1.y), bf_hi(a1.y)};
                v[r][j] = v[r][j] + g2v[j] * (y0v * w0[r] + y1v * w1[r]);
                ss += (v[r][j].x * v[r][j].x + v[r][j].y * v[r][j].y) + (v[r][j].z * v[r][j].z + v[r][j].w * v[r][j].w); }
            const float rstd = rsqrtf(wave_sum(ss) * (1.0f / D) + EPS);
#pragma unroll
            for (int j = 0; j < 4; ++j) xr[64 * j] = v[r][j] * rstd * fgv[j]; }
    }
}

__global__ void __launch_bounds__(NTHREADS, 2) trunk_fwd(Args a) {
    extern __shared__ __attribute__((aligned(16))) unsigned char lds_raw[];
    Ctx c; c.lds = (LAS unsigned char*)lds_raw; c.tid = threadIdx.x; c.lane = c.tid & 63; c.wave = __builtin_amdgcn_readfirstlane(c.tid >> 6);
    c.G = gridDim.x; c.gw = blockIdx.x * NWAVES + c.wave; c.NGW = c.G * NWAVES;
    unsigned char* ws = a.ws;
    const float* mod0 = (const float*)(ws + WS_MOD); const float* mod1 = mod0 + (size_t)17 * 6144;
    float* ZR = (float*)(ws + WS_ZRES);
    const int lo = a.ph_lo, hi = a.ph_hi;
#define IN(k) (lo <= (k) && (k) < hi)
    volatile LAS unsigned* MISC = (volatile LAS unsigned*)(c.lds + LDS_BYTES - 64);
    if (c.tid < 16) MISC[c.tid] = 0u;
    __syncthreads();
    XcdBarrier bar; bar.bar = (unsigned*)(ws + WS_BAR); bar.x = 0; bar.st = MISC;
    if (hi - lo > 1) bar = xcd_barrier_post((unsigned*)(ws + WS_BAR), MISC);
#ifdef PROBE_PH
    unsigned long long pt0 = 0, pt1 = 0;
#define PSTAMP(k) do { if ((k) == PROBE_PH) pt0 = __builtin_amdgcn_s_memrealtime(); if ((k) == PROBE_PH_END + 1) pt1 = __builtin_amdgcn_s_memrealtime(); } while (0)
#else
#define PSTAMP(k) do { } while (0)
#endif
#define SEAM(k) do { if (IN(k) && IN((k) + 1)) { xcd_barrier(bar); } PSTAMP((k) + 1); } while (0)
    PSTAMP(0);

    if (IN(0)) { p0_adaln(a, c); p0_convert(a, c); } SEAM(0);
    if (IN(1)) { pool_fused(a, c); } SEAM(1);
    PSTAMP(3); PSTAMP(4);
    if (IN(4)) {
        pg8::Prob P{(const bf16_t*)(ws + R_HB), (const bf16_t*)(ws + W_GUT), NT / 256, 2 * DFF / 256, D, D, D, 0, 0, nullptr, 0, nullptr, c.G, (int)blockIdx.x};
        P.esz = 1;
        pg8::EpiSwiGLU8 E{ws + R_HID, DFF};
        pg8::gemm_phase<pg8::EpiSwiGLU8, false, true>(c.lds, P, E);
        if ((int)blockIdx.x >= (NT / 256 * (2 * DFF / 256)) % c.G) moe_convert_queue(a, c, 1);
    } SEAM(4);
    if (IN(5)) {
        pg8::Prob P{(const bf16_t*)(ws + R_HID), (const bf16_t*)(ws + W_DT), NT / 256, D / 256, DFF, DFF, DFF, 0, 0, nullptr, 0, nullptr, c.G, (int)blockIdx.x};
        P.esz = 1;
        pg8::EpiResid E{a.out, a.out, ZR, ZR, mod0 + 5120, nullptr};
        pg8::gemm_phase<pg8::EpiResid, false, true>(c.lds, P, E);
        if ((int)blockIdx.x >= (NT / 256 * (D / 256)) % c.G) moe_convert_queue(a, c, 3);
    } SEAM(5);
    if (IN(6)) { norm_mod_rows(a.out, ZR, NT, a.in[6] + D, mod1, 0, 1024, (bf16_t*)(ws + R_H3), c); } SEAM(6);
    if (IN(7)) {
        pg8::Prob P{(const bf16_t*)(ws + R_H3), (const bf16_t*)(ws + W_INT), NT / 256, 2 * DR / 256, D, D, D, 0, 0, nullptr, 0, nullptr, c.G, (int)blockIdx.x};
        pg8::EpiBf16 E{(bf16_t*)(ws + R_GU2), 2 * DR};
        pg8::gemm_phase(c.lds, P, E);
    } SEAM(7);
    if (IN(8)) { lru_pass<1>(a, c); } SEAM(8);
    if (IN(9)) { lru_scan2(a, c); } SEAM(9);
    PSTAMP(11); PSTAMP(12);
    if (IN(12)) {
        pg8::Prob P{(const bf16_t*)(ws + R_Y), (const bf16_t*)(ws + W_OUTT), NX / 256, D / 256, DR, DR, DR, 0, 0, nullptr, 0, nullptr, c.G, (int)blockIdx.x};
        pg8::EpiResid E{a.out, a.out, ZR, ZR, mod1 + 2048, nullptr};
        pg8::gemm_phase(c.lds, P, E);
    } SEAM(12);
    if (IN(13)) { p12_route(a, c); } SEAM(13);
    if (IN(14)) { p13_assign(a, c); moe_convert_queue(a, c, 1 << 20); } SEAM(14);
    if (IN(15)) {
        const int mt = (int)__hip_atomic_load((unsigned*)(ws + WS_CTL) + 16 * 64, __ATOMIC_RELAXED, __HIP_MEMORY_SCOPE_AGENT);
        pg8::Prob P{(const bf16_t*)(ws + R_H4), (const bf16_t*)(ws + W_MGUT), mt, 2 * DE / 256, D, D, D, 0, 0, (const int*)(ws + WS_TILEE), (size_t)2 * DE * D, (const int*)(ws + WS_SLOTTOK), c.G, (int)blockIdx.x};
        P.esz = 1;
        pg8::EpiSwiGLU8 E{ws + R_MH, DE};
        pg8::gemm_phase<pg8::EpiSwiGLU8, true, true>(c.lds, P, E);
    } SEAM(15);
    if (IN(16)) {
        const int mt = (int)__hip_atomic_load((unsigned*)(ws + WS_CTL) + 16 * 64, __ATOMIC_RELAXED, __HIP_MEMORY_SCOPE_AGENT), main_mt = (mt / 64) * 64;
        pg8::Prob P{(const bf16_t*)(ws + R_MH), (const bf16_t*)(ws + W_MDT), main_mt, D / 256, DE, DE, DE, 0, 0, (const int*)(ws + WS_TILEE), (size_t)D * DE, nullptr, c.G, (int)blockIdx.x};
        P.esz = 1;
        pg8::EpiBf16 E{(bf16_t*)(ws + R_HP), D};
        pg8::gemm_phase<pg8::EpiBf16, false, true>(c.lds, P, E);
    } SEAM(16);
    if (IN(17)) {
        const int mt = (int)__hip_atomic_load((unsigned*)(ws + WS_CTL) + 16 * 64, __ATOMIC_RELAXED, __HIP_MEMORY_SCOPE_AGENT), main_mt = (mt / 64) * 64, ntail = (mt - main_mt) * 4;
        if (ntail >= c.G || (int)blockIdx.x < ntail) {
            pg8::Prob P{(const bf16_t*)(ws + R_MH), (const bf16_t*)(ws + W_MDT), mt - main_mt, D / 256, DE, DE, DE, 0, 0, (const int*)(ws + WS_TILEE), (size_t)D * DE, nullptr, c.G, (int)blockIdx.x};
            P.esz = 1; P.pm_off = main_mt;
            pg8::EpiBf16 E{(bf16_t*)(ws + R_HP), D};
            pg8::gemm_phase<pg8::EpiBf16, false, true>(c.lds, P, E);
        } else {
            p16_final(a, c, ((int)blockIdx.x - ntail) * NWAVES + c.wave, (c.G - ntail) * NWAVES, 1, main_mt * 256);
        }
    } SEAM(17);
    if (IN(18)) {
        const int mt = (int)__hip_atomic_load((unsigned*)(ws + WS_CTL) + 16 * 64, __ATOMIC_RELAXED, __HIP_MEMORY_SCOPE_AGENT), main_mt = (mt / 64) * 64, ntail = (mt - main_mt) * 4;
        p16_final(a, c, c.gw, c.NGW, ntail < c.G ? 2 : 0, main_mt * 256);
    }
#ifdef PROBE_PH
    if (PROBE_PH_END + 1 > NPHASES) pt1 = __builtin_amdgcn_s_memrealtime();
    { const unsigned long long tend = __builtin_amdgcn_s_memrealtime(), dt = (pt1 - pt0) * PROBE_MULT;
      while (__builtin_amdgcn_s_memrealtime() - tend < dt) __builtin_amdgcn_s_sleep(8); }
#endif
#undef IN
#undef SEAM
}

extern "C" void kernel_launch(void* const* d_in, const int* in_sizes, int n_in, void* d_out, int out_size, void* d_ws, size_t ws_size, hipStream_t stream) {
    static int grid = 0;
    if (grid == 0) {
        if (n_in != 25 || out_size != NX * D || ws_size < WS_NEED) { fprintf(stderr, "kernel_launch: unexpected shapes (n_in %d out %d ws %zu, need %zu)\n", n_in, out_size, ws_size, (size_t)WS_NEED); grid = -1; return; }
        int dev = 0, cus = 0, per_cu = 0;
        hipGetDevice(&dev); hipDeviceGetAttribute(&cus, hipDeviceAttributeMultiprocessorCount, dev);
        if (hipFuncSetAttribute((const void*)trunk_fwd, hipFuncAttributeMaxDynamicSharedMemorySize, LDS_BYTES) != hipSuccess) { fprintf(stderr, "kernel_launch: hipFuncSetAttribute failed\n"); grid = -1; return; }
        if (hipOccupancyMaxActiveBlocksPerMultiprocessor(&per_cu, (const void*)trunk_fwd, NTHREADS, LDS_BYTES) != hipSuccess || per_cu < 1) { fprintf(stderr, "kernel_launch: occupancy query says %d\n", per_cu); per_cu = 1; }
        (void)hipGetLastError();
        grid = cus;
    }
    if (grid < 0) return;
    hipMemsetAsync((char*)d_ws + WS_CTL, 0, CTL_BYTES, stream);
    Args a{};
    for (int i = 0; i < 25; ++i) a.in[i] = (const float*)d_in[i];
    a.out = (float*)d_out; a.ws = (unsigned char*)d_ws;
#if MK_SINGLE
    a.ph_lo = 0; a.ph_hi = NPHASES + 1;
    hipLaunchKernelGGL(trunk_fwd, dim3(grid), dim3(NTHREADS), LDS_BYTES, stream, a);
#else
    for (int ph = 0; ph <= NPHASES; ++ph) { a.ph_lo = ph; a.ph_hi = ph + 1;
        hipLaunchKernelGGL(trunk_fwd, dim3(grid), dim3(NTHREADS), LDS_BYTES, stream, a); }
#endif
}
```

```cpp
#include <hip/hip_runtime.h>
#include <cstdio>
#include <cstdint>

#define LAS __attribute__((address_space(3)))
typedef unsigned short bf16_t;
typedef short bf16x8 __attribute__((ext_vector_type(8)));
typedef float f32x4 __attribute__((ext_vector_type(4)));
typedef float f32x2 __attribute__((ext_vector_type(2)));
typedef unsigned u32x4 __attribute__((ext_vector_type(4)));
typedef unsigned u32x2 __attribute__((ext_vector_type(2)));
typedef int i32x4 __attribute__((ext_vector_type(4)));
typedef int i32x8 __attribute__((ext_vector_type(8)));

#ifndef MK_SINGLE
#define MK_SINGLE 1
#endif

constexpr int D = 1024, NB = 16, SEQ = 2048, CL = 256, NX = NB * SEQ, NZ = NB * CL, NT = NX + NZ;
constexpr int DFF = 2816, DR = 1280, DE = 3584, NE = 8;
constexpr int NSLOT = (NX * 2 / 256 + NE) * 256;
constexpr int NWAVES = 8, NTHREADS = 512;
constexpr float EPS = 1e-6f;
constexpr int NPHASES = 18;
constexpr int LDS_BYTES = 147456;

constexpr size_t MiB = 1024 * 1024;
constexpr size_t WS_CTL = 0;
constexpr size_t CTL_BYTES = 32768;
constexpr size_t WS_BAR = 16384;
constexpr size_t WS_TILEE = 8192;
constexpr size_t WS_MOD = 64 * 1024;
constexpr size_t WS_SP = 900 * 1024;
constexpr size_t WS_ROUTE = 1 * MiB;
constexpr size_t WS_SLOTTOK = 2 * MiB;
constexpr size_t WS_CHUNK = 3 * MiB;
constexpr size_t WS_ZRES = 9 * MiB;
constexpr size_t WS_W = 25 * MiB;
constexpr size_t W_POOLT = WS_W;
constexpr size_t W_GUT = W_POOLT + (size_t)1024 * 256 * 2;
constexpr size_t W_DT = W_GUT + (size_t)5632 * 1024 * 2;
constexpr size_t W_INT = W_DT + (size_t)1024 * 2816 * 2;
constexpr size_t W_GT = W_INT + (size_t)2560 * 1024 * 2;
constexpr size_t W_OUTT = W_GT + (size_t)5120 * 256 * 2;
constexpr size_t W_MGUT = W_OUTT + (size_t)1024 * 1280 * 2;
constexpr size_t W_MDT = W_MGUT + (size_t)8 * 7168 * 1024;
constexpr size_t W_END = W_MDT + (size_t)8 * 1024 * 3584;
constexpr size_t WS_XB = 140 * MiB;
static_assert(W_END <= WS_XB, "weights overflow");
constexpr size_t WS_R = 221 * MiB;
static_assert(WS_XB + (size_t)NT * D * 2 <= WS_R, "residual stream overflow");
constexpr size_t R_HB = WS_R;
constexpr size_t R_HID = WS_R + 72 * MiB;
constexpr size_t R_GU2 = WS_R;
constexpr size_t R_Y = WS_R + 180 * MiB;
constexpr size_t R_H3 = WS_R + 270 * MiB;
constexpr size_t R_CHUNK = WS_R + 600 * MiB;
constexpr size_t R_LABG = WS_R + 270 * MiB;
constexpr size_t R_HP = WS_R;
constexpr size_t R_MH = WS_R + 132 * MiB;
constexpr size_t R_H4 = WS_R;
constexpr size_t WS_NEED = WS_R + 630 * MiB;
static_assert(R_MH + (size_t)NSLOT * DE * 2 <= WS_NEED, "MH overflow");
static_assert(WS_NEED <= (size_t)896 * MiB, "workspace");

__device__ __forceinline__ unsigned cvt_pk_bf16(float lo, float hi) { unsigned r; asm volatile("v_cvt_pk_bf16_f32 %0, %1, %2" : "=v"(r) : "v"(lo), "v"(hi)); return r; }
__device__ __forceinline__ unsigned pk4_fp8(float a, float b, float c, float d) { int w = 0; w = __builtin_amdgcn_cvt_pk_fp8_f32(a, b, w, false); w = __builtin_amdgcn_cvt_pk_fp8_f32(c, d, w, true); return (unsigned)w; }
constexpr float YS_SCALE = 16.0f;
constexpr float W8_SCALE = 64.0f;
__device__ __forceinline__ float bf_lo(unsigned u) { return __uint_as_float(u << 16); }
__device__ __forceinline__ float bf_hi(unsigned u) { return __uint_as_float(u & 0xffff0000u); }
__device__ __forceinline__ float wave_sum(float v) {
#pragma unroll
    for (int o = 1; o < 64; o <<= 1) v += __shfl_xor(v, o);
    return v;
}
__device__ __forceinline__ float fast_exp(float x) { return __builtin_amdgcn_exp2f(x * 1.44269504089f); }
__device__ __forceinline__ float sigmoidf_(float x) { return __builtin_amdgcn_rcpf(1.0f + fast_exp(-x)); }
__device__ __forceinline__ float siluf_(float x) { return x * sigmoidf_(x); }
__device__ __forceinline__ float gelu_tanh(float x) {
    const float u = 0.7978845608f * (x + 0.044715f * x * x * x);
    const float t = 1.0f - 2.0f * __builtin_amdgcn_rcpf(fast_exp(2.0f * u) + 1.0f);
    return 0.5f * x * (1.0f + t);
}

#ifdef PROBE_SUB
#define SUBT0(id) do { if ((id) == PROBE_SUB) psub_t0 = __builtin_amdgcn_s_memrealtime(); } while (0)
#define SUBT1(id) do { if ((id) == PROBE_SUB) psub_acc += __builtin_amdgcn_s_memrealtime() - psub_t0; } while (0)
#define SUBDECL unsigned long long psub_t0 = 0, psub_acc = 0
#define SUBSPIN do { const unsigned long long te_ = __builtin_amdgcn_s_memrealtime(); while (__builtin_amdgcn_s_memrealtime() - te_ < psub_acc) __builtin_amdgcn_s_sleep(8); } while (0)
#else
#define SUBT0(id) do { } while (0)
#define SUBT1(id) do { } while (0)
#define SUBDECL do { } while (0)
#define SUBSPIN do { } while (0)
#endif
__device__ __forceinline__ f32x2 silu_mul_pk(f32x2 g, f32x2 u) {
    f32x2 t = g * -1.44269504089f; t.x = fminf(t.x, 60.0f); t.y = fminf(t.y, 60.0f);
    f32x2 e; e.x = __builtin_amdgcn_exp2f(t.x); e.y = __builtin_amdgcn_exp2f(t.y);
    const f32x2 d = e + 1.0f; const float R = __builtin_amdgcn_rcpf(d.x * d.y);
    return (g * u) * ((f32x2){d.y, d.x} * R);
}
__device__ __forceinline__ f32x2 gelu_tanh_pk(f32x2 x) {
    const f32x2 x2 = x * x, u2 = x * (x2 * (2.0f * 0.7978845608f * 0.044715f * 1.44269504089f) + (2.0f * 0.7978845608f * 1.44269504089f));
    f32x2 e; e.x = __builtin_amdgcn_exp2f(u2.x); e.y = __builtin_amdgcn_exp2f(u2.y);
    const f32x2 d = e + 1.0f; f32x2 r; r.x = __builtin_amdgcn_rcpf(d.x); r.y = __builtin_amdgcn_rcpf(d.y);
    return x - x * r;
}
namespace pg8 {
constexpr int ECAP = 32768;
constexpr int BM = 256, BK = 64, HALF = 128, HTB = HALF * BK * 2, STAGE_BYTES = 8 * HTB, NXCD = 8, WGM = 8;
__device__ __forceinline__ int lds_byte(int r, int c) { const int st = (r >> 4) * 2 + (c >> 5), rr = r & 15, cc = c & 31, ob = rr * 64 + cc * 2; return st * 1024 + (ob ^ (((ob >> 9) & 1) << 5)); }
__device__ __forceinline__ void stage_rc(int b, int& R, int& C) { const int st = b / 1024, sb = b % 1024, swz = sb ^ (((sb >> 9) & 1) << 5); R = (st >> 1) * 16 + swz / 64; C = (st & 1) * 32 + (swz % 64) / 2; }
__device__ __forceinline__ int perm32(int rho) { const int n = rho >> 4, i = rho & 15; return 8 * (i >> 2) + 4 * n + (i & 3); }

struct Unit { int pm, pn, rb; const char* A; const char* B; };

struct Prob {
    const bf16_t* A; const bf16_t* Bt; int nM, nN, K, lda, ldb;
    int grp, kshr;
    bool by_expert; size_t estride;
    const int* rowidx;
    int G, c;
    int pm_off = 0;
    int esz = 2;
    int tb[9] = {0, 0, 0, 0, 0, 0, 0, 0, 0};
    __device__ __forceinline__ bool next(int i, Unit& u) const {
        const int nwg = nM * nN; const long L = (long)i * G + c; if (L >= nwg) return false;
        int wgid = (int)L; { const int q = nwg / NXCD, r = nwg % NXCD, xcd = wgid % NXCD, off = wgid / NXCD; wgid = (xcd < r ? xcd * (q + 1) : r * (q + 1) + (xcd - r) * q) + off; }
        const int nig = WGM * nN, gid = wgid / nig, fm = gid * WGM, gsz = (nM - fm) < WGM ? (nM - fm) : WGM;
        u.pm = fm + ((wgid % nig) % gsz) + pm_off; u.pn = (wgid % nig) / gsz;
        u.A = rowidx ? (const char*)A : (const char*)A + ((size_t)u.pm * BM * lda + (grp ? (size_t)((u.pn >> kshr) * 256) : (size_t)0)) * esz;
        size_t bo = (size_t)u.pn * BM * ldb;
        u.rb = u.pm * BM;
        if (by_expert) { int e = 0, base = 0;
#pragma unroll
            for (int q = 1; q < 8; ++q) if (u.pm >= tb[q]) { e = q; base = tb[q]; }
            bo += (size_t)e * estride; u.rb = e * ECAP + (u.pm - base) * BM; }
        u.B = (const char*)Bt + bo * esz;
        return true;
    }
};

struct EpiBf16 {
    static constexpr bool PERM = true;
    bf16_t* O; int ldc; float sc = 1.0f;
    __device__ __forceinline__ void operator()(const f32x4 (&acc)[2][2][4][2], const Unit& u, int wr, int wc, int fr, int fq) const {
        const int row0 = u.pm * BM + wr * 64 + fr, col0 = u.pn * BM + wc * 32 + 8 * fq;
#pragma unroll
        for (int ai = 0; ai < 2; ++ai)
#pragma unroll
            for (int m = 0; m < 4; ++m) { bf16_t* rowp = O + (size_t)(row0 + ai * HALF + m * 16) * ldc + col0;
#pragma unroll
                for (int bj = 0; bj < 2; ++bj) { const f32x4 v0 = acc[ai][bj][m][0] * sc, v1 = acc[ai][bj][m][1] * sc;
                    u32x4 w; w.x = cvt_pk_bf16(v0[0], v0[1]); w.y = cvt_pk_bf16(v0[2], v0[3]); w.z = cvt_pk_bf16(v1[0], v1[1]); w.w = cvt_pk_bf16(v1[2], v1[3]);
                    *(u32x4*)(rowp + bj * HALF) = w; } }
    }
};
struct EpiSwiGLU {
    static constexpr bool PERM = true;
    bf16_t* O; int ldc;
    __device__ __forceinline__ void operator()(const f32x4 (&acc)[2][2][4][2], const Unit& u, int wr, int wc, int fr, int fq) const {
        const int row0 = u.pm * BM + wr * 64 + fr, col0 = u.pn * HALF + wc * 32 + 8 * fq;
#pragma unroll
        for (int ai = 0; ai < 2; ++ai)
#pragma unroll
            for (int m = 0; m < 4; ++m) { bf16_t* rowp = O + (size_t)(row0 + ai * HALF + m * 16) * ldc + col0;
                float v[8];
#pragma unroll
                for (int n = 0; n < 2; ++n)
#pragma unroll
                    for (int j = 0; j < 4; ++j) v[n * 4 + j] = siluf_(acc[ai][0][m][n][j]) * acc[ai][1][m][n][j];
                u32x4 w; w.x = cvt_pk_bf16(v[0], v[1]); w.y = cvt_pk_bf16(v[2], v[3]); w.z = cvt_pk_bf16(v[4], v[5]); w.w = cvt_pk_bf16(v[6], v[7]);
                *(u32x4*)rowp = w; }
    }
};
struct EpiSwiGLU8 {
    static constexpr bool PERM = true;
    unsigned char* O; int ldc;
    __device__ __forceinline__ void operator()(const f32x4 (&acc)[2][2][4][2], const Unit& u, int wr, int wc, int fr, int fq) const {
        const int row0 = u.pm * BM + wr * 64 + fr, col0 = u.pn * HALF + wc * 32 + 8 * (fq & ~1); const bool odd = fq & 1;
#pragma unroll
        for (int ai = 0; ai < 2; ++ai)
#pragma unroll
            for (int mp = 0; mp < 2; ++mp) { u32x2 w[2];
#pragma unroll
                for (int q = 0; q < 2; ++q) { const int m = 2 * mp + q; float v[8];
#pragma unroll
                    for (int n = 0; n < 2; ++n)
#pragma unroll
                        for (int jp = 0; jp < 2; ++jp) { const f32x2 r = silu_mul_pk((f32x2){acc[ai][0][m][n][2 * jp], acc[ai][0][m][n][2 * jp + 1]}, (f32x2){acc[ai][1][m][n][2 * jp], acc[ai][1][m][n][2 * jp + 1]});
                            v[n * 4 + 2 * jp] = r.x; v[n * 4 + 2 * jp + 1] = r.y; }
                    w[q].x = pk4_fp8(v[0], v[1], v[2], v[3]); w[q].y = pk4_fp8(v[4], v[5], v[6], v[7]); }
                const auto sx = __builtin_amdgcn_permlane16_swap(w[0].x, w[1].x, false, false), sy = __builtin_amdgcn_permlane16_swap(w[0].y, w[1].y, false, false);
                const int m = 2 * mp + (odd ? 1 : 0);
                u32x4 o; o.x = sx[0]; o.y = sy[0]; o.z = sx[1]; o.w = sy[1];
                *(u32x4*)(O + (size_t)(row0 + ai * HALF + m * 16) * ldc + col0) = o; }
    }
};
struct EpiFp8 {
    static constexpr bool PERM = true;
    unsigned char* O; int ldc; float sc;
    __device__ __forceinline__ void operator()(const f32x4 (&acc)[2][2][4][2], const Unit& u, int wr, int wc, int fr, int fq) const {
        const int row0 = u.pm * BM + wr * 64 + fr, col0 = u.pn * BM + wc * 32 + 8 * (fq & ~1); const bool odd = fq & 1;
#pragma unroll
        for (int ai = 0; ai < 2; ++ai)
#pragma unroll
            for (int bj = 0; bj < 2; ++bj)
#pragma unroll
                for (int mp = 0; mp < 2; ++mp) { u32x2 w[2];
#pragma unroll
                    for (int q = 0; q < 2; ++q) { const int m = 2 * mp + q; const f32x4 a0 = acc[ai][bj][m][0] * sc, a1 = acc[ai][bj][m][1] * sc;
                        w[q].x = pk4_fp8(a0.x, a0.y, a0.z, a0.w); w[q].y = pk4_fp8(a1.x, a1.y, a1.z, a1.w); }
                    const auto sx = __builtin_amdgcn_permlane16_swap(w[0].x, w[1].x, false, false), sy = __builtin_amdgcn_permlane16_swap(w[0].y, w[1].y, false, false);
                    const int m = 2 * mp + (odd ? 1 : 0);
                    u32x4 o; o.x = sx[0]; o.y = sy[0]; o.z = sx[1]; o.w = sy[1];
                    *(u32x4*)(O + (size_t)(row0 + ai * HALF + m * 16) * ldc + col0 + bj * HALF) = o; }
    }
};
struct EpiResid {
    static constexpr bool PERM = true;
    bf16_t* X; const float* gate  ; const float* colscale; float sc = 1.0f;
    __device__ __forceinline__ void operator()(const f32x4 (&acc)[2][2][4][2], const Unit& u, int wr, int wc, int fr, int fq) const {
        const int b = u.pm < NX / BM ? (u.pm >> 3) : NB;
        const int col0 = u.pn * BM + wc * 32 + 8 * fq;
        f32x4 gv[2][2];
#pragma unroll
        for (int bj = 0; bj < 2; ++bj)
#pragma unroll
            for (int n = 0; n < 2; ++n) { const int col = col0 + bj * HALF + 4 * n; gv[bj][n] = *(const f32x4*)(gate + (size_t)b * 6144 + col) * sc; if (colscale) gv[bj][n] = gv[bj][n] * *(const f32x4*)(colscale + col); }
#pragma unroll
        for (int ai = 0; ai < 2; ++ai)
#pragma unroll
            for (int m = 0; m < 4; ++m) { bf16_t* p = X + (size_t)(u.pm * BM + ai * HALF + wr * 64 + m * 16 + fr) * D + col0;
#pragma unroll
                for (int bj = 0; bj < 2; ++bj) { const u32x4 bs = *(const u32x4*)(p + bj * HALF);
                    const f32x4 o0 = (f32x4){bf_lo(bs.x), bf_hi(bs.x), bf_lo(bs.y), bf_hi(bs.y)} + gv[bj][0] * acc[ai][bj][m][0];
                    const f32x4 o1 = (f32x4){bf_lo(bs.z), bf_hi(bs.z), bf_lo(bs.w), bf_hi(bs.w)} + gv[bj][1] * acc[ai][bj][m][1];
                    u32x4 o; o.x = cvt_pk_bf16(o0.x, o0.y); o.y = cvt_pk_bf16(o0.z, o0.w); o.z = cvt_pk_bf16(o1.x, o1.y); o.w = cvt_pk_bf16(o1.z, o1.w);
                    *(u32x4*)(p + bj * HALF) = o; } }
    }
};
template <class Epi, bool GATHER = false, bool FP8 = false>
__device__ __forceinline__ void gemm_phase(LAS unsigned char* lds, const Prob& S, const Epi& E) {
    const int tid = threadIdx.x, wid = __builtin_amdgcn_readfirstlane(tid >> 6), lane = tid & 63, wr = wid >> 2, wc = wid & 3, fr = lane & 15, fq = lane >> 4;
    const int ESZ = FP8 ? 1 : 2;
    const int K = S.K, nt = K * ESZ / (BK * 2);
    unsigned voffA[2], voffB[2];
#pragma unroll
    for (int i = 0; i < 2; ++i) { int R, C; stage_rc(tid * 16 + i * 8192, R, C); const int Rb = Epi::PERM ? ((R & ~31) + perm32(R & 31)) : R;
        voffA[i] = (unsigned)(R * S.lda * ESZ + C * 2); voffB[i] = (unsigned)(Rb * S.ldb * ESZ + C * 2); }
    const size_t kstep = (size_t)(BK * 2);
    const size_t hstepA = GATHER ? (size_t)0 : (size_t)HALF * S.lda * ESZ, hstepB = (size_t)HALF * S.ldb * ESZ;
    unsigned gc[2][2], gn[2][2];
#define PG8_GLOAD(dst, rb_) do { _Pragma("unroll") for (int _i = 0; _i < 2; ++_i) { int R_, C_; stage_rc(tid * 16 + _i * 8192, R_, C_); _Pragma("unroll") for (int _h = 0; _h < 2; ++_h) \
        dst[_h][_i] = (unsigned)S.rowidx[(rb_) + _h * HALF + R_] * (unsigned)(S.lda * ESZ) + (unsigned)(C_ * 2); } } while (0)
    const unsigned ldsw = (unsigned)wid * 1024u;
    const int aoff = lds_byte(wr * 64 + fr, fq * 8), boff = lds_byte(wc * 32 + fr, fq * 8);
#define PG8_SA(b, h) (((b) * 2 + (h)) * HTB)
#define PG8_SB(b, h) ((4 + (b) * 2 + (h)) * HTB)
#define PG8_STAGE(bufoff, gbase, voff) do { _Pragma("unroll") for (int _i = 0; _i < 2; ++_i) \
        __builtin_amdgcn_global_load_lds((const unsigned*)((const char*)(gbase) + (voff)[_i]), (LAS unsigned*)(lds + (bufoff) + ldsw + _i * 8192), 16, 0, 0); } while (0)
#define PG8_STAGEA(bufoff, gbase, h, offs) do { if constexpr (GATHER) { PG8_STAGE(bufoff, gbase, offs[h]); } else { PG8_STAGE(bufoff, (gbase) + (h) * hstepA, voffA); } } while (0)
#define PG8_STAGEA2(bufoff, gbase, h) do { if constexpr (GATHER) { unsigned o_[2] = {last ? gn[h][0] : gc[h][0], last ? gn[h][1] : gc[h][1]}; PG8_STAGE(bufoff, gbase, o_); } else { PG8_STAGE(bufoff, (gbase) + (h) * hstepA, voffA); } } while (0)
#define PG8_LD32(p_) __builtin_shufflevector(*(const LAS i32x4*)(p_), *(const LAS i32x4*)((p_) + 1024), 0, 1, 2, 3, 4, 5, 6, 7)
#define PG8_LDA(dst, b, h) do { if constexpr (FP8) { _Pragma("unroll") for (int m = 0; m < 4; ++m) dst##8[m] = PG8_LD32(lds + PG8_SA(b, h) + aoff + m * 2048); } \
        else { _Pragma("unroll") for (int m = 0; m < 4; ++m) _Pragma("unroll") for (int k = 0; k < 2; ++k) dst[m][k] = *(const LAS bf16x8*)(lds + PG8_SA(b, h) + aoff + m * 2048 + k * 1024); } } while (0)
#define PG8_LDB(dst, b, h) do { if constexpr (FP8) { _Pragma("unroll") for (int n = 0; n < 2; ++n) dst##8[n] = PG8_LD32(lds + PG8_SB(b, h) + boff + n * 2048); } \
        else { _Pragma("unroll") for (int n = 0; n < 2; ++n) _Pragma("unroll") for (int k = 0; k < 2; ++k) dst[n][k] = *(const LAS bf16x8*)(lds + PG8_SB(b, h) + boff + n * 2048 + k * 1024); } } while (0)
#define PG8_MMA(ai, bj, At, Bt) do { __builtin_amdgcn_s_setprio(1); \
        if constexpr (FP8) { _Pragma("unroll") for (int m = 0; m < 4; ++m) _Pragma("unroll") for (int n = 0; n < 2; ++n) \
            asm volatile("v_mfma_scale_f32_16x16x128_f8f6f4 %0, %1, %2, %0, %3, %4 op_sel_hi:[0,0,0]" : "+v"(acc[ai][bj][m][n]) : "v"(Bt##8[n]), "v"(At##8[m]), "v"(scalew), "v"(scale1)); } \
        else { _Pragma("unroll") for (int m = 0; m < 4; ++m) _Pragma("unroll") for (int n = 0; n < 2; ++n) _Pragma("unroll") for (int k = 0; k < 2; ++k) \
            acc[ai][bj][m][n] = __builtin_amdgcn_mfma_f32_16x16x32_bf16(Bt[n][k], At[m][k], acc[ai][bj][m][n], 0, 0, 0); } \
        __builtin_amdgcn_s_setprio(0); } while (0)
#define PG8_WAIT_V(n) asm volatile("s_waitcnt vmcnt(" #n ")" ::: "memory")
#define PG8_WAIT_L(n) asm volatile("s_waitcnt lgkmcnt(" #n ")" ::: "memory")
#define PG8_BAR __builtin_amdgcn_s_barrier()
#define PG8_SCHED __builtin_amdgcn_sched_barrier(0)
    SUBDECL;
    Unit cur, nxt; int ui = 0;
    if (!S.next(0, cur)) return;
    f32x4 acc[2][2][4][2];
#pragma unroll
    for (int a = 0; a < 2; ++a)
#pragma unroll
        for (int b = 0; b < 2; ++b)
#pragma unroll
            for (int m = 0; m < 4; ++m)
#pragma unroll
                for (int n = 0; n < 2; ++n) acc[a][b][m][n] = (f32x4){0.f, 0.f, 0.f, 0.f};
    int scale1 = 0x7F7F7F7F, scalew = 0x79797979; asm volatile("" : "+v"(scale1), "+v"(scalew));
    bf16x8 At[4][2], B0[2][2], B1[2][2]; i32x8 At8[4], B08[2], B18[2];
    const char* cA = cur.A; const char* cB = cur.B;
    if constexpr (GATHER) { PG8_GLOAD(gc, cur.rb); asm volatile("s_waitcnt vmcnt(0)" ::: "memory"); }
    PG8_STAGE(PG8_SB(0, 0), cB, voffB); PG8_STAGE(PG8_SB(0, 1), cB + hstepB, voffB); PG8_STAGEA(PG8_SA(0, 0), cA, 0, gc); PG8_STAGEA(PG8_SA(0, 1), cA, 1, gc);
    if (wr == 1) PG8_BAR;
    PG8_WAIT_V(2); PG8_BAR;
    PG8_STAGE(PG8_SB(1, 0), cB + kstep, voffB); PG8_STAGEA(PG8_SA(1, 0), cA + kstep, 0, gc); PG8_STAGE(PG8_SB(1, 1), cB + hstepB + kstep, voffB);
    PG8_WAIT_V(6); PG8_BAR;
    for (;;) {
        const bool has_next = S.next(ui + 1, nxt);
        const char* nA = has_next ? nxt.A : cA; const char* nB = has_next ? nxt.B : cB;
        if constexpr (GATHER) { PG8_GLOAD(gn, (has_next ? nxt.rb : cur.rb)); asm volatile("s_waitcnt vmcnt(0)" ::: "memory"); }
        for (int t = 0; t < nt; t += 2) {
            const bool last = (t == nt - 2);
            const char* a1 = cA + (size_t)(t + 1) * kstep;
            const char* a2 = last ? nA : cA + (size_t)(t + 2) * kstep; const char* b2 = last ? nB : cB + (size_t)(t + 2) * kstep;
            const char* a3 = a2 + kstep; const char* b3 = b2 + kstep;
            PG8_LDB(B0, 0, 0); PG8_LDB(B1, 0, 1); PG8_SCHED; PG8_LDA(At, 0, 0); PG8_STAGEA(PG8_SA(1, 1), a1, 1, gc);
            PG8_WAIT_V(8); PG8_WAIT_L(0); PG8_BAR; PG8_MMA(0, 0, At, B0); PG8_MMA(0, 1, At, B1); PG8_BAR; PG8_SCHED;
            PG8_LDA(At, 0, 1); PG8_STAGE(PG8_SB(0, 0), b2, voffB); PG8_STAGE(PG8_SB(0, 1), b2 + hstepB, voffB); PG8_STAGEA2(PG8_SA(0, 0), a2, 0);
            PG8_WAIT_V(8); PG8_WAIT_L(0); PG8_BAR; PG8_MMA(1, 0, At, B0); PG8_MMA(1, 1, At, B1); PG8_BAR; PG8_SCHED;
            PG8_LDB(B0, 1, 0); PG8_LDB(B1, 1, 1); PG8_SCHED; PG8_LDA(At, 1, 0); PG8_STAGEA2(PG8_SA(0, 1), a2, 1);
            PG8_WAIT_V(8); PG8_WAIT_L(0); PG8_BAR; PG8_MMA(0, 0, At, B0); PG8_MMA(0, 1, At, B1); PG8_BAR; PG8_SCHED;
            PG8_LDA(At, 1, 1); PG8_STAGE(PG8_SB(1, 0), b3, voffB); PG8_STAGE(PG8_SB(1, 1), b3 + hstepB, voffB); PG8_STAGEA2(PG8_SA(1, 0), a3, 0);
            PG8_WAIT_V(8); PG8_WAIT_L(0); PG8_BAR; PG8_MMA(1, 0, At, B0); PG8_MMA(1, 1, At, B1); PG8_BAR; PG8_SCHED;
        }
        if (wr == 0) PG8_BAR;
        if constexpr (FP8) asm volatile("s_nop 15\n\ts_nop 15" ::: "memory");
        if constexpr (FP8 && GATHER) SUBT0(10);
        E(acc, cur, wr, wc, fr, fq);
        if constexpr (FP8 && GATHER) SUBT1(10);
        if (!has_next) break;
#pragma unroll
        for (int a = 0; a < 2; ++a)
#pragma unroll
            for (int b = 0; b < 2; ++b)
#pragma unroll
                for (int m = 0; m < 4; ++m)
#pragma unroll
                    for (int n = 0; n < 2; ++n) acc[a][b][m][n] = (f32x4){0.f, 0.f, 0.f, 0.f};
        cur = nxt; cA = nA; cB = nB; ++ui;
        if constexpr (GATHER) {
#pragma unroll
            for (int _h = 0; _h < 2; ++_h)
#pragma unroll
                for (int _i = 0; _i < 2; ++_i) gc[_h][_i] = gn[_h][_i]; }
        if (wr == 1) PG8_BAR;
    }
    PG8_WAIT_V(0);
    PG8_BAR;
    if constexpr (FP8 && GATHER) SUBSPIN;
#undef PG8_SA
#undef PG8_SB
#undef PG8_STAGE
#undef PG8_STAGEA
#undef PG8_STAGEA2
#undef PG8_GLOAD
#undef PG8_LDA
#undef PG8_LDB
#undef PG8_MMA
#undef PG8_LD32
#undef PG8_WAIT_V
#undef PG8_WAIT_L
#undef PG8_BAR
#undef PG8_SCHED
}
}


#define XB_TMO      128
#define XB_XCNT(j)  (256  + 64 * (j))
#define XB_XSUB(j)  (1280 + 64 * (j))
#define XB_XGEN(j)  (2304 + 64 * (j))
#define XB_TOP      3328
#define XB_TOPGEN   3392
#define XCD_BAR_WORDS 3456
#define XB_SPIN_CAP (1u << 20)
__device__ __forceinline__ unsigned xb_ld(unsigned* p)              { return __hip_atomic_load(p, __ATOMIC_RELAXED, __HIP_MEMORY_SCOPE_AGENT); }
__device__ __forceinline__ unsigned xb_add(unsigned* p, unsigned v) { return __hip_atomic_fetch_add(p, v, __ATOMIC_RELAXED, __HIP_MEMORY_SCOPE_AGENT); }
__device__ __forceinline__ unsigned xb_xcc_id() { return (unsigned)__builtin_amdgcn_s_getreg((3 << 11) | 20) & 0xFu; }
#define XB_SPIN(cond, bar) do { unsigned _sp = 0; while (cond) { __builtin_amdgcn_s_sleep(1); \
    if ((++_sp & 255u) == 0u) { if (xb_ld(&(bar)[XB_TMO])) break; if (_sp > XB_SPIN_CAP) { atomicAdd(&(bar)[XB_TMO], 1u); break; } } } } while (0)
struct XcdBarrier { unsigned* bar; unsigned x; volatile LAS unsigned* st; };
__device__ __forceinline__ XcdBarrier xcd_barrier_post(unsigned* bar, volatile LAS unsigned* st) {
    XcdBarrier b; b.bar = bar; b.x = xb_xcc_id(); b.st = st;
    if (threadIdx.x == 0) (void)xb_add(&bar[XB_XCNT(b.x)], 1u);
    return b;
}
__device__ __forceinline__ void xcd_barrier_complete(unsigned* bar, unsigned x, unsigned& nloc, unsigned& nx, unsigned& mask) {
    const unsigned G = gridDim.x * gridDim.y * gridDim.z;
    unsigned sum, cnt, mine, sp = 0u;
    for (;;) {
        sum = 0u; cnt = 0u; mine = 0u; mask = 0u;
#pragma unroll
        for (unsigned j = 0; j < 16; ++j) { const unsigned c = xb_ld(&bar[XB_XCNT(j)]); sum += c; cnt += (c > 0u) ? 1u : 0u; mask |= (c > 0u) ? (1u << j) : 0u; mine = (j == x) ? c : mine; }
        if (sum == G) break;
        __builtin_amdgcn_s_sleep(1);
        if ((++sp & 255u) == 0u) { if (xb_ld(&bar[XB_TMO])) break; if (sp > XB_SPIN_CAP) { atomicAdd(&bar[XB_TMO], 1u); break; } }
    }
    nloc = mine > 0u ? mine : 1u; nx = cnt > 0u ? cnt : 1u;
}
__device__ __forceinline__ void xcd_barrier(const XcdBarrier& b) {
    asm volatile("s_waitcnt vmcnt(0)" ::: "memory");
    __syncthreads();
    if (threadIdx.x == 0) {
        unsigned* bar = b.bar;
        __builtin_amdgcn_s_waitcnt(0);
        unsigned nloc = b.st[0], nx = b.st[1], mask = b.st[2];
        if (nloc == 0u) { xcd_barrier_complete(bar, b.x, nloc, nx, mask); b.st[0] = nloc; b.st[1] = nx; b.st[2] = mask; }
        const unsigned old = xb_add(&bar[XB_XSUB(b.x)], 1u);
        const unsigned gen = old / nloc;
        if (old + 1u == (gen + 1u) * nloc) {
            __builtin_amdgcn_fence(__ATOMIC_RELEASE, "agent");
            asm volatile("s_waitcnt vmcnt(0)" ::: "memory");
            const unsigned og = xb_add(&bar[XB_TOP], 1u);
            const unsigned tg = og / nx;
            if (og + 1u == (tg + 1u) * nx) {
#pragma unroll
                for (unsigned j = 0; j < 16; ++j) if ((mask >> j) & 1u) (void)__hip_atomic_fetch_add(&bar[XB_XGEN(j)], 1u, __ATOMIC_RELAXED, __HIP_MEMORY_SCOPE_AGENT); }
        }
        XB_SPIN(xb_ld(&bar[XB_XGEN(b.x)]) == gen, bar);
        __builtin_amdgcn_fence(__ATOMIC_ACQUIRE, "agent");
        asm volatile("s_waitcnt vmcnt(0)" ::: "memory");
    }
    __syncthreads();
}

struct Args {
    const float* in[25]; float* out; unsigned char* ws; int ph_lo, ph_hi;
};

struct Ctx { LAS unsigned char* lds; int tid, lane, wave, gw, NGW, G; };


template <int UNR = 8>
__device__ __forceinline__ void tr_item(const float* W, int ldw, int scol0, int k0, bf16_t* WT, int ldt, int drow0, int dk0, LAS float* scr, int lane) {
#pragma unroll UNR
    for (int i = 0; i < 32; ++i) { const int kk = 2 * i + (lane >> 5); scr[kk * 33 + (lane & 31)] = W[(size_t)(k0 + kk) * ldw + scol0 + (lane & 31)]; }
    asm volatile("s_waitcnt lgkmcnt(0)" ::: "memory");
    const int c = lane & 7;
#pragma unroll
    for (int j = 0; j < 4; ++j) { const int n = (lane >> 3) + 8 * j; const LAS float* s = scr + (8 * c) * 33 + n;
        u32x4 o; o.x = cvt_pk_bf16(s[0 * 33], s[1 * 33]); o.y = cvt_pk_bf16(s[2 * 33], s[3 * 33]); o.z = cvt_pk_bf16(s[4 * 33], s[5 * 33]); o.w = cvt_pk_bf16(s[6 * 33], s[7 * 33]);
        *(u32x4*)(WT + (size_t)(drow0 + n) * ldt + dk0 + k0 + 8 * c) = o; }
    asm volatile("s_waitcnt lgkmcnt(0)" ::: "memory");
}
template <int UNR = 8>
__device__ __forceinline__ void tr_item8(const float* W, int ldw, int scol0, int k0, unsigned char* WT, int ldt, int drow0, LAS float* scr, int lane) {
#pragma unroll UNR
    for (int i = 0; i < 32; ++i) { const int kk = 2 * i + (lane >> 5); scr[kk * 33 + (lane & 31)] = __builtin_nontemporal_load(&W[(size_t)(k0 + kk) * ldw + scol0 + (lane & 31)]) * W8_SCALE; }
    asm volatile("s_waitcnt lgkmcnt(0)" ::: "memory");
    const int c = lane & 3;
#pragma unroll
    for (int j = 0; j < 2; ++j) { const int n = (lane >> 2) + 16 * j; const LAS float* s = scr + (16 * c) * 33 + n;
        u32x4 o; o.x = pk4_fp8(s[0 * 33], s[1 * 33], s[2 * 33], s[3 * 33]); o.y = pk4_fp8(s[4 * 33], s[5 * 33], s[6 * 33], s[7 * 33]);
        o.z = pk4_fp8(s[8 * 33], s[9 * 33], s[10 * 33], s[11 * 33]); o.w = pk4_fp8(s[12 * 33], s[13 * 33], s[14 * 33], s[15 * 33]);
        *(u32x4*)(WT + (size_t)(drow0 + n) * ldt + k0 + 16 * c) = o; }
    asm volatile("s_waitcnt lgkmcnt(0)" ::: "memory");
}
template <int UNR = 8>
__device__ __forceinline__ void tr_item_gate(const float* W, int scol0, int k0, bf16_t* WT, int ri, int wcn, int kb, LAS float* scr, int lane) {
#pragma unroll UNR
    for (int i = 0; i < 32; ++i) { const int kk = 2 * i + (lane >> 5); scr[kk * 33 + (lane & 31)] = W[(size_t)(k0 + kk) * 128 + scol0 + (lane & 31)]; }
    asm volatile("s_waitcnt lgkmcnt(0)" ::: "memory");
    const int c = lane & 7;
#pragma unroll
    for (int j = 0; j < 4; ++j) { const int n = (lane >> 3) + 8 * j; const LAS float* s = scr + (8 * c) * 33 + n;
        u32x4 o; o.x = cvt_pk_bf16(s[0 * 33], s[1 * 33]); o.y = cvt_pk_bf16(s[2 * 33], s[3 * 33]); o.z = cvt_pk_bf16(s[4 * 33], s[5 * 33]); o.w = cvt_pk_bf16(s[6 * 33], s[7 * 33]);
        const int nbb = (n >> 4) & 1, fr = n & 15, ks = 2 * kb + (c >> 2), fq = c & 3;
        *(u32x4*)(WT + ((size_t)((((wcn * 2 + nbb) * 2 + ri) * 4 + ks) * 64 + fq * 16 + fr)) * 8) = o; }
    asm volatile("s_waitcnt lgkmcnt(0)" ::: "memory");
}
__device__ __forceinline__ int gu_src_col(int nrow, int H) { return ((nrow & 255) >> 7) * H + (nrow >> 8) * 128 + (nrow & 127); }

__device__ __forceinline__ void p0_convert(const Args& a, const Ctx& c) {
    unsigned char* ws = a.ws;
    LAS float* scr = (LAS float*)(c.lds + c.wave * 16384);
    constexpr int I_POOL = 4 * (256 / 64) * (256 / 32);
    constexpr int I_GU = (D / 64) * (2 * DFF / 32);
    constexpr int I_DN = (DFF / 64) * (D / 32);
    constexpr int I_IN = (D / 64) * (2 * DR / 32);
    constexpr int I_GT = 40 * 2 * 4;
    constexpr int I_OUT = (DR / 64) * (D / 32);
    constexpr int NITEMS = I_POOL + I_GU + I_DN + I_IN + I_GT + I_OUT;
    for (int it = c.gw; it < NITEMS; it += c.NGW) {
        int r = it;
        if (r < I_POOL) { continue; } r -= I_POOL;
        if (r < I_GU) { const int nblk = 2 * DFF / 32, kb = r / nblk, nb = r % nblk;
            tr_item8<32>(a.in[10], 2 * DFF, gu_src_col(32 * nb, DFF), 64 * kb, ws + W_GUT, D, 32 * nb, scr, c.lane); continue; } r -= I_GU;
        if (r < I_DN) { const int nblk = D / 32, kb = r / nblk, nb = r % nblk;
            tr_item8<32>(a.in[11], D, 32 * nb, 64 * kb, ws + W_DT, DFF, 32 * nb, scr, c.lane); continue; } r -= I_DN;
        if (r < I_IN) { const int nblk = 2 * DR / 32, kb = r / nblk, nb = r % nblk;
            tr_item<32>(a.in[12], 2 * DR, 32 * nb, 64 * kb, (bf16_t*)(ws + W_INT), D, 32 * nb, 0, scr, c.lane); continue; } r -= I_IN;
        if (r < I_GT) { const int mat = r / 8, q = r % 8, kb = q / 4, nb = q % 4; const int which = mat / 20, dh = mat % 20, dir = dh / 10, head = dh % 10;
            const float* W = (which ? a.in[17] : a.in[15]) + (size_t)(dir * 10 + head) * 16384;
            tr_item_gate<32>(W, 32 * nb, 64 * kb, (bf16_t*)(ws + W_GT) + (size_t)(head * 2 + dir) * 32768, which, nb, kb, scr, c.lane); continue; } r -= I_GT;
        if (r < I_OUT) { const int nblk = D / 32, kb = r / nblk, nb = r % nblk;
            tr_item<32>(a.in[20], D, 32 * nb, 64 * kb, (bf16_t*)(ws + W_OUTT), DR, 32 * nb, 0, scr, c.lane); continue; } r -= I_OUT;
        { (void)r; }
    }
    for (int i = c.gw * 64 + c.lane; i < 8 * 8 * 8 * 64; i += c.NGW * 64) { const int ln = i & 63, nb = (i >> 6) & 7, ks = (i >> 9) & 7, w = i >> 12, ii = ln & 15, fqq = ln >> 4, g = w >> 1;
        const int col = 128 * w + 32 * (nb >> 1) + 8 * (ii >> 2) + 4 * (nb & 1) + (ii & 3), dd = col - 256 * g, k = 32 * ks + 8 * fqq;
        const float* src = a.in[8] + (size_t)g * 65536 + (size_t)k * 256 + dd;
        u32x4 o; o.x = cvt_pk_bf16(src[0], src[256]); o.y = cvt_pk_bf16(src[512], src[768]); o.z = cvt_pk_bf16(src[1024], src[1280]); o.w = cvt_pk_bf16(src[1536], src[1792]);
        *(u32x4*)((bf16_t*)(ws + W_POOLT) + (size_t)i * 8) = o; }
    for (int i = c.gw * 64 + c.lane; i < 2 * DR; i += c.NGW * 64) ((float*)(ws + WS_SP))[i] = -8.0f * log1pf(__expf(-a.in[19][i]));
}

__device__ __forceinline__ void moe_convert_queue(const Args& a, const Ctx& c, int max_grabs, int GRAB = 64, bool allow_a = true, bool allow_b = true) {
    constexpr int I_MGU1 = (D / 64) * (2 * DE / 32);
    constexpr int I_MDN1 = (DE / 64) * (D / 32);
    constexpr int NA = NE * I_MGU1, NB_ = NE * I_MDN1;
    unsigned char* ws = a.ws;
    LAS float* scr = (LAS float*)(c.lds + c.wave * 16384);
    LAS int* slot = (LAS int*)(c.lds + 131072);
    unsigned* ctrA = (unsigned*)(ws + WS_CTL) + 20 * 64; unsigned* ctrB = (unsigned*)(ws + WS_CTL) + 21 * 64;
    bool a_left = allow_a;
    for (int gi = 0; gi < max_grabs; ++gi) {
        __syncthreads();
        if (c.tid == 0) { int q = -1, base = 0;
            if (a_left) { base = (int)atomicAdd(ctrA, (unsigned)GRAB); if (base < NA) q = 0; }
            if (q < 0 && allow_b) { base = (int)atomicAdd(ctrB, (unsigned)GRAB); if (base < NB_) q = 1; }
            slot[0] = q; slot[1] = base; }
        __syncthreads();
        const int q = slot[0], base = slot[1];
        if (q < 0) break;
        if (q == 1) a_left = false;
#pragma unroll 1
        for (int k = 0; k < GRAB / NWAVES; ++k) { const int r = base + k * NWAVES + c.wave;
            if (q == 0) { if (r >= NA) break; const int e = r / I_MGU1, qq = r % I_MGU1, nblk = 2 * DE / 32, kb = qq / nblk, nb = qq % nblk;
                tr_item8<32>(a.in[22] + (size_t)e * D * 2 * DE, 2 * DE, gu_src_col(32 * nb, DE), 64 * kb, ws + W_MGUT + (size_t)e * 2 * DE * D, D, 32 * nb, scr, c.lane); }
            else { if (r >= NB_) break; const int e = r / I_MDN1, qq = r % I_MDN1, nblk = D / 32, kb = qq / nblk, nb = qq % nblk;
                tr_item8<32>(a.in[23] + (size_t)e * DE * D, D, 32 * nb, 64 * kb, ws + W_MDT + (size_t)e * D * DE, DE, 32 * nb, scr, c.lane); } }
    }
}

__device__ __forceinline__ void p0_adaln(const Args& a, const Ctx& c) {
    if ((int)blockIdx.x >= 192) return;
    const int layer = blockIdx.x / 96, col0 = (blockIdx.x % 96) * 64;
    LAS float* s = (LAS float*)c.lds;
    LAS float* red = (LAS float*)(c.lds + 17 * 1024 * 4);
    for (int i = c.tid; i < 17 * 1024; i += NTHREADS) { const int b = i >> 10, k = i & 1023; const float v = b < NB ? a.in[1][b * D + k] : a.in[3][k]; s[i] = v / (1.0f + __expf(-v)); }
    __syncthreads();
    const int ks = c.lane >> 4, cq = c.lane & 15;
    const float* W = a.in[4] + (size_t)layer * D * 6 * D + col0 + 4 * cq;
    f32x4 acc[17];
#pragma unroll
    for (int b = 0; b < 17; ++b) acc[b] = (f32x4){0.f, 0.f, 0.f, 0.f};
    const int k0 = c.wave * 128 + ks;
#pragma unroll 8
    for (int kk = 0; kk < 32; ++kk) { const int k = k0 + 4 * kk; const f32x4 w = *(const f32x4*)(W + (size_t)k * 6 * D);
#pragma unroll
        for (int b = 0; b < 17; ++b) acc[b] += w * s[b * 1024 + k]; }
#pragma unroll
    for (int b = 0; b < 17; ++b) {
#pragma unroll
        for (int j = 0; j < 4; ++j) { float v = acc[b][j]; v += __shfl_xor(v, 16); v += __shfl_xor(v, 32); acc[b][j] = v; }
        if (ks == 0) *(LAS f32x4*)(red + (c.wave * 17 + b) * 64 + 4 * cq) = acc[b]; }
    __syncthreads();
    float* mod = (float*)(a.ws + WS_MOD) + (size_t)layer * 17 * 6144;
    for (int i = c.tid; i < 17 * 64; i += NTHREADS) { const int b = i >> 6, l = i & 63; float v = a.in[5][layer * 6 * D + col0 + l];
#pragma unroll
        for (int w = 0; w < 8; ++w) v += red[(w * 17 + b) * 64 + l];
        mod[b * 6144 + col0 + l] = v; }
    __syncthreads();
}

constexpr int PL_PITCH = 2064;
constexpr int PL_RS = 64 * PL_PITCH, PL_SS = PL_RS + 512;
template <int W>
__device__ __forceinline__ void pool_cols(int roff, int nrows, int t0, int L, int ntok, float g0, float g1, LAS unsigned char* lds, int col) {
    float r0[16], r1[16]; float S0 = 0.f, S1 = 0.f;
#pragma unroll
    for (int i = 0; i < 16; ++i) { r0[i] = 0.f; r1[i] = 0.f; }
    LAS unsigned char* pd = lds + col * 2 - (W / 2 - 1 + 8) * PL_PITCH;
#pragma unroll 1
    for (int so = 0; so < ntok + 16; so += 16) {
#pragma unroll
        for (int i = 0; i < 16; ++i) { const int s = so + i;
            const int r = s - roff; const bool ok = r >= 0 && r < nrows; const int rc = min(max(r, 0), nrows - 1);
            const unsigned hv = *(const LAS unsigned*)(lds + rc * PL_PITCH + col * 2);
            const float v0 = ok ? bf_lo(hv) : 0.f, v1 = ok ? bf_hi(hv) : 0.f;
            r0[i] = v0; r1[i] = v1; S0 += v0; S1 += v1;
            const int p = s - W / 2 + 1;
            if (p >= 8 && p < 8 + ntok) { const int tp = t0 - 8 + p; const int lo = max(tp - W / 2, 0), hi = min(tp - W / 2 + W, L); const float inv = __builtin_amdgcn_rcpf((float)(hi - lo));
                *(LAS unsigned*)pd = cvt_pk_bf16((S0 * inv - r0[(i - W / 2 + 1) & 15]) * g0, (S1 * inv - r1[(i - W / 2 + 1) & 15]) * g1); }
            pd += PL_PITCH;
            if (s - W + 1 >= 0) { S0 -= r0[(i - W + 1) & 15]; S1 -= r1[(i - W + 1) & 15]; } }
    }
}
__device__ __forceinline__ void pool_fused(const Args& a, const Ctx& c) {
    LAS unsigned char* lds = c.lds;
    LAS float* rs = (LAS float*)(lds + PL_RS); LAS float* rowss = (LAS float*)(lds + PL_SS);
    const float* g1n = a.in[6]; const float* g2n = a.in[7]; const float* pscale = a.in[9];
    const float* mod0 = (const float*)(a.ws + WS_MOD);
    const bf16_t* PW = (const bf16_t*)(a.ws + W_POOLT);
    unsigned char* H2 = a.ws + R_HB;
    const int tid = c.tid, lane = c.lane, w = c.wave, g = w >> 1;
    SUBDECL;
    const int ntile = 512 + NZ / 16, nk = (int)blockIdx.x < ntile ? (ntile - 1 - (int)blockIdx.x) / c.G + 1 : 0; const bool flip = ((blockIdx.x >> 3) & 1) != 0;
#define PL_TILE(tile_, isx_, L_, t0_, seq_) const bool isx_ = (tile_) < 512; const int L_ = isx_ ? 64 : 256; const int t0_ = isx_ ? 0 : (((tile_) - 512) & 15) * 16; \
        const float* seq_ = isx_ ? a.in[0] + (size_t)(tile_) * 64 * D : a.in[2] + (size_t)(((tile_) - 512) >> 4) * CL * D
#define PL_LOAD(V, isx_, L_, t0_, seq_, rb_) do { const int roff_ = (isx_) ? 8 : 0, nrows_ = (isx_) ? 64 : 32; \
        _Pragma("unroll") for (int q = 0; q < 4; ++q) { const int r = (rb_) + q * NWAVES, t = (t0_) - 8 + r + roff_; const bool ok = r < nrows_ && t >= 0 && t < (L_); \
            const f32x4* xr = (const f32x4*)((seq_) + (size_t)min(max(t, 0), (L_) - 1) * D) + lane; \
            _Pragma("unroll") for (int j = 0; j < 4; ++j) { const f32x4 ld = xr[64 * j]; V[q][j] = ok ? ld : (f32x4){0.f, 0.f, 0.f, 0.f}; } } } while (0)
#define PL_PROC(V, nrows_, rb_) do { _Pragma("unroll") for (int q = 0; q < 4; ++q) { const int r = (rb_) + q * NWAVES; float ss = 0.f; \
            _Pragma("unroll") for (int j = 0; j < 4; ++j) ss += (V[q][j].x * V[q][j].x + V[q][j].y * V[q][j].y) + (V[q][j].z * V[q][j].z + V[q][j].w * V[q][j].w); \
            const float rstd = rsqrtf(wave_sum(ss) * (1.0f / D) + EPS); \
            if (r < (nrows_)) { _Pragma("unroll") for (int j = 0; j < 4; ++j) { const f32x4 h = V[q][j] * rstd; u32x2 o; o.x = cvt_pk_bf16(h.x, h.y); o.y = cvt_pk_bf16(h.z, h.w); \
                *(LAS u32x2*)(lds + r * PL_PITCH + 8 * (lane + 64 * j)) = o; } } } } while (0)
    f32x4 vp[4][4];
    if (nk > 0) { const int tile0 = blockIdx.x + (flip ? nk - 1 : 0) * c.G; PL_TILE(tile0, isx0, L0, t00, seq0); PL_LOAD(vp, isx0, L0, t00, seq0, w); }
    for (int k = 0; k < nk; ++k) { const int kk = flip ? (k == 0 ? nk - 1 : k - 1) : k; const int tile = blockIdx.x + kk * c.G;
        int fr = lane & 15, fq = lane >> 4; asm volatile("" : "+v"(fr), "+v"(fq));
        const bool isx = tile < 512; const int L = isx ? 64 : 256, ntok = isx ? 64 : 16, nm = ntok >> 4;
        const int t0 = isx ? 0 : ((tile - 512) & 15) * 16;
        const float* seq = isx ? a.in[0] + (size_t)tile * 64 * D : a.in[2] + (size_t)((tile - 512) >> 4) * CL * D;
        const int b = isx ? (tile >> 5) : NB;
        const size_t orow0 = isx ? (size_t)tile * 64 : (size_t)NX + (size_t)((tile - 512) >> 4) * CL + t0;
        const float* mb = mod0 + (size_t)b * 6144;
        bf16_t* outp = (bf16_t*)(a.ws + WS_XB) + orow0 * D;
        __syncthreads();
        SUBT0(1);
        const int roff = isx ? 8 : 0, nrows = isx ? 64 : 32;
        PL_PROC(vp, nrows, w);
        if (nrows > 4 * NWAVES) { f32x4 v2[4][4]; PL_LOAD(v2, isx, L, t0, seq, w + 4 * NWAVES); PL_PROC(v2, nrows, w + 4 * NWAVES); }
        __syncthreads();
        { const int col = 2 * tid;
          const f32x2 gg = *(const f32x2*)(g1n + col), sc = *(const f32x2*)(mb + 1024 + col);
          const float ga = gg.x * (1.0f + sc.x), gb = gg.y * (1.0f + sc.y);
          const int grp = __builtin_amdgcn_readfirstlane(col >> 8);
          if (grp == 0) pool_cols<2>(roff, nrows, t0, L, ntok, ga, gb, lds, col);
          else if (grp == 1) pool_cols<4>(roff, nrows, t0, L, ntok, ga, gb, lds, col);
          else if (grp == 2) pool_cols<8>(roff, nrows, t0, L, ntok, ga, gb, lds, col);
          else pool_cols<16>(roff, nrows, t0, L, ntok, ga, gb, lds, col); }
        __syncthreads();
        SUBT1(2); SUBT0(3);
        float ssq[4] = {0.f, 0.f, 0.f, 0.f};
#pragma unroll 1
        for (int half = 0; half < 2; ++half) {
            f32x4 acc[4][4];
#pragma unroll
            for (int m = 0; m < 4; ++m)
#pragma unroll
                for (int nb = 0; nb < 4; ++nb) acc[m][nb] = (f32x4){0.f, 0.f, 0.f, 0.f};
            f32x4 xq[4][2];
            { const int col0 = 128 * w + 32 * (2 * half) + 8 * fq;
#pragma unroll
              for (int m = 0; m < 4; ++m) if (m < nm) { const float* xp = seq + (size_t)(t0 + 16 * m + fr) * D + col0; xq[m][0] = *(const f32x4*)xp; xq[m][1] = *(const f32x4*)(xp + 4); } }
            { const bf16_t* pw = PW + (size_t)w * 8 * 8 * 512 + (size_t)half * 4 * 512 + lane * 8;
              bf16x8 bb[3][4];
#pragma unroll
              for (int nb = 0; nb < 4; ++nb) { bb[0][nb] = *(const bf16x8*)(pw + nb * 512); bb[1][nb] = *(const bf16x8*)(pw + (8 + nb) * 512); }
#pragma unroll
              for (int ks = 0; ks < 8; ++ks) {
                  if (ks + 2 < 8) {
#pragma unroll
                      for (int nb = 0; nb < 4; ++nb) bb[(ks + 2) % 3][nb] = *(const bf16x8*)(pw + ((ks + 2) * 8 + nb) * 512); }
                  { const int sw = (32 * g + 4 * ks + fq) << 4; bf16x8 af[4];
#pragma unroll
                    for (int m = 0; m < 4; ++m) if (m < nm) af[m] = *(const LAS bf16x8*)(lds + (16 * m + fr) * PL_PITCH + sw);
#pragma unroll
                    for (int m = 0; m < 4; ++m) if (m < nm)
#pragma unroll
                        for (int nb = 0; nb < 4; ++nb) acc[m][nb] = __builtin_amdgcn_mfma_f32_16x16x32_bf16(bb[ks % 3][nb], af[m], acc[m][nb], 0, 0, 0); }
                  __builtin_amdgcn_sched_barrier(0); } }
#pragma unroll
            for (int pp = 0; pp < 2; ++pp) { const int col0 = 128 * w + 32 * (2 * half + pp) + 8 * fq;
                const f32x4 ga0 = *(const f32x4*)(mb + 2048 + col0) * *(const f32x4*)(pscale + col0), ga1 = *(const f32x4*)(mb + 2048 + col0 + 4) * *(const f32x4*)(pscale + col0 + 4);
#pragma unroll
                for (int m = 0; m < 4; ++m) if (m < nm) { const int tok = 16 * m + fr;
                    f32x4 x0, x1; if (pp == 0) { x0 = xq[m][0]; x1 = xq[m][1]; } else { x0 = *(const f32x4*)(seq + (size_t)(t0 + tok) * D + col0); x1 = *(const f32x4*)(seq + (size_t)(t0 + tok) * D + col0 + 4); }
                    const f32x4 o0 = x0 + ga0 * acc[m][2 * pp], o1 = x1 + ga1 * acc[m][2 * pp + 1];
                    { u32x4 ob; ob.x = cvt_pk_bf16(o0.x, o0.y); ob.y = cvt_pk_bf16(o0.z, o0.w); ob.z = cvt_pk_bf16(o1.x, o1.y); ob.w = cvt_pk_bf16(o1.z, o1.w); *(u32x4*)(outp + (size_t)tok * D + col0) = ob; }
                    ssq[m] += (o0.x * o0.x + o0.y * o0.y) + (o0.z * o0.z + o0.w * o0.w) + (o1.x * o1.x + o1.y * o1.y) + (o1.z * o1.z + o1.w * o1.w); } }
        }
#pragma unroll
        for (int m = 0; m < 4; ++m) if (m < nm) { float v = ssq[m]; v += __shfl_xor(v, 16); v += __shfl_xor(v, 32); if (fq == 0) rowss[w * 64 + 16 * m + fr] = v; }
        __syncthreads();
        SUBT1(3); SUBT0(4);
        if (k + 1 < nk) { const int kn = flip ? k : k + 1; const int tilen = blockIdx.x + kn * c.G; PL_TILE(tilen, isxn, Ln, t0n, seqn); PL_LOAD(vp, isxn, Ln, t0n, seqn, w); }
        else {
#pragma unroll
            for (int q = 0; q < 4; ++q)
#pragma unroll
                for (int j = 0; j < 4; ++j) vp[q][j] = (f32x4){0.f, 0.f, 0.f, 0.f}; }
        float rstd2[4];
#pragma unroll
        for (int m = 0; m < 4; ++m) { float t = 1.f;
            if (m < nm) { t = 0.f;
#pragma unroll
            for (int ww = 0; ww < 8; ++ww) t += rowss[ww * 64 + 16 * m + fr]; }
            rstd2[m] = rsqrtf(t * (1.0f / D) + EPS); }
#pragma unroll 2
        for (int p = 0; p < 4; ++p) { const int col0 = 128 * w + 32 * p + 8 * fq;
            const f32x4 gm0 = *(const f32x4*)(g2n + col0) * (*(const f32x4*)(mb + 4096 + col0) + 1.0f), gm1 = *(const f32x4*)(g2n + col0 + 4) * (*(const f32x4*)(mb + 4096 + col0 + 4) + 1.0f);
            const f32x4 sh0 = *(const f32x4*)(mb + 3072 + col0), sh1 = *(const f32x4*)(mb + 3072 + col0 + 4);
#pragma unroll
            for (int m = 0; m < 4; ++m) if (m < nm) { const int tok = 16 * m + fr;
                const u32x4 vb = *(const u32x4*)(outp + (size_t)tok * D + col0);
                const f32x4 v0 = (f32x4){bf_lo(vb.x), bf_hi(vb.x), bf_lo(vb.y), bf_hi(vb.y)}, v1 = (f32x4){bf_lo(vb.z), bf_hi(vb.z), bf_lo(vb.w), bf_hi(vb.w)};
                const f32x4 h0 = v0 * rstd2[m] * gm0 + sh0, h1 = v1 * rstd2[m] * gm1 + sh1;
                u32x2 o; o.x = pk4_fp8(h0.x, h0.y, h0.z, h0.w); o.y = pk4_fp8(h1.x, h1.y, h1.z, h1.w);
                *(u32x2*)(H2 + (orow0 + tok) * D + col0) = o; } }
        SUBT1(4);
    }
    SUBSPIN;
#undef PL_TILE
#undef PL_LOAD
#undef PL_PROC
}

__device__ __forceinline__ void norm_mod_rows(const bf16_t* XBp, int nrows, const float* gvec, const float* modl, int sh_off, int sc_off, bf16_t* out, const Ctx& c) {
    const int RPW = ((nrows + c.NGW - 1) / c.NGW + 1) & ~1, rbeg = c.gw * RPW, rend = min(nrows, rbeg + RPW);
    f32x4 gm[4], shv[4]; int bcur = -1;
    for (int row0 = rbeg; row0 < rend; row0 += 2) {
        f32x4 v[2][4]; float ss[2];
#pragma unroll
        for (int r = 0; r < 2; ++r) { const int row = row0 + r;
            const u32x2* xr = (const u32x2*)(XBp + (size_t)row * D) + c.lane; ss[r] = 0.f; u32x2 t[4];
#pragma unroll
            for (int j = 0; j < 4; ++j) t[j] = xr[64 * j];
#pragma unroll
            for (int j = 0; j < 4; ++j) v[r][j] = (f32x4){bf_lo(t[j].x), bf_hi(t[j].x), bf_lo(t[j].y), bf_hi(t[j].y)}; }
        const int b = row0 < NX ? row0 / SEQ : NB;
        if (b != bcur) { bcur = b; const float* mb = modl + (size_t)b * 6144;
#pragma unroll
            for (int j = 0; j < 4; ++j) { const int col = 4 * (c.lane + 64 * j); gm[j] = *(const f32x4*)(gvec + col) * (*(const f32x4*)(mb + sc_off + col) + 1.0f); shv[j] = *(const f32x4*)(mb + sh_off + col); } }
#pragma unroll
        for (int r = 0; r < 2; ++r)
#pragma unroll
            for (int j = 0; j < 4; ++j) ss[r] += (v[r][j].x * v[r][j].x + v[r][j].y * v[r][j].y) + (v[r][j].z * v[r][j].z + v[r][j].w * v[r][j].w);
#pragma unroll
        for (int r = 0; r < 2; ++r) { const int row = row0 + r;
            const float rstd = rsqrtf(wave_sum(ss[r]) * (1.0f / D) + EPS);
#pragma unroll
            for (int j = 0; j < 4; ++j) { const int col = 4 * (c.lane + 64 * j);
                const f32x4 h = v[r][j] * rstd * gm[j] + shv[j];
                u32x2 w; w.x = cvt_pk_bf16(h.x, h.y); w.y = cvt_pk_bf16(h.z, h.w);
                *(u32x2*)(out + (size_t)row * D + col) = w; } }
    }
}

constexpr int LRU_NCK = 288;
constexpr int L_A = 0, L_LAB = 32768, L_B = 32768, L_HF = 100352, L_SEG = 133120, L_CARRY = 141312;
constexpr int LAB_PITCH = 528;
constexpr int LRU_NHC = 2 * LRU_NCK;
constexpr int P1_WOFF = 65536, P1_WLDS = 9728, P1_PITCH = 144;
__device__ __forceinline__ void lru_pass1(const Args& a, const Ctx& c) {
    const bf16_t* GU2 = (const bf16_t*)(a.ws + R_GU2); const bf16_t* GT3 = (const bf16_t*)(a.ws + W_GT);
    float* CAg = (float*)(a.ws + R_CHUNK); float* CBg = CAg + (size_t)2 * LRU_NHC * DR;
    const float* SP = (const float*)(a.ws + WS_SP);
    const float* cw = a.in[13]; const float* cb = a.in[14];
    LAS unsigned char* lds = c.lds;
    const int tid = c.tid, lane = c.lane, wid = c.wave, wr = wid >> 2, wc = wid & 3, fr = lane & 15, fq = lane >> 4;
    LAS unsigned char* wl = lds + P1_WOFF + wid * P1_WLDS;
    const int sg = lane >> 4, cp = lane & 15;
    const int nunits = LRU_NCK * 10;
    const int tq = tid >> 4, c8 = tid & 15;
    u32x4 uw[7]; bf16x8 bq[2][2][4];
#define P1_ROW(t_) ((t_) * P1_PITCH + ((t_) >> 4) * 128)
#define LRU_LOAD_U(L_) do { const int head_ = (L_) % 10, ck_ = (L_) / 10; const bool isx_ = ck_ < 256; const int jj_ = isx_ ? (ck_ & 15) : ((ck_ - 256) & 1); \
        const int Ls_ = isx_ ? SEQ : CL; const size_t r0_ = isx_ ? (size_t)ck_ * 128 : (size_t)NX + (size_t)(ck_ - 256) * 128; \
        _Pragma("unroll") for (int i = 0; i < 7; ++i) { const int t = jj_ * 128 + 4 * tq + i - 2; const bool ok_ = t >= 0 && t < Ls_; const int tc_ = min(max(t, 0), Ls_ - 1); \
            const u32x4 ld_ = *(const u32x4*)(GU2 + (r0_ - jj_ * 128 + tc_) * (size_t)(2 * DR) + DR + head_ * 128 + 8 * c8);     \
            uw[i].x = ok_ ? ld_.x : 0u; uw[i].y = ok_ ? ld_.y : 0u; uw[i].z = ok_ ? ld_.z : 0u; uw[i].w = ok_ ? ld_.w : 0u; } } while (0)
#define LRU_LOAD_B(L_, dir_) do { const bf16_t* src_ = GT3 + ((size_t)(((L_) % 10) * 2 + (dir_)) * 4 + wc) * 8192 + lane * 8; \
        _Pragma("unroll") for (int nb = 0; nb < 2; ++nb) _Pragma("unroll") for (int ri = 0; ri < 2; ++ri) _Pragma("unroll") for (int ks = 0; ks < 4; ++ks) \
            bq[nb][ri][ks] = *(const bf16x8*)(src_ + ((nb * 2 + ri) * 4 + ks) * 512); } while (0)
    if ((int)blockIdx.x < nunits) { LRU_LOAD_U((int)blockIdx.x); }
    int it = 0;
    for (int L = blockIdx.x; L < nunits; L += c.G, ++it) {
        const int head = L % 10, ck = L / 10;
        LAS unsigned char* ab = lds + (it & 1) * 32768;
        const bool isx = ck < 256;
        const bool has_next = L + c.G < nunits;
        LRU_LOAD_B(L, 0);
        { const int ch = head * 128 + 8 * c8;
          float wv[4][8], bv[8];
#pragma unroll
          for (int k = 0; k < 4; ++k) { const f32x4 w0 = *(const f32x4*)(cw + k * DR + ch), w1 = *(const f32x4*)(cw + k * DR + ch + 4);
              wv[k][0] = w0.x; wv[k][1] = w0.y; wv[k][2] = w0.z; wv[k][3] = w0.w; wv[k][4] = w1.x; wv[k][5] = w1.y; wv[k][6] = w1.z; wv[k][7] = w1.w; }
          { const f32x4 b0 = *(const f32x4*)(cb + ch), b1 = *(const f32x4*)(cb + ch + 4); bv[0] = b0.x; bv[1] = b0.y; bv[2] = b0.z; bv[3] = b0.w; bv[4] = b1.x; bv[5] = b1.y; bv[6] = b1.z; bv[7] = b1.w; }
#pragma unroll
          for (int o = 0; o < 4; ++o) { float acc[8];
#pragma unroll
              for (int j = 0; j < 8; ++j) acc[j] = bv[j];
#pragma unroll
              for (int k = 0; k < 4; ++k) { const u32x4 u = uw[o + k];
                  acc[0] += wv[k][0] * bf_lo(u.x); acc[1] += wv[k][1] * bf_hi(u.x); acc[2] += wv[k][2] * bf_lo(u.y); acc[3] += wv[k][3] * bf_hi(u.y);
                  acc[4] += wv[k][4] * bf_lo(u.z); acc[5] += wv[k][5] * bf_hi(u.z); acc[6] += wv[k][6] * bf_lo(u.w); acc[7] += wv[k][7] * bf_hi(u.w); }
              u32x4 w; w.x = cvt_pk_bf16(acc[0], acc[1]); w.y = cvt_pk_bf16(acc[2], acc[3]); w.z = cvt_pk_bf16(acc[4], acc[5]); w.w = cvt_pk_bf16(acc[6], acc[7]);
              const int tok = 4 * tq + o;
              *(LAS u32x4*)(ab + tok * 256 + ((c8 ^ (tok & 15)) << 4)) = w; } }
        __syncthreads();
#pragma unroll
        for (int dir = 0; dir < 2; ++dir) {
            f32x4 brv[2], biv[2], spv[2];
#pragma unroll
            for (int nb = 0; nb < 2; ++nb) { const int ch = dir * DR + head * 128 + 32 * wc + 16 * nb + 4 * fq;
                brv[nb] = *(const f32x4*)(a.in[16] + ch); biv[nb] = *(const f32x4*)(a.in[18] + ch); spv[nb] = *(const f32x4*)(SP + ch); }
            f32x4 acc[4][2][2];
#pragma unroll
            for (int m = 0; m < 4; ++m)
#pragma unroll
                for (int nb = 0; nb < 2; ++nb)
#pragma unroll
                    for (int ri = 0; ri < 2; ++ri) acc[m][nb][ri] = (f32x4){0.f, 0.f, 0.f, 0.f};
#pragma unroll
            for (int ks = 0; ks < 4; ++ks) { const int sw = ((ks * 4 + fq) ^ fr) << 4;
                bf16x8 af[4];
#pragma unroll
                for (int m = 0; m < 4; ++m) af[m] = *(const LAS bf16x8*)(ab + (64 * wr + 16 * m + fr) * 256 + sw);
#pragma unroll
                for (int m = 0; m < 4; ++m)
#pragma unroll
                    for (int nb = 0; nb < 2; ++nb)
#pragma unroll
                        for (int ri = 0; ri < 2; ++ri) acc[m][nb][ri] = __builtin_amdgcn_mfma_f32_16x16x32_bf16(bq[nb][ri][ks], af[m], acc[m][nb][ri], 0, 0, 0); }
            if (dir == 0) { LRU_LOAD_B(L, 1); }
#pragma unroll
            for (int nb = 0; nb < 2; ++nb) { const int chl = 32 * wc + 16 * nb + 4 * fq;
#pragma unroll
                for (int m = 0; m < 4; ++m) { const int tok = 64 * wr + 16 * m + fr, tl = 16 * m + fr;
                    const u32x2 uq = *(const LAS u32x2*)(ab + tok * 256 + (((chl >> 3) ^ (tok & 15)) << 4) + (chl & 7) * 2);
                    const float uv[4] = {bf_lo(uq.x), bf_hi(uq.x), bf_lo(uq.y), bf_hi(uq.y)};
                    u32x4 w;
#pragma unroll
                    for (int jp = 0; jp < 2; ++jp) {
                        const f32x2 pr = (f32x2){acc[m][nb][0][2 * jp], acc[m][nb][0][2 * jp + 1]} + (f32x2){brv[nb][2 * jp], brv[nb][2 * jp + 1]};
                        const f32x2 pi = (f32x2){acc[m][nb][1][2 * jp], acc[m][nb][1][2 * jp + 1]} + (f32x2){biv[nb][2 * jp], biv[nb][2 * jp + 1]};
                        const f32x2 ar = pr * -1.44269504089f, ai = pi * -1.44269504089f;
                        f32x2 er, ei; er.x = __builtin_amdgcn_exp2f(ar.x); er.y = __builtin_amdgcn_exp2f(ar.y); ei.x = __builtin_amdgcn_exp2f(ai.x); ei.y = __builtin_amdgcn_exp2f(ai.y);
                        er = er + 1.0f; ei = ei + 1.0f;
                        const f32x2 den = er * ei; f32x2 R; R.x = __builtin_amdgcn_rcpf(den.x); R.y = __builtin_amdgcn_rcpf(den.y);
                        const f32x2 r = ei * R, ig = er * R;
                        const f32x2 l = r * (f32x2){spv[nb][2 * jp], spv[nb][2 * jp + 1]}, y = l * 2.0f;
                        f32x2 em = (y * (1.0f / 24.0f) + (1.0f / 6.0f)); em = em * y + 0.5f; em = em * y + 1.0f; em = em * (y * -1.0f);
                        if (__builtin_expect(y.x <= -0.3f || y.y <= -0.3f, 0)) { em.x = 1.0f - fast_exp(y.x); em.y = 1.0f - fast_exp(y.y); }
                        f32x2 sq; sq.x = __builtin_amdgcn_sqrtf(em.x); sq.y = __builtin_amdgcn_sqrtf(em.y);
                        const f32x2 bb = sq * ig * (f32x2){uv[2 * jp], uv[2 * jp + 1]};
                        w[2 * jp] = cvt_pk_bf16(l.x, bb.x); w[2 * jp + 1] = cvt_pk_bf16(l.y, bb.y); }
                    *(LAS u32x4*)(wl + P1_ROW(tl) + (16 * nb + 4 * fq) * 4) = w; } }
            if (dir == 1 && has_next) { LRU_LOAD_U(L + c.G); }
            { float s0 = 0.f, s1 = 0.f, h0 = 0.f, h1 = 0.f;
#pragma unroll
              for (int i = 0; i < 16; ++i) { const int t = 16 * sg + (dir ? 15 - i : i);
                  const u32x2 e = *(const LAS u32x2*)(wl + P1_ROW(t) + cp * 8);
                  const float l0 = bf_lo(e.x), l1 = bf_lo(e.y); s0 += l0; s1 += l1;
                  h0 = fast_exp(l0) * h0 + bf_hi(e.x); h1 = fast_exp(l1) * h1 + bf_hi(e.y); }
              const float A0 = fast_exp(s0), A1 = fast_exp(s1);
              float c0 = 0.f, c1 = 0.f, T0 = 1.f, T1 = 1.f;
#pragma unroll
              for (int k = 0; k < 4; ++k) { const int s_ = dir ? 3 - k : k;
                  const float a0 = __shfl(A0, s_ * 16 + cp), a1 = __shfl(A1, s_ * 16 + cp), b0 = __shfl(h0, s_ * 16 + cp), b1 = __shfl(h1, s_ * 16 + cp);
                  c0 = a0 * c0 + b0; c1 = a1 * c1 + b1; T0 *= a0; T1 *= a1; }
              if (sg == 0) { const size_t o = ((size_t)dir * LRU_NHC + 2 * ck + wr) * DR + head * 128 + 32 * wc + 2 * cp;
                  *(f32x2*)(CAg + o) = (f32x2){T0, T1}; *(f32x2*)(CBg + o) = (f32x2){c0, c1}; } }
            if (isx) { unsigned char* dstg = a.ws + R_LABG + ((size_t)(ck * 10 + head) * 2 + dir) * 65536 + (size_t)wc * 16384 + (size_t)(64 * wr) * 128;
#pragma unroll
                for (int i = 0; i < 8; ++i) { const int p = lane + 64 * i, tl = p >> 3;
                    __builtin_nontemporal_store(*(const LAS u32x4*)(wl + P1_ROW(tl) + (p & 7) * 16), (u32x4*)(dstg + (size_t)p * 16)); } }
        }
    }
#undef P1_ROW
#undef LRU_LOAD_U
#undef LRU_LOAD_B
}

constexpr int S2_WLDS = 17408;
__device__ __forceinline__ void lru_scan2(const Args& a, const Ctx& c) {
    const bf16_t* GU2 = (const bf16_t*)(a.ws + R_GU2);
    const float* CAg = (const float*)(a.ws + R_CHUNK); const float* CBg = CAg + (size_t)2 * LRU_NHC * DR;
    bf16_t* Yg = (bf16_t*)(a.ws + R_Y);
    LAS unsigned char* wl = c.lds + c.wave * S2_WLDS;
    const int lane = c.lane, sg = lane >> 4, cp = lane & 15;
    const int nitems = 256 * 10 * 4;
    u32x4 lab[16];
#define S2_ROW(t_) ((t_) * 128 + ((t_) >> 5) * 128)
#define S2_LOAD(U_, dir_) do { const unsigned char* src_ = a.ws + R_LABG + ((size_t)((U_) >> 2) * 2 + (dir_)) * 65536 + (size_t)((U_) & 3) * 16384; \
        _Pragma("unroll") for (int i = 0; i < 16; ++i) lab[i] = __builtin_nontemporal_load((const u32x4*)(src_ + (size_t)(lane + 64 * i) * 16)); } while (0)
#define S2_PUT() do { _Pragma("unroll") for (int i = 0; i < 16; ++i) { const int p = lane + 64 * i, tok = p >> 3; *(LAS u32x4*)(wl + S2_ROW(tok) + (p & 7) * 16) = lab[i]; } } while (0)
    if (c.gw < nitems) { S2_LOAD(c.gw, 0); }
    for (int U = c.gw; U < nitems; U += c.NGW) {
        const int q = U & 3, L = U >> 2, head = L % 10, ck = L / 10, bb_ = ck >> 4, jj = ck & 15;
        const size_t r0 = (size_t)ck * 128;
        const int chb = head * 128 + q * 32 + 2 * cp;
        const bool has_next = U + c.NGW < nitems;
        f32x2 car[2];
#pragma unroll
        for (int dir = 0; dir < 2; ++dir) { const int n = dir == 0 ? 4 + 2 * jj : 4 + (30 - 2 * jj); const size_t cbase = (size_t)dir * LRU_NHC * DR + chb;
            f32x2 Ac = (f32x2){1.f, 1.f}, Bc = (f32x2){0.f, 0.f};
#pragma unroll
            for (int kk = 0; kk < 9; ++kk) { const int k = 9 * sg + kk; int idx; if (dir == 0) idx = k < 4 ? 512 + 4 * bb_ + k : 32 * bb_ + k - 4; else idx = k < 4 ? 512 + 4 * bb_ + 3 - k : 32 * bb_ + 31 - (k - 4);
                f32x2 Av = (f32x2){1.f, 1.f}, Bv = (f32x2){0.f, 0.f};
                if (k < n) { Av = *(const f32x2*)(CAg + cbase + (size_t)idx * DR); Bv = *(const f32x2*)(CBg + cbase + (size_t)idx * DR); }
                Bc = Av * Bc + Bv; Ac = Ac * Av; }
            f32x2 cc = (f32x2){0.f, 0.f};
#pragma unroll
            for (int s_ = 0; s_ < 4; ++s_) { f32x2 As, Bs; As.x = __shfl(Ac.x, s_ * 16 + cp); As.y = __shfl(Ac.y, s_ * 16 + cp); Bs.x = __shfl(Bc.x, s_ * 16 + cp); Bs.y = __shfl(Bc.y, s_ * 16 + cp);
                cc = As * cc + Bs; }
            car[dir] = cc;
            asm volatile("" ::: "memory"); }
        unsigned hf[32];
        S2_PUT();
        S2_LOAD(U, 1);
        { float s0 = 0.f, s1 = 0.f, h0 = 0.f, h1 = 0.f;
#pragma unroll
          for (int i = 0; i < 32; ++i) { const int t = 32 * sg + i; const u32x2 e = *(const LAS u32x2*)(wl + S2_ROW(t) + cp * 8);
              const float l0 = bf_lo(e.x), l1 = bf_lo(e.y); s0 += l0; s1 += l1; h0 = fast_exp(l0) * h0 + bf_hi(e.x); h1 = fast_exp(l1) * h1 + bf_hi(e.y); }
          const float A0 = fast_exp(s0), A1 = fast_exp(s1); float c0 = car[0].x, c1 = car[0].y;
#pragma unroll
          for (int s_ = 0; s_ < 3; ++s_) { const float a0 = __shfl(A0, s_ * 16 + cp), a1 = __shfl(A1, s_ * 16 + cp), b0 = __shfl(h0, s_ * 16 + cp), b1 = __shfl(h1, s_ * 16 + cp);
              if (s_ < sg) { c0 = a0 * c0 + b0; c1 = a1 * c1 + b1; } }
          h0 = c0; h1 = c1;
#pragma unroll
          for (int i = 0; i < 32; ++i) { const int t = 32 * sg + i; const u32x2 e = *(const LAS u32x2*)(wl + S2_ROW(t) + cp * 8);
              h0 = fast_exp(bf_lo(e.x)) * h0 + bf_hi(e.x); h1 = fast_exp(bf_lo(e.y)) * h1 + bf_hi(e.y); hf[i] = cvt_pk_bf16(h0, h1); } }
        asm volatile("" ::: "memory");
        unsigned gt[32];
        { const bf16_t* gp = GU2 + (r0 + 32 * sg) * (size_t)(2 * DR) + chb;
#pragma unroll
          for (int i = 0; i < 32; ++i) { asm volatile("" : "+v"(gp)); gt[i] = *(const unsigned*)gp; gp += 2 * DR; } }
        S2_PUT();
        if (has_next) { S2_LOAD(U + c.NGW, 0); }
        { float s0 = 0.f, s1 = 0.f, h0 = 0.f, h1 = 0.f;
#pragma unroll
          for (int i = 0; i < 32; ++i) { const int t = 32 * sg + 31 - i; const u32x2 e = *(const LAS u32x2*)(wl + S2_ROW(t) + cp * 8);
              const float l0 = bf_lo(e.x), l1 = bf_lo(e.y); s0 += l0; s1 += l1; h0 = fast_exp(l0) * h0 + bf_hi(e.x); h1 = fast_exp(l1) * h1 + bf_hi(e.y); }
          const float A0 = fast_exp(s0), A1 = fast_exp(s1); float c0 = car[1].x, c1 = car[1].y;
#pragma unroll
          for (int s_ = 3; s_ > 0; --s_) { const float a0 = __shfl(A0, s_ * 16 + cp), a1 = __shfl(A1, s_ * 16 + cp), b0 = __shfl(h0, s_ * 16 + cp), b1 = __shfl(h1, s_ * 16 + cp);
              if (s_ > sg) { c0 = a0 * c0 + b0; c1 = a1 * c1 + b1; } }
          h0 = c0; h1 = c1;
#pragma unroll
          for (int i = 0; i < 32; ++i) { const int t = 32 * sg + 31 - i; const u32x2 e = *(const LAS u32x2*)(wl + S2_ROW(t) + cp * 8);
              h0 = fast_exp(bf_lo(e.x)) * h0 + bf_hi(e.x); h1 = fast_exp(bf_lo(e.y)) * h1 + bf_hi(e.y);
              const unsigned fw = hf[31 - i], g = gt[31 - i];
              *(LAS unsigned*)(wl + S2_ROW(t) + cp * 4) = cvt_pk_bf16((h0 + bf_lo(fw)) * gelu_tanh(bf_lo(g)), (h1 + bf_hi(fw)) * gelu_tanh(bf_hi(g))); } }
        { bf16_t* yp = Yg + (r0 + (lane >> 2)) * (size_t)DR + head * 128 + q * 32 + (lane & 3) * 8;
#pragma unroll
          for (int i = 0; i < 8; ++i) { const int tok = (lane >> 2) + 16 * i; asm volatile("" : "+v"(yp));
              *(u32x4*)yp = *(const LAS u32x4*)(wl + S2_ROW(tok) + (lane & 3) * 16); yp += 16 * DR; } }
    }
#undef S2_ROW
#undef S2_LOAD
#undef S2_PUT
}

constexpr int RT_RPWMAX = 64;
__device__ __forceinline__ void p12_route(const Args& a, const Ctx& c) {
    LAS unsigned* lcnt = (LAS unsigned*)c.lds;
    if (c.tid < NE) lcnt[c.tid] = 0u;
    __syncthreads();
    const bf16_t* X = (const bf16_t*)(a.ws + WS_XB); const float* gvec = a.in[7] + D; const float* modl = (const float*)(a.ws + WS_MOD) + (size_t)17 * 6144; const float* WR = a.in[21];
    unsigned char* H4 = a.ws + R_H4;
    float* tok_w = (float*)(a.ws + WS_ROUTE + (size_t)NX * 8); int* tok_slot = (int*)(a.ws + WS_ROUTE + (size_t)NX * 16); int* slot_tok = (int*)(a.ws + WS_SLOTTOK);
    LAS unsigned* gbase = lcnt + 8; LAS unsigned* lrank = lcnt + 16;
    f32x4 wa[4][4], wb[4][4];
#pragma unroll
    for (int j = 0; j < 4; ++j)
#pragma unroll
        for (int q = 0; q < 4; ++q) { const int col = 4 * (c.lane + 64 * j) + q; wa[j][q] = *(const f32x4*)(WR + (size_t)col * 8); wb[j][q] = *(const f32x4*)(WR + (size_t)col * 8 + 4); }
    const int RPW = (NX + c.NGW - 1) / c.NGW, rbeg = c.gw * RPW, rend = min(NX, rbeg + RPW);
    u32x2 vnx[4]; f32x4 gm[4], shv[4];
    if (rbeg < NX) { const u32x2* xr = (const u32x2*)(X + (size_t)rbeg * D) + c.lane;
#pragma unroll
        for (int j = 0; j < 4; ++j) vnx[j] = xr[64 * j]; }
    int bcur = -1;
    for (int row = rbeg; row < rend; ++row) {
        const int b = row / SEQ; f32x4 v[4]; float ss = 0.f;
#pragma unroll
        for (int j = 0; j < 4; ++j) v[j] = (f32x4){bf_lo(vnx[j].x), bf_hi(vnx[j].x), bf_lo(vnx[j].y), bf_hi(vnx[j].y)};
        if (row + 1 < rend) { const u32x2* xr = (const u32x2*)(X + (size_t)(row + 1) * D) + c.lane;
#pragma unroll
            for (int j = 0; j < 4; ++j) vnx[j] = xr[64 * j]; }
        if (b != bcur) { bcur = b; const float* mb = modl + (size_t)b * 6144;
#pragma unroll
            for (int j = 0; j < 4; ++j) { const int col = 4 * (c.lane + 64 * j); gm[j] = *(const f32x4*)(gvec + col) * (*(const f32x4*)(mb + 4096 + col) + 1.0f); shv[j] = *(const f32x4*)(mb + 3072 + col); } }
#pragma unroll
        for (int j = 0; j < 4; ++j) ss += (v[j].x * v[j].x + v[j].y * v[j].y) + (v[j].z * v[j].z + v[j].w * v[j].w);
        const float rstd = rsqrtf(wave_sum(ss) * (1.0f / D) + EPS);
        f32x4 la = (f32x4){0.f, 0.f, 0.f, 0.f}, lb = (f32x4){0.f, 0.f, 0.f, 0.f};
#pragma unroll
        for (int j = 0; j < 4; ++j) { const int col = 4 * (c.lane + 64 * j);
            const f32x4 h = v[j] * rstd * gm[j] + shv[j];
            *(unsigned*)(H4 + (size_t)row * D + col) = pk4_fp8(h.x, h.y, h.z, h.w);
#pragma unroll
            for (int q = 0; q < 4; ++q) { la += wa[j][q] * h[q]; lb += wb[j][q] * h[q]; } }
        float lg[8] = {la.x, la.y, la.z, la.w, lb.x, lb.y, lb.z, lb.w};
#pragma unroll
        for (int e = 0; e < 8; ++e) lg[e] = wave_sum(lg[e]);
        int e0 = 0; float l0 = lg[0];
#pragma unroll
        for (int e = 1; e < 8; ++e) if (lg[e] > l0) { l0 = lg[e]; e0 = e; }
        int e1 = -1; float l1 = -3.0e38f;
#pragma unroll
        for (int e = 0; e < 8; ++e) if (e != e0 && lg[e] > l1) { l1 = lg[e]; e1 = e; }
        if (c.lane == 0) { const float w0 = 1.0f / (1.0f + __expf(l1 - l0));
            tok_w[row * 2] = w0; tok_w[row * 2 + 1] = 1.0f - w0;
            const unsigned r0 = atomicAdd((unsigned*)&lcnt[e0], 1u), r1 = atomicAdd((unsigned*)&lcnt[e1], 1u);
            const int j = min(row - rbeg, RT_RPWMAX - 1);
            lrank[(c.wave * RT_RPWMAX + j) * 2] = ((unsigned)e0 << 16) | r0; lrank[(c.wave * RT_RPWMAX + j) * 2 + 1] = ((unsigned)e1 << 16) | r1; }
    }
    __syncthreads();
    if (c.tid < NE) gbase[c.tid] = lcnt[c.tid] ? atomicAdd((unsigned*)(a.ws + WS_CTL) + c.tid * 64, lcnt[c.tid]) : 0u;
    __syncthreads();
    for (int i = c.tid; i < NWAVES * RPW * 2; i += NTHREADS) { const int w = i / (2 * RPW), j = (i % (2 * RPW)) >> 1, k = i & 1, row = (blockIdx.x * NWAVES + w) * RPW + j;
        if (row < NX && j < RT_RPWMAX) { const unsigned v = lrank[(w * RT_RPWMAX + j) * 2 + k], e = v >> 16, ent = e * pg8::ECAP + gbase[e] + (v & 0xffffu);
            tok_slot[row * 2 + k] = (int)ent; slot_tok[ent] = row; } }
}

__device__ __forceinline__ void expert_tiles(const Args& a, int (&tb)[9]) {
    const unsigned* ctl = (const unsigned*)(a.ws + WS_CTL); tb[0] = 0;
#pragma unroll
    for (int e = 0; e < 8; ++e) tb[e + 1] = tb[e] + (int)((__hip_atomic_load(ctl + e * 64, __ATOMIC_RELAXED, __HIP_MEMORY_SCOPE_AGENT) + 255u) >> 8);
}

constexpr int LDS_TB = 131072 + 256;
__device__ __forceinline__ int entry_row(int ent, const LAS int* tbl) { return tbl[ent >> 15] * 256 + (ent & (pg8::ECAP - 1)); }
__device__ __forceinline__ void p16_final(const Args& a, const Ctx& c, int gw, int NGW, int mode, int slot_thresh) {
    const LAS int* tbl = (const LAS int*)(c.lds + LDS_TB);
    const float* modl = (const float*)(a.ws + WS_MOD) + (size_t)17 * 6144; const float* fg = a.in[24];
    const float* tok_w = (const float*)(a.ws + WS_ROUTE + (size_t)NX * 8); const int* tok_slot = (const int*)(a.ws + WS_ROUTE + (size_t)NX * 16);
    const unsigned char* YS = a.ws + R_HP;
    const int RPW = ((NX + NGW - 1) / NGW + 1) & ~1, rbeg = gw * RPW, rend = min(NX, rbeg + RPW);
    f32x4 g2v[4], fgv[4]; int bcur = -1;
#pragma unroll
    for (int j = 0; j < 4; ++j) fgv[j] = *(const f32x4*)(fg + 4 * (c.lane + 64 * j));
    for (int row0 = rbeg; row0 < rend; row0 += 2) {
        f32x4 v[2][4]; u32x2 xv[2][4]; unsigned ya[2][4], yb[2][4]; float w0[2], w1[2]; bool go[2];
#pragma unroll
        for (int r = 0; r < 2; ++r) { const int row = row0 + r; const u32x2* xr = (const u32x2*)((const bf16_t*)(a.ws + WS_XB) + (size_t)row * D) + c.lane;
            const int s0 = entry_row(tok_slot[row * 2], tbl), s1 = entry_row(tok_slot[row * 2 + 1], tbl);
            go[r] = mode == 0 || ((max(s0, s1) >= slot_thresh) == (mode == 2));
            if (go[r]) { w0[r] = tok_w[row * 2] * (1.0f / YS_SCALE); w1[r] = tok_w[row * 2 + 1] * (1.0f / YS_SCALE);
                const unsigned* y0 = (const unsigned*)(YS + (size_t)s0 * D) + c.lane; const unsigned* y1 = (const unsigned*)(YS + (size_t)s1 * D) + c.lane;
#pragma unroll
                for (int j = 0; j < 4; ++j) { xv[r][j] = xr[64 * j]; ya[r][j] = y0[64 * j]; yb[r][j] = y1[64 * j]; } } }
        const int b = row0 / SEQ;
        if (b != bcur) { bcur = b;
#pragma unroll
            for (int j = 0; j < 4; ++j) g2v[j] = *(const f32x4*)(modl + (size_t)b * 6144 + 5120 + 4 * (c.lane + 64 * j)); }
#pragma unroll
        for (int r = 0; r < 2; ++r) if (go[r]) { const int row = row0 + r; f32x4* xr = (f32x4*)(a.out + (size_t)row * D) + c.lane; float ss = 0.f;
#pragma unroll
            for (int j = 0; j < 4; ++j) { const unsigned a0 = ya[r][j], a1 = yb[r][j];
                const f32x2 p0 = __builtin_amdgcn_cvt_pk_f32_fp8((int)a0, false), p1 = __builtin_amdgcn_cvt_pk_f32_fp8((int)a0, true), q0 = __builtin_amdgcn_cvt_pk_f32_fp8((int)a1, false), q1 = __builtin_amdgcn_cvt_pk_f32_fp8((int)a1, true);
                const f32x4 y0v = (f32x4){p0.x, p0.y, p1.x, p1.y}, y1v = (f32x4){q0.x, q0.y, q1.x, q1.y};
                v[r][j] = (f32x4){bf_lo(xv[r][j].x), bf_hi(xv[r][j].x), bf_lo(xv[r][j].y), bf_hi(xv[r][j].y)} + g2v[j] * (y0v * w0[r] + y1v * w1[r]);
                ss += (v[r][j].x * v[r][j].x + v[r][j].y * v[r][j].y) + (v[r][j].z * v[r][j].z + v[r][j].w * v[r][j].w); }
            const float rstd = rsqrtf(wave_sum(ss) * (1.0f / D) + EPS);
#pragma unroll
            for (int j = 0; j < 4; ++j) xr[64 * j] = v[r][j] * rstd * fgv[j]; }
    }
}

__global__ void __launch_bounds__(NTHREADS, 2) trunk_fwd(Args a) {
    extern __shared__ __attribute__((aligned(16))) unsigned char lds_raw[];
    Ctx c; c.lds = (LAS unsigned char*)lds_raw; c.tid = threadIdx.x; c.lane = c.tid & 63; c.wave = __builtin_amdgcn_readfirstlane(c.tid >> 6);
    c.G = gridDim.x; c.gw = blockIdx.x * NWAVES + c.wave; c.NGW = c.G * NWAVES;
    unsigned char* ws = a.ws;
    const float* mod0 = (const float*)(ws + WS_MOD); const float* mod1 = mod0 + (size_t)17 * 6144;
    bf16_t* XB = (bf16_t*)(ws + WS_XB);
    const int lo = a.ph_lo, hi = a.ph_hi;
#define IN(k) (lo <= (k) && (k) < hi)
    volatile LAS unsigned* MISC = (volatile LAS unsigned*)(c.lds + LDS_BYTES - 64);
    if (c.tid < 16) MISC[c.tid] = 0u;
    __syncthreads();
    XcdBarrier bar; bar.bar = (unsigned*)(ws + WS_BAR); bar.x = 0; bar.st = MISC;
    if (hi - lo > 1) bar = xcd_barrier_post((unsigned*)(ws + WS_BAR), MISC);
#ifdef PROBE_PH
    unsigned long long pt0 = 0, pt1 = 0;
#define PSTAMP(k) do { if ((k) == PROBE_PH) pt0 = __builtin_amdgcn_s_memrealtime(); if ((k) == PROBE_PH_END + 1) pt1 = __builtin_amdgcn_s_memrealtime(); } while (0)
#else
#define PSTAMP(k) do { } while (0)
#endif
#define SEAM(k) do { if (IN(k) && IN((k) + 1)) { xcd_barrier(bar); } PSTAMP((k) + 1); } while (0)
    PSTAMP(0);

    if (IN(0)) { p0_adaln(a, c); p0_convert(a, c); } SEAM(0);
    if (IN(1)) { pool_fused(a, c); } SEAM(1);
    PSTAMP(3); PSTAMP(4);
    if (IN(4)) {
        pg8::Prob P{(const bf16_t*)(ws + R_HB), (const bf16_t*)(ws + W_GUT), NT / 256, 2 * DFF / 256, D, D, D, 0, 0, false, 0, nullptr, c.G, (int)blockIdx.x};
        P.esz = 1;
        pg8::EpiSwiGLU8 E{ws + R_HID, DFF};
        pg8::gemm_phase<pg8::EpiSwiGLU8, false, true>(c.lds, P, E);
        if ((int)blockIdx.x >= (NT / 256 * (2 * DFF / 256)) % c.G) moe_convert_queue(a, c, 1, 16);
    } SEAM(4);
    if (IN(5)) {
        pg8::Prob P{(const bf16_t*)(ws + R_HID), (const bf16_t*)(ws + W_DT), NT / 256, D / 256, DFF, DFF, DFF, 0, 0, false, 0, nullptr, c.G, (int)blockIdx.x};
        P.esz = 1;
        pg8::EpiResid E{XB, mod0 + 5120, nullptr};
        const int rem5 = (NT / 256 * (D / 256)) % c.G; const bool slack5 = (int)blockIdx.x >= rem5, pre5 = slack5 && ((blockIdx.x >> 3) & 1);
        if (pre5) { moe_convert_queue(a, c, 1); __syncthreads(); }
        pg8::gemm_phase<pg8::EpiResid, false, true>(c.lds, P, E);
        if (slack5) moe_convert_queue(a, c, pre5 ? 1 : 2);
    } SEAM(5);
    if (IN(6)) { norm_mod_rows(XB, NT, a.in[6] + D, mod1, 0, 1024, (bf16_t*)(ws + R_H3), c); } SEAM(6);
    if (IN(7)) {
        pg8::Prob P{(const bf16_t*)(ws + R_H3), (const bf16_t*)(ws + W_INT), NT / 256, 2 * DR / 256, D, D, D, 0, 0, false, 0, nullptr, c.G, (int)blockIdx.x};
        pg8::EpiBf16 E{(bf16_t*)(ws + R_GU2), 2 * DR};
        pg8::gemm_phase(c.lds, P, E);
        if ((int)blockIdx.x >= (NT / 256 * (2 * DR / 256)) % c.G) moe_convert_queue(a, c, 1);
    } SEAM(7);
    if (IN(8)) { lru_pass1(a, c); if ((int)blockIdx.x >= (LRU_NCK * 10) % c.G) moe_convert_queue(a, c, 1, 32); } SEAM(8);
    if (IN(9)) { lru_scan2(a, c); } SEAM(9);
    PSTAMP(11); PSTAMP(12);
    if (IN(12)) {
        { int* slot_tok = (int*)(ws + WS_SLOTTOK); for (int i = blockIdx.x * NTHREADS + c.tid; i < NE * pg8::ECAP; i += c.G * NTHREADS) slot_tok[i] = 0; }
        pg8::Prob P{(const bf16_t*)(ws + R_Y), (const bf16_t*)(ws + W_OUTT), NX / 256, D / 256, DR, DR, DR, 0, 0, false, 0, nullptr, c.G, (int)blockIdx.x};
        pg8::EpiResid E{XB, mod1 + 2048, nullptr};
        pg8::gemm_phase(c.lds, P, E);
    } SEAM(12);
    if (IN(13)) { p12_route(a, c); moe_convert_queue(a, c, 1 << 20, 64, true, false); } SEAM(13);
    PSTAMP(15);
    int tb[9];
    if (IN(15) || IN(16) || IN(17) || IN(18)) { expert_tiles(a, tb);
        if (c.tid == 0) { LAS int* tbl = (LAS int*)(c.lds + LDS_TB);
#pragma unroll
            for (int q = 0; q < 9; ++q) tbl[q] = tb[q]; }
        __syncthreads(); }
    if (IN(15)) {
        pg8::Prob P{(const bf16_t*)(ws + R_H4), (const bf16_t*)(ws + W_MGUT), tb[8], 2 * DE / 256, D, D, D, 0, 0, true, (size_t)2 * DE * D, (const int*)(ws + WS_SLOTTOK), c.G, (int)blockIdx.x};
        P.esz = 1;
#pragma unroll
        for (int q = 0; q < 9; ++q) P.tb[q] = tb[q];
        pg8::EpiSwiGLU8 E{ws + R_MH, DE};
        pg8::gemm_phase<pg8::EpiSwiGLU8, true, true>(c.lds, P, E);
        { const int rem15 = (tb[8] * (2 * DE / 256)) % c.G; if (rem15 == 0 || (int)blockIdx.x >= rem15) moe_convert_queue(a, c, 1 << 20, 32, false, true); }
    } SEAM(15);
    const int mt = tb[8], main_mt = (mt / 64) * 64, ntail = (mt - main_mt) * 4;
    if (IN(16)) {
        pg8::Prob P{(const bf16_t*)(ws + R_MH), (const bf16_t*)(ws + W_MDT), main_mt, D / 256, DE, DE, DE, 0, 0, true, (size_t)D * DE, nullptr, c.G, (int)blockIdx.x};
        P.esz = 1;
#pragma unroll
        for (int q = 0; q < 9; ++q) P.tb[q] = tb[q];
        pg8::EpiFp8 E{ws + R_HP, D, YS_SCALE};
        pg8::gemm_phase<pg8::EpiFp8, false, true>(c.lds, P, E);
    } SEAM(16);
    if (IN(17)) {
        if (ntail >= c.G || (int)blockIdx.x < ntail) {
            pg8::Prob P{(const bf16_t*)(ws + R_MH), (const bf16_t*)(ws + W_MDT), mt - main_mt, D / 256, DE, DE, DE, 0, 0, true, (size_t)D * DE, nullptr, c.G, (int)blockIdx.x};
            P.esz = 1; P.pm_off = main_mt;
#pragma unroll
            for (int q = 0; q < 9; ++q) P.tb[q] = tb[q];
            pg8::EpiFp8 E{ws + R_HP, D, YS_SCALE};
            pg8::gemm_phase<pg8::EpiFp8, false, true>(c.lds, P, E);
        } else {
            p16_final(a, c, ((int)blockIdx.x - ntail) * NWAVES + c.wave, (c.G - ntail) * NWAVES, 1, main_mt * 256);
        }
    } SEAM(17);
    if (IN(18)) { p16_final(a, c, c.gw, c.NGW, ntail < c.G ? 2 : 0, main_mt * 256); }
#ifdef PROBE_PH
    if (PROBE_PH_END + 1 > NPHASES) pt1 = __builtin_amdgcn_s_memrealtime();
    { const unsigned long long tend = __builtin_amdgcn_s_memrealtime(), dt = (pt1 - pt0) * PROBE_MULT;
      while (__builtin_amdgcn_s_memrealtime() - tend < dt) __builtin_amdgcn_s_sleep(8); }
#endif
#undef IN
#undef SEAM
}

extern "C" void kernel_launch(void* const* d_in, const int* in_sizes, int n_in, void* d_out, int out_size, void* d_ws, size_t ws_size, hipStream_t stream) {
    static int grid = 0;
    if (grid == 0) {
        if (n_in != 25 || out_size != NX * D || ws_size < WS_NEED) { fprintf(stderr, "kernel_launch: unexpected shapes (n_in %d out %d ws %zu, need %zu)\n", n_in, out_size, ws_size, (size_t)WS_NEED); grid = -1; return; }
        int dev = 0, cus = 0, per_cu = 0;
        hipGetDevice(&dev); hipDeviceGetAttribute(&cus, hipDeviceAttributeMultiprocessorCount, dev);
        if (hipFuncSetAttribute((const void*)trunk_fwd, hipFuncAttributeMaxDynamicSharedMemorySize, LDS_BYTES) != hipSuccess) { fprintf(stderr, "kernel_launch: hipFuncSetAttribute failed\n"); grid = -1; return; }
        if (hipOccupancyMaxActiveBlocksPerMultiprocessor(&per_cu, (const void*)trunk_fwd, NTHREADS, LDS_BYTES) != hipSuccess || per_cu < 1) { fprintf(stderr, "kernel_launch: occupancy query says %d\n", per_cu); per_cu = 1; }
        (void)hipGetLastError();
        grid = cus;
    }
    if (grid < 0) return;
    hipMemsetAsync((char*)d_ws + WS_CTL, 0, CTL_BYTES, stream);
    Args a{};
    for (int i = 0; i < 25; ++i) a.in[i] = (const float*)d_in[i];
    a.out = (float*)d_out; a.ws = (unsigned char*)d_ws;
#if MK_SINGLE
    a.ph_lo = 0; a.ph_hi = NPHASES + 1;
    hipLaunchKernelGGL(trunk_fwd, dim3(grid), dim3(NTHREADS), LDS_BYTES, stream, a);
#else
    for (int ph = 0; ph <= NPHASES; ++ph) { a.ph_lo = ph; a.ph_hi = ph + 1;
        hipLaunchKernelGGL(trunk_fwd, dim3(grid), dim3(NTHREADS), LDS_BYTES, stream, a); }
#endif
}
```
